# Optimizing an MI355X kernel written in HIP

```python
import math, functools
import jax
import jax.numpy as jnp
from jax import lax
import numpy as np

D_MODEL = 1024
BATCH = 4
SEQ = 8192
DEPTH = 4

CTX_LEN = 256
GRID_W = 64
N_MIXERS = 4
GROUP_W = D_MODEL // N_MIXERS
D_MIX = N_MIXERS * GROUP_W
HEAD_DIM = 64
N_HEADS = GROUP_W // HEAD_DIM
CHUNK = 64
CONV_W = 3
EPS = 1e-6
D_FF = 2816
N_MOD = 9
GLA_RANK = 16
GLA_NORMALISER = 16.0
SSD_STATE = 64
SSD_GROUPS = 2
SSD_CONV_CH = GROUP_W + 2 * SSD_GROUPS * SSD_STATE
S5_CH = 16
S5_GROUPS = GROUP_W // S5_CH
S5_STATE = 64
GLA_COLS = 4 * GROUP_W + 2 * GLA_RANK
SSD_COLS = SSD_CONV_CH + GROUP_W + 2 * N_HEADS
MLSTM_COLS = 4 * GROUP_W + 4 * N_HEADS
S5_COLS = GROUP_W
IN_COLS = GLA_COLS + SSD_COLS + MLSTM_COLS + S5_COLS

kernel_name = 'hybrid_parallel_mixer_diffusion_trunk'


def _rmsnorm(t, g):
    tf = t.astype(jnp.float32)
    return (tf * lax.rsqrt(jnp.mean(tf * tf, axis=-1, keepdims=True) + EPS)).astype(t.dtype) * g


def _modnorm(t, m, j, g):
    return _rmsnorm(t, g) * (1.0 + m[:, :, 3 * j + 1]) + m[:, :, 3 * j]


def _gated_add(t, m, j, y, weight):
    return t + (weight * m[:, :, 3 * j + 2] * y).astype(t.dtype)


def _swiglu(h, w_in, w_out):
    gate, up = jnp.split(h @ w_in, 2, axis=-1)
    return (jax.nn.silu(gate) * up) @ w_out


def _split(p, sizes):
    idx = [int(i) for i in np.cumsum(sizes)[:-1]]
    return jnp.split(p, idx, axis=-1)


def _heads(t, n=N_HEADS):
    b, l, _ = t.shape
    return t.reshape(b, l, n, -1).transpose(0, 2, 1, 3)


def _merge(t):
    b, h, l, d = t.shape
    return t.transpose(0, 2, 1, 3).reshape(b, l, h * d)


def _head_rmsnorm(o, g):
    o = o * lax.rsqrt(jnp.mean(o * o, axis=-1, keepdims=True) + EPS)
    return _merge(o) * g


def _dwconv(t, w, bias):
    y = lax.conv_general_dilated(t, w.astype(t.dtype)[:, None, :], window_strides=(1,), padding='SAME',
                                 dimension_numbers=('NWC', 'WIO', 'NWC'), feature_group_count=t.shape[-1])
    return y + bias


def _to_col_major(t, rows):
    b, l, ch = t.shape
    return t.reshape(b, rows, GRID_W, ch).transpose(0, 2, 1, 3).reshape(b, l, ch)


def _to_row_major(t, rows):
    b, l, ch = t.shape
    return t.reshape(b, GRID_W, rows, ch).transpose(0, 2, 1, 3).reshape(b, l, ch)


def _to_chunks(t):
    b, h, l = t.shape[:3]
    return jnp.moveaxis(t.reshape((b, h, l // CHUNK, CHUNK) + t.shape[3:]), 2, 0)


def _from_chunks(t):
    t = jnp.moveaxis(t, 0, 2)
    return t.reshape(t.shape[:2] + (-1,) + t.shape[4:])


def _causal_mask():
    return jnp.tril(jnp.ones((CHUNK, CHUNK), dtype=bool))


def _flip_time(t, reverse):
    return jnp.flip(t, axis=2) if reverse else t


def _bidirectional(runs, ctx_ins, lat_ins):
    out_c, out_l = [], []
    for d in range(2):
        rev = d == 1
        oc, state = runs[d](tuple(_flip_time(t, rev) for t in ctx_ins[d]), None)
        ol, _ = runs[d](tuple(_flip_time(t, rev) for t in lat_ins[d]), state)
        out_c.append(_flip_time(oc, rev))
        out_l.append(_flip_time(ol, rev))
    return out_c[0] + out_c[1], out_l[0] + out_l[1]


def _gla_run(inp, state):
    q, k, v, g = inp
    if state is None:
        state = jnp.zeros(q.shape[:2] + (q.shape[-1], v.shape[-1]), jnp.float32)
    mask = _causal_mask()

    def step(s, blk):
        qc, kc, vc, gc = blk
        b = jnp.cumsum(gc, axis=2)
        q_t = qc * jnp.exp(b)
        att = jnp.where(mask, jnp.einsum('bhtd,bhsd->bhts', q_t, kc * jnp.exp(-b)), 0.0)
        o = jnp.einsum('bhts,bhsv->bhtv', att, vc) + jnp.einsum('bhtd,bhdv->bhtv', q_t, s)
        b_last = b[:, :, -1:, :]
        s = jnp.exp(b_last[:, :, 0])[..., None] * s + jnp.einsum('bhsd,bhsv->bhdv', kc * jnp.exp(b_last - b), vc)
        return s, o

    s, o = lax.scan(step, state, tuple(_to_chunks(t) for t in inp))
    return _from_chunks(o), s


def _gla_mixer(pc, px, w_lr2, b_lr2, g_out):
    def prep(p):
        q, k, v, r, lr_f, lr_b = _split(p, [GROUP_W, GROUP_W, GROUP_W, GROUP_W, GLA_RANK, GLA_RANK])
        q = _heads(q) * HEAD_DIM ** -0.5
        k, v = _heads(k), _heads(v)
        ins = tuple((q, k, v, _heads(jax.nn.log_sigmoid(lr @ w_lr2[d] + b_lr2[d]) / GLA_NORMALISER))
                    for d, lr in enumerate((lr_f, lr_b)))
        return ins, r

    ins_c, r_c = prep(pc)
    ins_x, r_x = prep(px)
    o_c, o_x = _bidirectional((_gla_run, _gla_run), ins_c, ins_x)
    return (_head_rmsnorm(o_c, g_out) * jax.nn.silu(r_c), _head_rmsnorm(o_x, g_out) * jax.nn.silu(r_x))


def _ssd_run(inp, state):
    c_in, b_in, xdt, a = inp
    if state is None:
        state = jnp.zeros(b_in.shape[:2] + (b_in.shape[-1], xdt.shape[-1]), jnp.float32)
    mask = _causal_mask()

    def step(s, blk):
        cc, bc, xc, ac = blk
        cum = jnp.cumsum(ac, axis=-1)
        decay = jnp.exp(jnp.where(mask, cum[..., :, None] - cum[..., None, :], -jnp.inf))
        scores = jnp.einsum('bhtn,bhsn->bhts', cc, bc) * decay
        y = (jnp.einsum('bhts,bhsp->bhtp', scores, xc)
             + jnp.exp(cum)[..., None] * jnp.einsum('bhtn,bhnp->bhtp', cc, s))
        w = jnp.exp(cum[..., -1:] - cum)[..., None]
        s = jnp.exp(cum[..., -1])[..., None, None] * s + jnp.einsum('bhsn,bhsp->bhnp', bc * w, xc)
        return s, y

    s, y = lax.scan(step, state, tuple(_to_chunks(t) for t in inp))
    return _from_chunks(y), s


def _ssd_mixer(pc, px, conv_w, conv_b, a_log, dt_bias, d_skip, g_out):
    hpg = N_HEADS // SSD_GROUPS
    neg_a = -jnp.exp(a_log.astype(jnp.float32))

    def prep(p):
        b, l, _ = p.shape
        xbc, z, dt = _split(p, [SSD_CONV_CH, GROUP_W, 2 * N_HEADS])
        xs, bm, cm = _split(jax.nn.silu(_dwconv(xbc, conv_w, conv_b)),
                            [GROUP_W, SSD_GROUPS * SSD_STATE, SSD_GROUPS * SSD_STATE])
        xs = _heads(xs)
        bm = jnp.repeat(_heads(bm, SSD_GROUPS), hpg, axis=1)
        cm = jnp.repeat(_heads(cm, SSD_GROUPS), hpg, axis=1)
        dt = jax.nn.softplus(dt.reshape(b, l, 2, N_HEADS) + dt_bias).transpose(2, 0, 3, 1)
        ins = tuple((cm, bm, xs * dt[d][..., None], dt[d] * neg_a[d][:, None]) for d in range(2))
        return ins, xs, z

    ins_c, xs_c, z_c = prep(pc)
    ins_x, xs_x, z_x = prep(px)
    o_c, o_x = _bidirectional((_ssd_run, _ssd_run), ins_c, ins_x)

    def out(o, xs, z):
        return _rmsnorm(_merge(o + d_skip[:, None, None] * xs) * jax.nn.silu(z), g_out)

    return out(o_c, xs_c, z_c), out(o_x, xs_x, z_x)


def _mlstm_run(inp, state):
    q, k, v, ig, lf = inp
    if state is None:
        bh = q.shape[:2]
        state = (jnp.zeros(bh + (q.shape[-1], v.shape[-1]), jnp.float32),
                 jnp.zeros(bh + (q.shape[-1],), jnp.float32),
                 jnp.zeros(bh, jnp.float32))
    mask = _causal_mask()

    def step(carry, blk):
        c_s, n_s, m_s = carry
        qc, kc, vc, ic, fc = blk
        f_cum = jnp.cumsum(fc, axis=-1)
        log_intra = jnp.where(mask, f_cum[..., :, None] - f_cum[..., None, :] + ic[..., None, :], -jnp.inf)
        log_inter = f_cum + m_s[..., None]
        m = jnp.maximum(log_inter, jnp.max(log_intra, axis=-1))
        w = jnp.einsum('bhtd,bhsd->bhts', qc, kc) * jnp.exp(log_intra - m[..., None])
        w_inter = jnp.exp(log_inter - m)
        num = jnp.einsum('bhts,bhsv->bhtv', w, vc) + w_inter[..., None] * jnp.einsum('bhtd,bhdv->bhtv', qc, c_s)
        den = jnp.sum(w, axis=-1) + w_inter * jnp.einsum('bhtd,bhd->bht', qc, n_s)
        h = num / jnp.maximum(jnp.abs(den), jnp.exp(-m))[..., None]
        m_new = m[..., -1]
        decay = jnp.exp(f_cum[..., -1] + m_s - m_new)
        k_w = kc * jnp.exp(f_cum[..., -1:] - f_cum + ic - m_new[..., None])[..., None]
        c_s = decay[..., None, None] * c_s + jnp.einsum('bhsd,bhsv->bhdv', k_w, vc)
        n_s = decay[..., None] * n_s + jnp.sum(k_w, axis=2)
        return (c_s, n_s, m_new), h

    final, h = lax.scan(step, state, tuple(_to_chunks(t) for t in inp))
    return _from_chunks(h), final


def _mlstm_mixer(pc, px, conv_w, conv_b, gate_bias, g_out):
    def prep(p):
        b, l, _ = p.shape
        qk, v, o, gates = _split(p, [2 * GROUP_W, GROUP_W, GROUP_W, 4 * N_HEADS])
        q, k = jnp.split(jax.nn.silu(_dwconv(qk, conv_w, conv_b)), 2, axis=-1)
        q, k, v = _heads(q), _heads(k) * HEAD_DIM ** -0.5, _heads(v)
        g = (gates.reshape(b, l, 2, 2, N_HEADS) + gate_bias).transpose(2, 3, 0, 4, 1)
        ins = tuple((q, k, v, g[d, 0], jax.nn.log_sigmoid(g[d, 1])) for d in range(2))
        return ins, o

    ins_c, o_c = prep(pc)
    ins_x, o_x = prep(px)
    h_c, h_x = _bidirectional((_mlstm_run, _mlstm_run), ins_c, ins_x)
    return (_head_rmsnorm(h_c, g_out) * jax.nn.sigmoid(o_c), _head_rmsnorm(h_x, g_out) * jax.nn.sigmoid(o_x))


def _s5_discretise(a_re, a_im, log_step, b_re, b_im):
    a_re = jnp.minimum(a_re.astype(jnp.float32), -1e-4)
    a_im = a_im.astype(jnp.float32)
    b_re, b_im = b_re.astype(jnp.float32), b_im.astype(jnp.float32)
    step = jnp.exp(log_step.astype(jnp.float32))[:, None]
    mag = jnp.exp(a_re * step)
    abar_re, abar_im = mag * jnp.cos(a_im * step), mag * jnp.sin(a_im * step)
    den = a_re * a_re + a_im * a_im
    nr, ni = abar_re - 1.0, abar_im
    coef_re = (nr * a_re + ni * a_im) / den
    coef_im = (ni * a_re - nr * a_im) / den
    bbar_re = coef_re[..., None] * b_re - coef_im[..., None] * b_im
    bbar_im = coef_re[..., None] * b_im + coef_im[..., None] * b_re
    return abar_re, abar_im, bbar_re, bbar_im


def _complex_linear_combine(e1, e2):
    ar1, ai1, br1, bi1 = e1
    ar2, ai2, br2, bi2 = e2
    return (ar2 * ar1 - ai2 * ai1, ar2 * ai1 + ai2 * ar1,
            ar2 * br1 - ai2 * bi1 + br2, ar2 * bi1 + ai2 * br1 + bi2)


def _s5_run(abar_re, abar_im, bbar_re, bbar_im, c_re, c_im, inp, state):
    (u,) = inp
    bu_re = jnp.einsum('bglj,gnj->bgln', u, bbar_re)
    bu_im = jnp.einsum('bglj,gnj->bgln', u, bbar_im)
    if state is not None:
        h_re0, h_im0 = state
        bu_re = bu_re.at[:, :, 0].add(abar_re * h_re0 - abar_im * h_im0)
        bu_im = bu_im.at[:, :, 0].add(abar_re * h_im0 + abar_im * h_re0)
    shape = (1, abar_re.shape[0], u.shape[2], abar_re.shape[1])
    a_re = jnp.broadcast_to(abar_re[None, :, None, :], shape)
    a_im = jnp.broadcast_to(abar_im[None, :, None, :], shape)
    _, _, h_re, h_im = lax.associative_scan(_complex_linear_combine, (a_re, a_im, bu_re, bu_im), axis=2)
    y = jnp.einsum('bgln,gjn->bglj', h_re, c_re) - jnp.einsum('bgln,gjn->bglj', h_im, c_im)
    return y, (h_re[:, :, -1], h_im[:, :, -1])


def _s5_mixer(pc, px, a_re, a_im, log_step, b_re, b_im, c_re, c_im, d_skip, w_glu, b_glu):
    c_re, c_im = c_re.astype(jnp.float32), c_im.astype(jnp.float32)
    runs = tuple(functools.partial(_s5_run, *_s5_discretise(a_re[d], a_im[d], log_step[d], b_re, b_im), c_re, c_im)
                 for d in range(2))

    def groups(p):
        b, l, _ = p.shape
        return (p.reshape(b, l, S5_GROUPS, S5_CH).transpose(0, 2, 1, 3),)

    u_c, u_x = groups(pc), groups(px)
    y_c, y_x = _bidirectional(runs, (u_c, u_c), (u_x, u_x))

    def out(y, p):
        b, _, l, _ = y.shape
        y = y.transpose(0, 2, 1, 3).reshape(b, l, GROUP_W) + d_skip * p
        g = jax.nn.gelu(y)
        return g * jax.nn.sigmoid(g @ w_glu + b_glu)

    return out(y_c, pc), out(y_x, px)


def _token_mixing(hc, hx, rows, w_in, gla_w_lr2, gla_b_lr2, gla_g_norm, ssd_conv_w, ssd_conv_b, ssd_a_log,
                  ssd_dt_bias, ssd_d, ssd_g_norm, ml_conv_w, ml_conv_b, ml_gate_bias, ml_g_norm, s5_a_re, s5_a_im,
                  s5_log_step, s5_b_re, s5_b_im, s5_c_re, s5_c_im, s5_d, s5_w_glu, s5_b_glu):
    sizes = [GLA_COLS, SSD_COLS, MLSTM_COLS, S5_COLS]
    gla_c, ssd_c, ml_c, s5_c = _split((hc @ w_in).astype(jnp.float32), sizes)
    gla_x, ssd_x, ml_x, s5_x = _split((hx @ w_in).astype(jnp.float32), sizes)
    a_c, a_x = _gla_mixer(gla_c, gla_x, gla_w_lr2, gla_b_lr2, gla_g_norm)
    b_c, b_x = _ssd_mixer(ssd_c, _to_col_major(ssd_x, rows), ssd_conv_w, ssd_conv_b, ssd_a_log, ssd_dt_bias,
                          ssd_d, ssd_g_norm)
    m_c, m_x = _mlstm_mixer(ml_c, ml_x, ml_conv_w, ml_conv_b, ml_gate_bias, ml_g_norm)
    d_c, d_x = _s5_mixer(s5_c, _to_col_major(s5_x, rows), s5_a_re, s5_a_im, s5_log_step, s5_b_re, s5_b_im,
                         s5_c_re, s5_c_im, s5_d, s5_w_glu, s5_b_glu)
    out_c = jnp.concatenate([a_c, b_c, m_c, d_c], axis=-1)
    out_x = jnp.concatenate([a_x, _to_row_major(b_x, rows), m_x, _to_row_major(d_x, rows)], axis=-1)
    return out_c, out_x


def setup_inputs(seed: int = 0) -> dict:
    key = jax.random.key(seed)
    ks = iter(jax.random.split(key, 48))
    f32 = jnp.float32
    L, D = DEPTH, D_MODEL

    def nrm(shape, scale):
        return jax.random.normal(next(ks), shape, f32) * scale

    def gain(shape):
        return 1.0 + nrm(shape, 0.02)

    def log_uniform(shape, lo, hi):
        return jax.random.uniform(next(ks), shape, f32, math.log(lo), math.log(hi))

    ssd_dt = jnp.exp(log_uniform((L, 2, N_HEADS), 1e-3, 1e-1))
    ml_gate_bias = jnp.stack([nrm((L, 2, N_HEADS), 0.1),
                              jnp.linspace(3.0, 6.0, N_HEADS, dtype=f32) + nrm((L, 2, N_HEADS), 0.1)], axis=2)
    return {
        'x': nrm((BATCH, SEQ, D), 1.0),
        'c': nrm((BATCH, D), 1.0),
        'ctx': nrm((BATCH, CTX_LEN, D), 1.0),
        'c_ctx': nrm((D,), 1.0),
        'w_mod': nrm((L, D, N_MOD * D), 0.5 * D ** -0.5),
        'b_mod': nrm((L, N_MOD * D), 0.02),
        'g_norm': gain((L, 3, D)),
        'ffn_w_in': nrm((L, 2, D, 2 * D_FF), D ** -0.5),
        'ffn_w_out': nrm((L, 2, D_FF, D), D_FF ** -0.5),
        'w_in': nrm((L, D, IN_COLS), D ** -0.5),
        'w_out': nrm((L, D_MIX, D), D_MIX ** -0.5),
        'gla_w_lr2': nrm((L, 2, GLA_RANK, GROUP_W), GLA_RANK ** -0.5),
        'gla_b_lr2': 1.0 + nrm((L, 2, GROUP_W), 0.1),
        'gla_g_norm': gain((L, GROUP_W)),
        'ssd_conv_w': nrm((L, CONV_W, SSD_CONV_CH), CONV_W ** -0.5),
        'ssd_conv_b': nrm((L, SSD_CONV_CH), 0.02),
        'ssd_a_log': jnp.log(jax.random.uniform(next(ks), (L, 2, N_HEADS), f32, 1.0, 16.0)),
        'ssd_dt_bias': ssd_dt + jnp.log(-jnp.expm1(-ssd_dt)),
        'ssd_d': gain((L, N_HEADS)),
        'ssd_g_norm': gain((L, GROUP_W)),
        'ml_conv_w': nrm((L, CONV_W, 2 * GROUP_W), CONV_W ** -0.5),
        'ml_conv_b': nrm((L, 2 * GROUP_W), 0.02),
        'ml_gate_bias': ml_gate_bias,
        'ml_g_norm': gain((L, GROUP_W)),
        's5_a_re': -0.5 + nrm((L, 2, S5_GROUPS, S5_STATE), 0.01),
        's5_a_im': jnp.pi * jnp.arange(S5_STATE, dtype=f32) + nrm((L, 2, S5_GROUPS, S5_STATE), 0.01),
        's5_log_step': log_uniform((L, 2, S5_GROUPS), 1e-3, 1e-1),
        's5_b_re': nrm((L, S5_GROUPS, S5_STATE, S5_CH), (2 * S5_CH) ** -0.5),
        's5_b_im': nrm((L, S5_GROUPS, S5_STATE, S5_CH), (2 * S5_CH) ** -0.5),
        's5_c_re': nrm((L, S5_GROUPS, S5_CH, S5_STATE), (2 * S5_STATE) ** -0.5),
        's5_c_im': nrm((L, S5_GROUPS, S5_CH, S5_STATE), (2 * S5_STATE) ** -0.5),
        's5_d': nrm((L, GROUP_W), 1.0),
        's5_w_glu': nrm((L, GROUP_W, GROUP_W), GROUP_W ** -0.5),
        's5_b_glu': nrm((L, GROUP_W), 0.02),
        'g_final': gain((D,)),
    }


def reference(x, c, ctx, c_ctx, w_mod, b_mod, g_norm, ffn_w_in, ffn_w_out, w_in, w_out, gla_w_lr2, gla_b_lr2,
              gla_g_norm, ssd_conv_w, ssd_conv_b, ssd_a_log, ssd_dt_bias, ssd_d, ssd_g_norm, ml_conv_w, ml_conv_b,
              ml_gate_bias, ml_g_norm, s5_a_re, s5_a_im, s5_log_step, s5_b_re, s5_b_im, s5_c_re, s5_c_im, s5_d,
              s5_w_glu, s5_b_glu, g_final):
    bsz = x.shape[0]
    rows = x.shape[1] // GRID_W
    for l in range(DEPTH):
        last = l == DEPTH - 1
        m_x = (jax.nn.silu(c) @ w_mod[l] + b_mod[l]).reshape(bsz, 1, N_MOD, D_MODEL)
        m_c = (jax.nn.silu(c_ctx) @ w_mod[l] + b_mod[l]).reshape(1, 1, N_MOD, D_MODEL)
        x = _gated_add(x, m_x, 0, _swiglu(_modnorm(x, m_x, 0, g_norm[l, 0]), ffn_w_in[l, 0], ffn_w_out[l, 0]), 0.5)
        ctx = _gated_add(ctx, m_c, 0, _swiglu(_modnorm(ctx, m_c, 0, g_norm[l, 0]), ffn_w_in[l, 0], ffn_w_out[l, 0]), 0.5)
        o_c, o_x = _token_mixing(
            _modnorm(ctx, m_c, 1, g_norm[l, 1]), _modnorm(x, m_x, 1, g_norm[l, 1]), rows, w_in[l],
            gla_w_lr2[l], gla_b_lr2[l], gla_g_norm[l], ssd_conv_w[l], ssd_conv_b[l], ssd_a_log[l], ssd_dt_bias[l],
            ssd_d[l], ssd_g_norm[l], ml_conv_w[l], ml_conv_b[l], ml_gate_bias[l], ml_g_norm[l], s5_a_re[l],
            s5_a_im[l], s5_log_step[l], s5_b_re[l], s5_b_im[l], s5_c_re[l], s5_c_im[l], s5_d[l], s5_w_glu[l],
            s5_b_glu[l])
        x = _gated_add(x, m_x, 1, o_x @ w_out[l], 1.0)
        x = _gated_add(x, m_x, 2, _swiglu(_modnorm(x, m_x, 2, g_norm[l, 2]), ffn_w_in[l, 1], ffn_w_out[l, 1]), 0.5)
        if not last:
            ctx = _gated_add(ctx, m_c, 1, o_c @ w_out[l], 1.0)
            ctx = _gated_add(ctx, m_c, 2, _swiglu(_modnorm(ctx, m_c, 2, g_norm[l, 2]), ffn_w_in[l, 1], ffn_w_out[l, 1]), 0.5)
    return _rmsnorm(x, g_final)
```

```cpp
#include <hip/hip_runtime.h>
#include <hip/hip_cooperative_groups.h>
#include <cstdio>
namespace cg = cooperative_groups;

#define LAS __attribute__((address_space(3)))
typedef unsigned short bf16_t;
typedef short bf16x8 __attribute__((ext_vector_type(8)));
typedef float f32x4 __attribute__((ext_vector_type(4)));
typedef unsigned u32x4 __attribute__((ext_vector_type(4)));
typedef unsigned u32x2 __attribute__((ext_vector_type(2)));
typedef LAS unsigned char* lds_t;

constexpr int DM = 1024, NB = 4, SEQ = 8192, DEPTH = 4, CTXL = 256;
constexpr int NLAT = NB * SEQ, NCTX = NB * CTXL, NT = NLAT + NCTX;
constexpr int DFF = 2816, NIN = 3128, NINP = 3328;
constexpr int GLA_Q = 0, GLA_K = 256, GLA_V = 512, GLA_R = 768;
constexpr int SSD_X = 1056, SSD_B = 1312, SSD_C = 1440, SSD_Z = 1568;
constexpr int ML_Q = 1832, ML_V = 2344, ML_O = 2600;
constexpr int S50 = 2872;
constexpr int PGW = 96;
constexpr float EPS = 1e-6f;

constexpr size_t SZ_WFI = (size_t)DEPTH * 2 * 5632 * 1024 * 2;
constexpr size_t SZ_WFO = (size_t)DEPTH * 2 * 1024 * 2816 * 2;
constexpr size_t SZ_WIN = (size_t)DEPTH * NINP * 1024 * 2;
constexpr size_t SZ_WOUT = (size_t)DEPTH * 1024 * 1024 * 2;
constexpr size_t SZ_WGLU = (size_t)DEPTH * 256 * 256 * 2;
constexpr size_t SZ_MODS = (size_t)DEPTH * 5 * 9216 * 4;
constexpr size_t SZ_CTXX = (size_t)NCTX * 1024 * 4;
constexpr size_t SZ_H = (size_t)NT * 1024 * 2;
constexpr size_t SZ_PB = (size_t)NT * NINP * 2;
constexpr size_t SZ_PG = (size_t)NT * PGW * 4;
constexpr size_t SZ_GB = (size_t)NT * 256 * 2;
constexpr size_t WS_WFI = 0;
constexpr size_t WS_WFO = WS_WFI + SZ_WFI;
constexpr size_t WS_WIN = WS_WFO + SZ_WFO;
constexpr size_t WS_WOUT = WS_WIN + SZ_WIN;
constexpr size_t WS_WGLU = WS_WOUT + SZ_WOUT;
constexpr size_t WS_MODS = WS_WGLU + SZ_WGLU;
constexpr size_t WS_CTXX = WS_MODS + SZ_MODS;
constexpr size_t WS_H = WS_CTXX + SZ_CTXX;
constexpr size_t WS_H2 = WS_H + SZ_H;
constexpr size_t WS_PB = WS_H2 + SZ_H;
constexpr size_t WS_PG = WS_PB + SZ_PB;
constexpr size_t WS_GB = WS_PG + SZ_PG;
constexpr size_t WS_BAR = WS_GB + SZ_GB;
constexpr size_t SZ_BAR = 16384;
constexpr size_t WS_SLAB = WS_BAR + SZ_BAR;
constexpr size_t SZ_SLAB = (size_t)11 * NCTX * 1024 * 4;
constexpr size_t WS_END = WS_SLAB + SZ_SLAB;

struct Params {
    const float* in[35];
    float* out;
    unsigned char* ws;
};
typedef const __attribute__((address_space(4))) Params* cparams_t;
#define CPR const __attribute__((address_space(4))) Params&
__device__ __forceinline__ cparams_t getP() { cparams_t p = (cparams_t)__builtin_amdgcn_kernarg_segment_ptr(); asm volatile("" : "+s"(p)); return p; }
enum { I_X = 0, I_C, I_CTX, I_CCTX, I_WMOD, I_BMOD, I_GNORM, I_FFNWIN, I_FFNWOUT, I_WIN, I_WOUT, I_GLAW, I_GLAB, I_GLAG,
       I_SSDCW, I_SSDCB, I_SSDALOG, I_SSDDTB, I_SSDD, I_SSDG, I_MLCW, I_MLCB, I_MLGB, I_MLG, I_S5ARE, I_S5AIM, I_S5LS,
       I_S5BRE, I_S5BIM, I_S5CRE, I_S5CIM, I_S5D, I_S5WGLU, I_S5BGLU, I_GFINAL };

__device__ __forceinline__ float bf2f(unsigned b) { return __uint_as_float(b << 16); }
typedef __bf16 bf16x2_t __attribute__((ext_vector_type(2)));
typedef float f32x2_t __attribute__((ext_vector_type(2)));
__device__ __forceinline__ unsigned cvt_pk_bf16(float lo, float hi) { const f32x2_t f = {lo, hi}; return __builtin_bit_cast(unsigned, __builtin_convertvector(f, bf16x2_t)); }
__device__ __forceinline__ bf16_t f2bf(float f) { return (bf16_t)(cvt_pk_bf16(f, 0.f) & 0xffffu); }
__device__ __forceinline__ float bflo(unsigned w) { return __uint_as_float(w << 16); }
__device__ __forceinline__ float bfhi(unsigned w) { return __uint_as_float(w & 0xffff0000u); }
__device__ __forceinline__ float sigmoidf_(float x) { return 1.0f / (1.0f + __expf(-x)); }
__device__ __forceinline__ float siluf_(float x) { return x * sigmoidf_(x); }
__device__ __forceinline__ float logsigf_(float x) { return fminf(x, 0.f) - __logf(1.0f + __expf(-fabsf(x))); }
__device__ __forceinline__ float softplusf_(float x) { return fmaxf(x, 0.f) + __logf(1.0f + __expf(-fabsf(x))); }
__device__ __forceinline__ float geluf_(float x) { const float u = 0.7978845608028654f * (x + 0.044715f * x * x * x); return x * sigmoidf_(2.0f * u); }

__device__ __forceinline__ int tok_row(int seg, int b, int p, bool colmajor) {
    if (seg == 0) return NLAT + b * CTXL + p;
    return b * SEQ + (colmajor ? ((p & 127) * 64 + (p >> 7)) : p);
}

__device__ __forceinline__ int opaque_tid() { int t = threadIdx.x; asm volatile("" : "+v"(t) :: "memory"); return t; }
__device__ __forceinline__ float shfl_idx(float v, int srclane) { return __int_as_float(__builtin_amdgcn_ds_bpermute(srclane << 2, __float_as_int(v))); }
template <bool TRANS, int KSTEPS, int SA, int SB, bool SAFE = false>
__device__ __forceinline__ void mma_tile(f32x4& acc, lds_t As, int arow0, lds_t Bs, int brow0, int fr, int fq) {
#pragma unroll
    for (int kk = 0; kk < KSTEPS; ++kk) {
        const bf16x8 a = *(const LAS bf16x8*)(As + (arow0 + fr) * SA + kk * 64 + fq * 16);
        const bf16x8 b = *(const LAS bf16x8*)(Bs + (brow0 + fr) * SB + kk * 64 + fq * 16);
        if (SAFE) asm volatile("s_waitcnt lgkmcnt(0)" ::: "memory");
        if (TRANS) acc = __builtin_amdgcn_mfma_f32_16x16x32_bf16(b, a, acc, 0, 0, 0);
        else acc = __builtin_amdgcn_mfma_f32_16x16x32_bf16(a, b, acc, 0, 0, 0);
    }
}
constexpr int LDT = 144;

namespace pg8 {
constexpr int BM = 256, BK = 64, HALF = 128, HTB = HALF * BK * 2, STAGE_BYTES = 8 * HTB, NXCD = 8, WGM = 8;
__device__ __forceinline__ int lds_byte(int r, int c) { const int st = (r >> 4) * 2 + (c >> 5), rr = r & 15, cc = c & 31, ob = rr * 64 + cc * 2; return st * 1024 + (ob ^ (((ob >> 9) & 1) << 5)); }
__device__ __forceinline__ void stage_rc(int b, int& R, int& C) { const int st = b / 1024, sb = b % 1024, swz = sb ^ (((sb >> 9) & 1) << 5); R = (st >> 1) * 16 + swz / 64; C = (st & 1) * 32 + (swz % 64) / 2; }
__device__ __forceinline__ int perm32(int rho) { const int n = rho >> 4, i = rho & 15; return 8 * (i >> 2) + 4 * n + (i & 3); }
struct Unit { int pm, pn, ks; };
struct Gemm { const bf16_t* A; const bf16_t* Bt; int M, N, K, lda, ldb; };
struct StaticOrder {
    int nM, nN, nwg, G, c;
    __device__ void init(int M, int N, int G_, int c_) { nM = M / BM; nN = N / BM; nwg = nM * nN; G = G_; c = c_; }
    __device__ bool next(int i, Unit& u) const {
        const long L = (long)i * G + c; if (L >= nwg) return false;
        int wgid = (int)L; { const int q = nwg / NXCD, r = nwg % NXCD, xcd = wgid % NXCD, off = wgid / NXCD; wgid = (xcd < r ? xcd * (q + 1) : r * (q + 1) + (xcd - r) * q) + off; }
        const int nig = WGM * nN, gid = wgid / nig, fm = gid * WGM, gsz = (nM - fm) < WGM ? (nM - fm) : WGM;
        u.pm = fm + ((wgid % nig) % gsz); u.pn = (wgid % nig) / gsz; u.ks = 0; return true;
    }
};
struct SplitKOrder {
    int nN, nks, n, G, c;
    __device__ void init(int M, int N, int nks_, int G_, int c_) { nN = N / BM; nks = nks_; n = (M / BM) * nN * nks; G = G_; c = c_; }
    __device__ bool next(int i, Unit& u) const { const long L = (long)i * G + c; if (L >= n) return false; const int l = (int)L; u.ks = l % nks; const int r = l / nks; u.pn = r % nN; u.pm = r / nN; return true; }
};
template <class Epi, class Sched>
__device__ __forceinline__ void gemm_phase(lds_t lds, const Gemm g, const Sched& S, const Epi& E) {
    const int tid = opaque_tid(), wid = __builtin_amdgcn_readfirstlane(tid >> 6), lane = tid & 63, wr = wid >> 2, wc = wid & 3, fr = lane & 15, fq = lane >> 4;
    const int K = g.K, nt = K / BK;
    unsigned voffA[2], voffB[2];
#pragma unroll
    for (int i = 0; i < 2; ++i) { int R, C; stage_rc(tid * 16 + i * 8192, R, C); const int Rb = Epi::PERM ? ((R & ~31) + perm32(R & 31)) : R;
        voffA[i] = (unsigned)(R * g.lda + C) * 2u; voffB[i] = (unsigned)(Rb * g.ldb + C) * 2u; }
    const size_t kstep = (size_t)(BK * 2);
    const size_t hstepA = (size_t)HALF * g.lda * 2, hstepB = (size_t)HALF * g.ldb * 2;
    const size_t tstepA = 2 * hstepA, tstepB = 2 * hstepB, kslice = (size_t)K * 2;
    const unsigned ldsw = (unsigned)wid * 1024u;
    const int aoff = lds_byte(wr * 64 + fr, fq * 8), boff = lds_byte(wc * 32 + fr, fq * 8);
#define PG8_SA(b, h) (((b) * 2 + (h)) * HTB)
#define PG8_SB(b, h) ((4 + (b) * 2 + (h)) * HTB)
#define PG8_STAGE(bufoff, gbase, voff) do { _Pragma("unroll") for (int _i = 0; _i < 2; ++_i) \
        __builtin_amdgcn_global_load_lds((const unsigned*)((const char*)(gbase) + (voff)[_i]), (LAS unsigned*)(lds + (bufoff) + ldsw + _i * 8192), 16, 0, 0); } while (0)
#define PG8_LDA(dst, b, h) do { _Pragma("unroll") for (int m = 0; m < 4; ++m) _Pragma("unroll") for (int k = 0; k < 2; ++k) dst[m][k] = *(const LAS bf16x8*)(lds + PG8_SA(b, h) + aoff + m * 2048 + k * 1024); } while (0)
#define PG8_LDB(dst, b, h) do { _Pragma("unroll") for (int n = 0; n < 2; ++n) _Pragma("unroll") for (int k = 0; k < 2; ++k) dst[n][k] = *(const LAS bf16x8*)(lds + PG8_SB(b, h) + boff + n * 2048 + k * 1024); } while (0)
#define PG8_MMA(ai, bj, At, Bt) do { __builtin_amdgcn_s_setprio(1); _Pragma("unroll") for (int m = 0; m < 4; ++m) _Pragma("unroll") for (int n = 0; n < 2; ++n) _Pragma("unroll") for (int k = 0; k < 2; ++k) \
        acc[ai][bj][m][n] = __builtin_amdgcn_mfma_f32_16x16x32_bf16(Bt[n][k], At[m][k], acc[ai][bj][m][n], 0, 0, 0); __builtin_amdgcn_s_setprio(0); } while (0)
#define PG8_WAIT_V(n) asm volatile("s_waitcnt vmcnt(" #n ")" ::: "memory")
#define PG8_WAIT_L(n) asm volatile("s_waitcnt lgkmcnt(" #n ")" ::: "memory")
#define PG8_BAR __builtin_amdgcn_s_barrier()
#define PG8_SCHED __builtin_amdgcn_sched_barrier(0)
    Unit cur, nxt; int ui = 0;
    if (!S.next(0, cur)) return;
    f32x4 acc[2][2][4][2];
#pragma unroll
    for (int a = 0; a < 2; ++a)
#pragma unroll
        for (int b = 0; b < 2; ++b)
#pragma unroll
            for (int m = 0; m < 4; ++m)
#pragma unroll
                for (int n = 0; n < 2; ++n) acc[a][b][m][n] = (f32x4){0.f, 0.f, 0.f, 0.f};
    bf16x8 At[4][2], B0[2][2], B1[2][2];
    const char* cA = (const char*)g.A + (size_t)cur.pm * tstepA + (size_t)cur.ks * kslice; const char* cB = (const char*)g.Bt + (size_t)cur.pn * tstepB + (size_t)cur.ks * kslice;
    PG8_STAGE(PG8_SB(0, 0), cB, voffB); PG8_STAGE(PG8_SA(0, 0), cA, voffA); PG8_STAGE(PG8_SB(0, 1), cB + hstepB, voffB); PG8_STAGE(PG8_SA(0, 1), cA + hstepA, voffA);
    if (wr == 1) PG8_BAR;
    PG8_WAIT_V(4); PG8_BAR;
    PG8_STAGE(PG8_SB(1, 0), cB + kstep, voffB); PG8_STAGE(PG8_SA(1, 0), cA + kstep, voffA); PG8_STAGE(PG8_SB(1, 1), cB + hstepB + kstep, voffB);
    PG8_WAIT_V(6); PG8_BAR;
    for (;;) {
        const bool has_next = S.next(ui + 1, nxt);
        const char* nA = has_next ? (const char*)g.A + (size_t)nxt.pm * tstepA + (size_t)nxt.ks * kslice : cA; const char* nB = has_next ? (const char*)g.Bt + (size_t)nxt.pn * tstepB + (size_t)nxt.ks * kslice : cB;
        for (int t = 0; t < nt; t += 2) {
            const bool last = (t == nt - 2);
            const char* a1 = cA + (size_t)(t + 1) * kstep;
            const char* a2 = last ? nA : cA + (size_t)(t + 2) * kstep; const char* b2 = last ? nB : cB + (size_t)(t + 2) * kstep;
            const char* a3 = a2 + kstep; const char* b3 = b2 + kstep;
            PG8_LDB(B0, 0, 0); PG8_SCHED; PG8_LDA(At, 0, 0); PG8_STAGE(PG8_SA(1, 1), a1 + hstepA, voffA);
            PG8_WAIT_L(8); PG8_BAR; PG8_WAIT_L(0); PG8_MMA(0, 0, At, B0); PG8_BAR; PG8_SCHED;
            PG8_LDB(B1, 0, 1); PG8_STAGE(PG8_SB(0, 0), b2, voffB);
            PG8_BAR; PG8_WAIT_L(0); PG8_MMA(0, 1, At, B1); PG8_BAR;
            PG8_LDA(At, 0, 1); PG8_STAGE(PG8_SA(0, 0), a2, voffA);
            PG8_BAR; PG8_WAIT_L(0); PG8_MMA(1, 0, At, B0); PG8_BAR; PG8_SCHED;
            PG8_STAGE(PG8_SB(0, 1), b2 + hstepB, voffB);
            PG8_WAIT_V(6); PG8_BAR; PG8_MMA(1, 1, At, B1); PG8_BAR;
            PG8_LDB(B0, 1, 0); PG8_SCHED; PG8_LDA(At, 1, 0); PG8_STAGE(PG8_SA(0, 1), a2 + hstepA, voffA);
            PG8_WAIT_L(8); PG8_BAR; PG8_WAIT_L(0); PG8_MMA(0, 0, At, B0); PG8_BAR; PG8_SCHED;
            PG8_LDB(B1, 1, 1); PG8_STAGE(PG8_SB(1, 0), b3, voffB);
            PG8_BAR; PG8_WAIT_L(0); PG8_MMA(0, 1, At, B1); PG8_BAR;
            PG8_LDA(At, 1, 1); PG8_STAGE(PG8_SA(1, 0), a3, voffA);
            PG8_BAR; PG8_WAIT_L(0); PG8_MMA(1, 0, At, B0); PG8_BAR; PG8_SCHED;
            PG8_STAGE(PG8_SB(1, 1), b3 + hstepB, voffB);
            PG8_WAIT_V(6); PG8_BAR; PG8_MMA(1, 1, At, B1); PG8_BAR;
        }
        { const int t2 = opaque_tid(); E(acc, cur, wr, wc, t2 & 15, (t2 & 63) >> 4); }
        if (!has_next) break;
#pragma unroll
        for (int a = 0; a < 2; ++a)
#pragma unroll
            for (int b = 0; b < 2; ++b)
#pragma unroll
                for (int m = 0; m < 4; ++m)
#pragma unroll
                    for (int n = 0; n < 2; ++n) acc[a][b][m][n] = (f32x4){0.f, 0.f, 0.f, 0.f};
        cur = nxt; cA = nA; cB = nB; ++ui;
    }
    PG8_WAIT_V(0);
    if (wr == 0) PG8_BAR;
    PG8_BAR;
#undef PG8_SA
#undef PG8_SB
#undef PG8_STAGE
#undef PG8_LDA
#undef PG8_LDB
#undef PG8_MMA
#undef PG8_WAIT_V
#undef PG8_WAIT_L
#undef PG8_BAR
#undef PG8_SCHED
}
}
using pg8::Unit;

struct EpiSwiGLU {
    static constexpr bool PERM = true;
    bf16_t* O;
    __device__ __forceinline__ void operator()(const f32x4 (&acc)[2][2][4][2], const Unit& u, int wr, int wc, int fr, int fq) const {
        const int row0 = u.pm * 256 + wr * 64 + fr, col0 = u.pn * 128 + wc * 32 + 8 * fq;
#pragma unroll
        for (int ai = 0; ai < 2; ++ai)
#pragma unroll
            for (int m = 0; m < 4; ++m) {
                bf16_t* rowp = O + (size_t)(row0 + ai * 128 + m * 16) * DFF + col0;
                const f32x4 g0 = acc[ai][0][m][0], g1 = acc[ai][0][m][1], u0 = acc[ai][1][m][0], u1 = acc[ai][1][m][1];
                u32x4 w;
                w.x = cvt_pk_bf16(siluf_(g0[0]) * u0[0], siluf_(g0[1]) * u0[1]);
                w.y = cvt_pk_bf16(siluf_(g0[2]) * u0[2], siluf_(g0[3]) * u0[3]);
                w.z = cvt_pk_bf16(siluf_(g1[0]) * u1[0], siluf_(g1[1]) * u1[1]);
                w.w = cvt_pk_bf16(siluf_(g1[2]) * u1[2], siluf_(g1[3]) * u1[3]);
                *(u32x4*)rowp = w;
                asm volatile("" ::: "memory");
            }
    }
};
struct EpiResid {
    static constexpr bool PERM = false;
    float* xlat; float* xctx; const float* gate_l; float coef;
    __device__ __forceinline__ void operator()(const f32x4 (&acc)[2][2][4][2], const Unit& u, int wr, int wc, int fr, int fq) const {
        float* base; int mod;
        if (u.pm < 128) { base = xlat + (size_t)u.pm * 256 * 1024; mod = u.pm >> 5; } else { base = xctx + (size_t)(u.pm - 128) * 256 * 1024; mod = 4; }
        const int col0 = u.pn * 256 + wc * 32 + 4 * fq;
        const float* gp = gate_l + mod * 9216 + col0;
        float* rbase = base + (size_t)(wr * 64 + fr) * 1024 + col0;
#pragma unroll
        for (int bj = 0; bj < 2; ++bj) {
            f32x4 xv[2][2][4];
#pragma unroll
            for (int n = 0; n < 2; ++n)
#pragma unroll
                for (int ai = 0; ai < 2; ++ai)
#pragma unroll
                    for (int m = 0; m < 4; ++m) xv[n][ai][m] = *(const f32x4*)(rbase + (size_t)(ai * 128 + m * 16) * 1024 + bj * 128 + n * 16);
            const f32x4 gv0 = *(const f32x4*)(gp + bj * 128) * coef, gv1 = *(const f32x4*)(gp + bj * 128 + 16) * coef;
#pragma unroll
            for (int n = 0; n < 2; ++n)
#pragma unroll
                for (int ai = 0; ai < 2; ++ai)
#pragma unroll
                    for (int m = 0; m < 4; ++m)
                        *(f32x4*)(rbase + (size_t)(ai * 128 + m * 16) * 1024 + bj * 128 + n * 16) = xv[n][ai][m] + (n == 0 ? gv0 : gv1) * acc[ai][bj][m][n];
            asm volatile("" ::: "memory");
        }
    }
};
struct EpiSlab {
    static constexpr bool PERM = false;
    float* slab;
    __device__ __forceinline__ void operator()(const f32x4 (&acc)[2][2][4][2], const Unit& u, int wr, int wc, int fr, int fq) const {
        float* base = slab + ((size_t)u.ks * NCTX + (size_t)u.pm * 256) * 1024;
        const int col0 = u.pn * 256 + wc * 32 + 4 * fq;
#pragma unroll
        for (int ai = 0; ai < 2; ++ai)
#pragma unroll
            for (int m = 0; m < 4; ++m) {
                float* rowp = base + (size_t)(wr * 64 + fr + ai * 128 + m * 16) * 1024 + col0;
#pragma unroll
                for (int bj = 0; bj < 2; ++bj)
#pragma unroll
                    for (int n = 0; n < 2; ++n) *(f32x4*)(rowp + bj * 128 + n * 16) = acc[ai][bj][m][n];
                asm volatile("" ::: "memory");
            }
    }
};
struct EpiInProj {
    static constexpr bool PERM = true;
    bf16_t* Pb; float* Pg;
    __device__ __forceinline__ void operator()(const f32x4 (&acc)[2][2][4][2], const Unit& u, int wr, int wc, int fr, int fq) const {
        const int row0 = u.pm * 256 + wr * 64 + fr;
#pragma unroll
        for (int bj = 0; bj < 2; ++bj) {
            const int c0 = u.pn * 256 + bj * 128 + wc * 32 + 8 * fq;
            int gi = -1;
            if (c0 >= 1024 && c0 < 1056) gi = c0 - 1024; else if (c0 >= 1824 && c0 < 1832) gi = 32 + c0 - 1824; else if (c0 >= 2856 && c0 < 2872) gi = 64 + c0 - 2856;
#pragma unroll
            for (int ai = 0; ai < 2; ++ai)
#pragma unroll
                for (int m = 0; m < 4; ++m) {
                    const size_t row = (size_t)(row0 + ai * 128 + m * 16);
                    const f32x4 v0 = acc[ai][bj][m][0], v1 = acc[ai][bj][m][1];
                    u32x4 w; w.x = cvt_pk_bf16(v0[0], v0[1]); w.y = cvt_pk_bf16(v0[2], v0[3]); w.z = cvt_pk_bf16(v1[0], v1[1]); w.w = cvt_pk_bf16(v1[2], v1[3]);
                    *(u32x4*)(Pb + row * NINP + c0) = w;
                    if (gi >= 0) { *(f32x4*)(Pg + row * PGW + gi) = v0; *(f32x4*)(Pg + row * PGW + gi + 4) = v1; }
                    asm volatile("" ::: "memory");
                }
        }
    }
};
struct EpiGLU {
    static constexpr bool PERM = true;
    const bf16_t* G; const float* bglu; bf16_t* O;
    __device__ __forceinline__ void operator()(const f32x4 (&acc)[2][2][4][2], const Unit& u, int wr, int wc, int fr, int fq) const {
        const int row0 = u.pm * 256 + wr * 64 + fr;
#pragma unroll
        for (int bj = 0; bj < 2; ++bj) {
            const int c0 = bj * 128 + wc * 32 + 8 * fq;
            const f32x4 bb0 = *(const f32x4*)(bglu + c0), bb1 = *(const f32x4*)(bglu + c0 + 4);
            u32x4 gw[2][4];
#pragma unroll
            for (int ai = 0; ai < 2; ++ai)
#pragma unroll
                for (int m = 0; m < 4; ++m) gw[ai][m] = *(const u32x4*)(G + (size_t)(row0 + ai * 128 + m * 16) * 256 + c0);
#pragma unroll
            for (int ai = 0; ai < 2; ++ai)
#pragma unroll
                for (int m = 0; m < 4; ++m) {
                    const size_t row = (size_t)(row0 + ai * 128 + m * 16);
                    const f32x4 v0 = acc[ai][bj][m][0] + bb0, v1 = acc[ai][bj][m][1] + bb1; const u32x4 g4 = gw[ai][m];
                    u32x4 w;
                    w.x = cvt_pk_bf16(bflo(g4.x) * sigmoidf_(v0[0]), bfhi(g4.x) * sigmoidf_(v0[1]));
                    w.y = cvt_pk_bf16(bflo(g4.y) * sigmoidf_(v0[2]), bfhi(g4.y) * sigmoidf_(v0[3]));
                    w.z = cvt_pk_bf16(bflo(g4.z) * sigmoidf_(v1[0]), bfhi(g4.z) * sigmoidf_(v1[1]));
                    w.w = cvt_pk_bf16(bflo(g4.w) * sigmoidf_(v1[2]), bfhi(g4.w) * sigmoidf_(v1[3]));
                    *(u32x4*)(O + row * 1024 + 768 + c0) = w;
                }
            asm volatile("" ::: "memory");
        }
    }
};

__device__ __forceinline__ void phase_mods(CPR P, lds_t lds) {
    const int tid = opaque_tid();
    LAS float* sc = (LAS float*)lds;
    LAS float* red = sc + 5120;
    const float* c = P.in[I_C]; const float* cc = P.in[I_CCTX]; const float* wmod = P.in[I_WMOD]; const float* bmod = P.in[I_BMOD];
    float* mods = (float*)(P.ws + WS_MODS);
    for (int i = tid; i < 5120; i += 512) { const int v = i >> 10, k = i & 1023; const float x = v < 4 ? c[v * 1024 + k] : cc[k]; sc[i] = siluf_(x); }
    __syncthreads();
    for (int item = blockIdx.x; item < 288; item += gridDim.x) {
        const int l = item / 72, col0 = (item % 72) * 128, c4 = (tid & 31) * 4, kg = tid >> 5;
        f32x4 acc[5];
#pragma unroll
        for (int v = 0; v < 5; ++v) acc[v] = (f32x4){0.f, 0.f, 0.f, 0.f};
        const float* wp = wmod + ((size_t)l * 1024 + kg * 64) * 9216 + col0 + c4;
#pragma unroll 8
        for (int kk = 0; kk < 64; ++kk) {
            const f32x4 w = *(const f32x4*)(wp + (size_t)kk * 9216);
#pragma unroll
            for (int v = 0; v < 5; ++v) { const float s = sc[v * 1024 + kg * 64 + kk]; acc[v] += w * s; }
        }
#pragma unroll
        for (int v = 0; v < 5; ++v) *(LAS f32x4*)(red + (kg * 5 + v) * 128 + c4) = acc[v];
        __syncthreads();
        for (int o = tid; o < 640; o += 512) {
            const int v = o >> 7, cx = o & 127; float s = 0.f;
#pragma unroll
            for (int k2 = 0; k2 < 16; ++k2) s += red[(k2 * 5 + v) * 128 + cx];
            mods[(size_t)(l * 5 + v) * 9216 + col0 + cx] = s + bmod[l * 9216 + col0 + cx];
        }
        __syncthreads();
    }
}

__device__ __forceinline__ void conv_tile(const float* src, int src_ld, int col0, int ncv, int k0, bf16_t* dst, int dst_ld, int drow0, LAS float* tile) {
    const int tid = opaque_tid();
    { const int r = tid >> 4, c4 = (tid & 15) * 4;
#pragma unroll
      for (int i = 0; i < 2; ++i) { const int k = r + 32 * i; f32x4 v = (f32x4){0.f, 0.f, 0.f, 0.f};
          if (c4 < ncv) v = *(const f32x4*)(src + (size_t)(k0 + k) * src_ld + col0 + c4);
          tile[k * 65 + c4 + 0] = v[0]; tile[k * 65 + c4 + 1] = v[1]; tile[k * 65 + c4 + 2] = v[2]; tile[k * 65 + c4 + 3] = v[3]; } }
    __syncthreads();
    { const int n = tid >> 3, k8 = (tid & 7) * 8; u32x4 w;
      w.x = cvt_pk_bf16(tile[(k8 + 0) * 65 + n], tile[(k8 + 1) * 65 + n]); w.y = cvt_pk_bf16(tile[(k8 + 2) * 65 + n], tile[(k8 + 3) * 65 + n]);
      w.z = cvt_pk_bf16(tile[(k8 + 4) * 65 + n], tile[(k8 + 5) * 65 + n]); w.w = cvt_pk_bf16(tile[(k8 + 6) * 65 + n], tile[(k8 + 7) * 65 + n]);
      *(u32x4*)(dst + (size_t)(drow0 + n) * dst_ld + k0 + k8) = w; }
    __syncthreads();
}
__device__ __forceinline__ void phase_convert(CPR P, lds_t lds, int l, int b0, int nb) {
    LAS float* tile = (LAS float*)lds;
    constexpr int PER_LAYER = 2 * 1408 + 2 * 704 + 832 + 256 + 16;
    for (int idx = (int)blockIdx.x - b0; idx < PER_LAYER; idx += nb) {
        int t = idx;
        if (t < 2816) {
            const int s = t / 1408; t %= 1408; const int rt = t >> 4, kt = t & 15, drow0 = rt * 64, t256 = drow0 >> 8, cc = drow0 & 255, j0 = t256 * 128 + (cc & 127);
            const int scol = (cc < 128) ? j0 : DFF + j0;
            conv_tile(P.in[I_FFNWIN] + (size_t)(l * 2 + s) * 1024 * 5632, 5632, scol, 64, kt * 64, (bf16_t*)(P.ws + WS_WFI) + (size_t)(l * 2 + s) * 5632 * 1024, 1024, drow0, tile);
        } else if (t < 4224) {
            t -= 2816; const int s = t / 704; t %= 704; const int rt = t / 44, kt = t % 44;
            conv_tile(P.in[I_FFNWOUT] + (size_t)(l * 2 + s) * DFF * 1024, 1024, rt * 64, 64, kt * 64, (bf16_t*)(P.ws + WS_WFO) + (size_t)(l * 2 + s) * 1024 * DFF, DFF, rt * 64, tile);
        } else if (t < 5056) {
            t -= 4224; const int rt = t >> 4, kt = t & 15;
            conv_tile(P.in[I_WIN] + (size_t)l * 1024 * NIN, NIN, rt * 64, NIN - rt * 64, kt * 64, (bf16_t*)(P.ws + WS_WIN) + (size_t)l * NINP * 1024, 1024, rt * 64, tile);
        } else if (t < 5312) {
            t -= 5056; const int rt = t >> 4, kt = t & 15;
            conv_tile(P.in[I_WOUT] + (size_t)l * 1024 * 1024, 1024, rt * 64, 64, kt * 64, (bf16_t*)(P.ws + WS_WOUT) + (size_t)l * 1024 * 1024, 1024, rt * 64, tile);
        } else {
            t -= 5312; const int rt = t >> 2, kt = t & 3;
            conv_tile(P.in[I_S5WGLU] + (size_t)l * 256 * 256, 256, rt * 64, 64, kt * 64, (bf16_t*)(P.ws + WS_WGLU) + (size_t)l * 256 * 256, 256, rt * 64, tile);
        }
    }
}

template <int CTRL> __device__ __forceinline__ float dpp_mov(float x) { return __int_as_float(__builtin_amdgcn_update_dpp(0, __float_as_int(x), CTRL, 0xf, 0xf, false)); }
__device__ __forceinline__ float wave_scan_add(float x, int lane) {
    const int rl = lane & 15; float t;
    t = dpp_mov<0x111>(x) + x; if (rl >= 1) x = t;
    t = dpp_mov<0x112>(x) + x; if (rl >= 2) x = t;
    t = dpp_mov<0x114>(x) + x; if (rl >= 4) x = t;
    t = dpp_mov<0x118>(x) + x; if (rl >= 8) x = t;
    t = dpp_mov<0x142>(x) + x; if ((lane & 31) >= 16) x = t;
    t = dpp_mov<0x143>(x) + x; if (lane >= 32) x = t;
    return x;
}
__device__ __forceinline__ float wave_scan_max(float x, int lane) {
    const int rl = lane & 15; float t;
    t = fmaxf(dpp_mov<0x111>(x), x); if (rl >= 1) x = t;
    t = fmaxf(dpp_mov<0x112>(x), x); if (rl >= 2) x = t;
    t = fmaxf(dpp_mov<0x114>(x), x); if (rl >= 4) x = t;
    t = fmaxf(dpp_mov<0x118>(x), x); if (rl >= 8) x = t;
    t = fmaxf(dpp_mov<0x142>(x), x); if ((lane & 31) >= 16) x = t;
    t = fmaxf(dpp_mov<0x143>(x), x); if (lane >= 32) x = t;
    return x;
}

__device__ __forceinline__ float row16_sum(float s) { s += dpp_mov<0xB1>(s); s += dpp_mov<0x4E>(s); s += dpp_mov<0x124>(s); s += dpp_mov<0x128>(s); return s; }
__device__ __forceinline__ float wave_sum(float s) { s = row16_sum(s);
    const int si = __float_as_int(s);
    return __int_as_float(__builtin_amdgcn_readlane(si, 0)) + __int_as_float(__builtin_amdgcn_readlane(si, 16)) + __int_as_float(__builtin_amdgcn_readlane(si, 32)) + __int_as_float(__builtin_amdgcn_readlane(si, 48)); }

__device__ __forceinline__ void phase_modnorm(CPR P, int l, int j, bool first) {
    const int jp = (j + 2) % 3, lp = (j == 0) ? l - 1 : l, nks = first ? 0 : (jp == 1 ? 4 : 11); const float coefp = (jp == 1) ? 1.0f : 0.5f;
    const float* slab = (const float*)(P.ws + WS_SLAB);
    const float* gatep = (const float*)(P.ws + WS_MODS) + (size_t)(lp < 0 ? 0 : lp) * 5 * 9216 + 4 * 9216 + (3 * jp + 2) * 1024;
    const int tid_ = opaque_tid(); const int lane = tid_ & 63, wid = tid_ >> 6;
    const float* mods_l = (const float*)(P.ws + WS_MODS) + (size_t)l * 5 * 9216;
    const float* gn = P.in[I_GNORM] + (size_t)(l * 3 + j) * 1024;
    float* xctx = (float*)(P.ws + WS_CTXX);
    bf16_t* H = (bf16_t*)(P.ws + WS_H);
    const float* xlat_src = first ? P.in[I_X] : P.out; const float* xctx_src = first ? P.in[I_CTX] : xctx;
    f32x4 gv[4], sh[4], scl[4], xn[4];
#pragma unroll
    for (int i = 0; i < 4; ++i) { gv[i] = *(const f32x4*)(gn + lane * 4 + 256 * i); sh[i] = gv[i]; scl[i] = gv[i]; xn[i] = gv[i]; }
    const int stride = gridDim.x * 8; int row = blockIdx.x * 8 + wid; int curmod = -1;
#define MN_LOAD(r_) do { const float* s_ = ((r_) < NLAT) ? xlat_src + (size_t)(r_) * 1024 : xctx_src + (size_t)((r_) - NLAT) * 1024; \
        _Pragma("unroll") for (int i_ = 0; i_ < 4; ++i_) xn[i_] = *(const f32x4*)(s_ + lane * 4 + 256 * i_); } while (0)
    if (row < NT) MN_LOAD(row);
    for (; row < NT; row += stride) {
        float* dst; int mod;
        if (row < NLAT) { dst = P.out + (size_t)row * 1024; mod = row >> 13; } else { dst = xctx + (size_t)(row - NLAT) * 1024; mod = 4; }
        f32x4 xv[4];
#pragma unroll
        for (int i = 0; i < 4; ++i) xv[i] = xn[i];
        if (row + stride < NT) MN_LOAD(row + stride);
        if (row >= NLAT && nks > 0) {
#pragma unroll
            for (int i = 0; i < 4; ++i) {
                f32x4 s = (f32x4){0.f, 0.f, 0.f, 0.f};
                for (int ks = 0; ks < nks; ++ks) s += *(const f32x4*)(slab + ((size_t)ks * NCTX + (row - NLAT)) * 1024 + lane * 4 + 256 * i);
                xv[i] += *(const f32x4*)(gatep + lane * 4 + 256 * i) * coefp * s;
                *(f32x4*)(dst + lane * 4 + 256 * i) = xv[i];
            }
        }
        float ss = 0.f;
#pragma unroll
        for (int i = 0; i < 4; ++i) ss += xv[i][0] * xv[i][0] + xv[i][1] * xv[i][1] + xv[i][2] * xv[i][2] + xv[i][3] * xv[i][3];
        if (first) {
#pragma unroll
            for (int i = 0; i < 4; ++i) *(f32x4*)(dst + lane * 4 + 256 * i) = xv[i];
        }
        if (mod != curmod) {
            const float* mp = mods_l + (size_t)mod * 9216 + (3 * j) * 1024;
#pragma unroll
            for (int i = 0; i < 4; ++i) { sh[i] = *(const f32x4*)(mp + lane * 4 + 256 * i); scl[i] = *(const f32x4*)(mp + 1024 + lane * 4 + 256 * i) + 1.0f; }
            curmod = mod;
        }
        const float rstd = rsqrtf(wave_sum(ss) * (1.0f / 1024.0f) + EPS);
#pragma unroll
        for (int i = 0; i < 4; ++i) {
            const f32x4 hv = xv[i] * rstd * gv[i] * scl[i] + sh[i];
            u32x2 w; w.x = cvt_pk_bf16(hv[0], hv[1]); w.y = cvt_pk_bf16(hv[2], hv[3]);
            *(u32x2*)(H + (size_t)row * 1024 + lane * 4 + 256 * i) = w;
        }
    }
#undef MN_LOAD
}
__device__ __forceinline__ void phase_final(CPR P) {
    const int tid_ = opaque_tid(); const int lane = tid_ & 63, wid = tid_ >> 6;
    const float* gn = P.in[I_GFINAL];
    f32x4 gv[4];
#pragma unroll
    for (int i = 0; i < 4; ++i) gv[i] = *(const f32x4*)(gn + lane * 4 + 256 * i);
    for (int row = blockIdx.x * 8 + wid; row < NLAT; row += gridDim.x * 8) {
        float* p = P.out + (size_t)row * 1024;
        f32x4 xv[4]; float ss = 0.f;
#pragma unroll
        for (int i = 0; i < 4; ++i) { xv[i] = *(const f32x4*)(p + lane * 4 + 256 * i); ss += xv[i][0] * xv[i][0] + xv[i][1] * xv[i][1] + xv[i][2] * xv[i][2] + xv[i][3] * xv[i][3]; }
        const float rstd = rsqrtf(wave_sum(ss) * (1.0f / 1024.0f) + EPS);
#pragma unroll
        for (int i = 0; i < 4; ++i) *(f32x4*)(p + lane * 4 + 256 * i) = xv[i] * rstd * gv[i];
    }
}

__device__ __forceinline__ void scan_gla(CPR P, int l, int b, int h, int dir, lds_t lds) {
    const int tid = opaque_tid(), lane = tid & 63, wid = tid >> 6, fr = lane & 15, fq = lane >> 4;
    const bf16_t* PB = (const bf16_t*)(P.ws + WS_PB); const float* PG = (const float*)(P.ws + WS_PG);
    bf16_t* OUT = (bf16_t*)(P.ws + (dir ? WS_H2 : WS_H));
    lds_t QR = lds, KR = lds + 9216, VT = lds + 18432, QT = lds + 27648, KT = lds + 36864, KWT = lds + 46080, ATT = lds + 55296, ST = lds + 64512;
    LAS float* LR = (LAS float*)(lds + 73728); LAS float* TOT = (LAS float*)(lds + 77824); LAS float* DEC = (LAS float*)(lds + 79872);
    const int d = tid & 63, o = tid >> 6;
    float wreg[16];
#pragma unroll
    for (int r = 0; r < 16; ++r) wreg[r] = P.in[I_GLAW][(size_t)((l * 2 + dir) * 16 + r) * 256 + h * 64 + d];
    const float bias = P.in[I_GLAB][(l * 2 + dir) * 256 + h * 64 + d];
    for (int i = tid; i < 9216 / 4; i += 512) ((LAS unsigned*)ST)[i] = 0u;
    f32x4 sacc[2] = {(f32x4){0.f, 0.f, 0.f, 0.f}, (f32x4){0.f, 0.f, 0.f, 0.f}};
    const int tm = wid >> 1, tn0 = (wid & 1) * 2;
    __syncthreads();
    u32x4 q8, k8, v8; f32x4 lr4 = (f32x4){0.f, 0.f, 0.f, 0.f};
#define GLA_ISSUE(cc_) do { const int sg_ = (cc_) >= 4, c_ = sg_ ? (cc_) - 4 : (cc_), L_ = sg_ ? SEQ : CTXL; const int t_ = tid >> 3, c8_ = tid & 7; const int lp_ = c_ * 64 + t_, p_ = dir ? (L_ - 1 - lp_) : lp_; \
        const bf16_t* pr_ = PB + (size_t)tok_row(sg_, b, p_, false) * NINP + h * 64 + c8_ * 8; \
        q8 = *(const u32x4*)(pr_ + GLA_Q); k8 = *(const u32x4*)(pr_ + GLA_K); v8 = *(const u32x4*)(pr_ + GLA_V); \
        { const int t2_ = (tid & 255) >> 2, r4_ = tid & 3; const int lp2_ = c_ * 64 + t2_, p2_ = dir ? (L_ - 1 - lp2_) : lp2_; \
            lr4 = *(const f32x4*)(PG + (size_t)tok_row(sg_, b, p2_, false) * PGW + dir * 16 + r4_ * 4); } } while (0)
    GLA_ISSUE(0);
#pragma unroll 1
    for (int cc = 0; cc < 132; ++cc) {
        {
            const int seg = cc >= 4, c = seg ? cc - 4 : cc, L = seg ? SEQ : CTXL;
            asm volatile("s_waitcnt vmcnt(0)" ::: "memory");
            {
                const int t = tid >> 3, c8 = tid & 7;
                *(LAS u32x4*)(QR + t * LDT + c8 * 16) = q8; *(LAS u32x4*)(KR + t * LDT + c8 * 16) = k8;
#pragma unroll
                for (int i = 0; i < 4; ++i) { *(LAS bf16_t*)(VT + (c8 * 8 + 2 * i) * LDT + t * 2) = (bf16_t)(v8[i] & 0xffffu); *(LAS bf16_t*)(VT + (c8 * 8 + 2 * i + 1) * LDT + t * 2) = (bf16_t)(v8[i] >> 16); }
                if (tid < 256) { const int t2 = tid >> 2, r4 = tid & 3; *(LAS f32x4*)(LR + t2 * 16 + r4 * 4) = lr4; }
            }
            __syncthreads();
            if (cc + 1 < 132) GLA_ISSUE(cc + 1);
            float bl[8]; float run = 0.f;
#pragma unroll
            for (int i = 0; i < 8; ++i) {
                const int t = o * 8 + i; float dot = bias;
#pragma unroll
                for (int r4 = 0; r4 < 4; ++r4) { const f32x4 x = *(const LAS f32x4*)(LR + t * 16 + r4 * 4); dot += x[0] * wreg[4 * r4] + x[1] * wreg[4 * r4 + 1] + x[2] * wreg[4 * r4 + 2] + x[3] * wreg[4 * r4 + 3]; }
                run += logsigf_(dot) * (1.0f / 16.0f); bl[i] = run;
            }
            TOT[o * 64 + d] = run;
            __syncthreads();
            {
                float pre = 0.f, tot = 0.f;
#pragma unroll
                for (int o2 = 0; o2 < 8; ++o2) { const float v = TOT[o2 * 64 + d]; if (o2 < o) pre += v; tot += v; }
                float kw[8]; const float et = __expf(tot);
#pragma unroll
                for (int i = 0; i < 8; ++i) {
                    const int t = o * 8 + i; const float bb = pre + bl[i]; const float enb = __expf(-bb);
                    const float qv = bf2f(*(const LAS bf16_t*)(QR + t * LDT + d * 2)), kv = bf2f(*(const LAS bf16_t*)(KR + t * LDT + d * 2));
                    *(LAS bf16_t*)(QT + t * LDT + d * 2) = f2bf(qv * 0.125f * __expf(bb));
                    *(LAS bf16_t*)(KT + t * LDT + d * 2) = f2bf(kv * enb);
                    kw[i] = kv * (et * enb);
                }
                u32x4 w; w.x = cvt_pk_bf16(kw[0], kw[1]); w.y = cvt_pk_bf16(kw[2], kw[3]); w.z = cvt_pk_bf16(kw[4], kw[5]); w.w = cvt_pk_bf16(kw[6], kw[7]);
                *(LAS u32x4*)(KWT + d * LDT + o * 16) = w;
                if (o == 0) DEC[d] = et;
            }
            __syncthreads();
            f32x4 oacc[2];
#pragma unroll
            for (int i = 0; i < 2; ++i) {
                const int tn = tn0 + i; f32x4 a = (f32x4){0.f, 0.f, 0.f, 0.f};
                mma_tile<true, 2, LDT, LDT>(a, QT, tm * 16, KT, tn * 16, fr, fq);
                const int t = tm * 16 + fr, s0 = tn * 16 + fq * 4;
#pragma unroll
                for (int jx = 0; jx < 4; ++jx) a[jx] = (s0 + jx <= t) ? a[jx] : 0.f;
                u32x2 w; w.x = cvt_pk_bf16(a[0], a[1]); w.y = cvt_pk_bf16(a[2], a[3]);
                *(LAS u32x2*)(ATT + t * LDT + s0 * 2) = w;
                oacc[i] = (f32x4){0.f, 0.f, 0.f, 0.f};
                mma_tile<true, 2, LDT, LDT>(oacc[i], QT, tm * 16, ST, tn * 16, fr, fq);
            }
            __syncthreads();
            {
                const int t = tm * 16 + fr; const int lp = c * 64 + t, p = dir ? (L - 1 - lp) : lp;
                bf16_t* orow = OUT + (size_t)tok_row(seg, b, p, false) * 1024 + 0 + h * 64;
#pragma unroll
                for (int i = 0; i < 2; ++i) {
                    const int tn = tn0 + i;
                    mma_tile<true, 2, LDT, LDT>(oacc[i], ATT, tm * 16, VT, tn * 16, fr, fq);
                    u32x2 w; w.x = cvt_pk_bf16(oacc[i][0], oacc[i][1]); w.y = cvt_pk_bf16(oacc[i][2], oacc[i][3]);
                    *(u32x2*)(orow + tn * 16 + fq * 4) = w;
                }
                const f32x4 dv = *(const LAS f32x4*)(DEC + tm * 16 + fq * 4);
#pragma unroll
                for (int i = 0; i < 2; ++i) {
                    const int tn = tn0 + i;
                    sacc[i] *= dv;
                    mma_tile<false, 2, LDT, LDT>(sacc[i], KWT, tm * 16, VT, tn * 16, fr, fq);
                    u32x2 w; w.x = cvt_pk_bf16(sacc[i][0], sacc[i][1]); w.y = cvt_pk_bf16(sacc[i][2], sacc[i][3]);
                    *(LAS u32x2*)(ST + (tn * 16 + fr) * LDT + (tm * 16 + fq * 4) * 2) = w;
                }
            }
            __syncthreads();
        }
    }
}

__device__ __forceinline__ void scan_ssd(CPR P, int l, int b, int h, int dir, lds_t lds) {
    const int tid = opaque_tid(), lane = tid & 63, wid = tid >> 6, fr = lane & 15, fq = lane >> 4;
    const bf16_t* PB = (const bf16_t*)(P.ws + WS_PB); const float* PG = (const float*)(P.ws + WS_PG);
    bf16_t* OUT = (bf16_t*)(P.ws + (dir ? WS_H2 : WS_H));
    lds_t CM = lds, BM = lds + 9216, XT = lds + 18432, BWT = lds + 27648, SC = lds + 36864, ST = lds + 46080, XS = lds + 55296, RAW = lds + 64512;
    LAS float* CUM = (LAS float*)(lds + 90912); LAS float* DTV = (LAS float*)(lds + 91168); LAS float* EWV = (LAS float*)(lds + 91424);
    constexpr int RS = 400;
    const int d = tid & 63, o = tid >> 6, g2 = h >> 1;
    const float* cw = P.in[I_SSDCW] + (size_t)l * 3 * 512; const float* cb = P.in[I_SSDCB] + (size_t)l * 512;
    const int chv[3] = {h * 64 + d, 256 + g2 * 64 + d, 384 + g2 * 64 + d};
    float w0[3], w1[3], w2[3], wb[3];
#pragma unroll
    for (int g = 0; g < 3; ++g) { w0[g] = cw[(dir ? 2 : 0) * 512 + chv[g]]; w1[g] = cw[512 + chv[g]]; w2[g] = cw[(dir ? 0 : 2) * 512 + chv[g]]; wb[g] = cb[chv[g]]; }
    const float dtb = P.in[I_SSDDTB][(l * 2 + dir) * 4 + h], nega = -__expf(P.in[I_SSDALOG][(l * 2 + dir) * 4 + h]), dsk = P.in[I_SSDD][l * 4 + h]; const float dskv = dir == 0 ? dsk : 0.f;
    for (int i = tid; i < 9216 / 4; i += 512) ((LAS unsigned*)ST)[i] = 0u;
    f32x4 sacc[2] = {(f32x4){0.f, 0.f, 0.f, 0.f}, (f32x4){0.f, 0.f, 0.f, 0.f}};
    const int tm = wid >> 1, tn0 = (wid & 1) * 2;
    __syncthreads();
    u32x4 rw[4]; float dtraw = 0.f;
#define SSD_LD(dst_, lp_) do { int lpp_ = (lp_); lpp_ = lpp_ < 0 ? 0 : (lpp_ >= L_ ? L_ - 1 : lpp_); const int p_ = dir ? (L_ - 1 - lpp_) : lpp_; \
        const int col_ = cgp_ == 0 ? SSD_X + h * 64 : (cgp_ == 1 ? SSD_B + g2 * 64 : SSD_C + g2 * 64); dst_ = *(const u32x4*)(PB + (size_t)tok_row(sg_, b, p_, true) * NINP + col_ + c8_ * 8); } while (0)
#define SSD_ISSUE(cc_) do { const int sg_ = (cc_) >= 4, c_ = sg_ ? (cc_) - 4 : (cc_), L_ = sg_ ? SEQ : CTXL; \
        _Pragma("unroll") for (int k_ = 0; k_ < 3; ++k_) { const int idx_ = tid + 512 * k_; const int rr_ = idx_ / 24, rem_ = idx_ % 24, cgp_ = rem_ >> 3, c8_ = rem_ & 7; SSD_LD(rw[k_], c_ * 64 + rr_); } \
        { const int th_ = tid % 48; const int rr_ = th_ / 24, rem_ = th_ % 24, cgp_ = rem_ >> 3, c8_ = rem_ & 7; SSD_LD(rw[3], c_ * 64 + (rr_ ? 64 : -1)); } \
        { const int lp_ = c_ * 64 + lane, p_ = dir ? (L_ - 1 - lp_) : lp_; dtraw = PG[(size_t)tok_row(sg_, b, p_, true) * PGW + 32 + dir * 4 + h]; } } while (0)
    SSD_ISSUE(0);
#pragma unroll 1
    for (int cc = 0; cc < 132; ++cc) {
        {
            const int seg = cc >= 4, c = seg ? cc - 4 : cc, L = seg ? SEQ : CTXL;
            asm volatile("s_waitcnt vmcnt(0)" ::: "memory");
            {
#pragma unroll
                for (int k = 0; k < 3; ++k) { const int idx = tid + 512 * k; const int rr = idx / 24, rem = idx % 24, cgp = rem >> 3, c8 = rem & 7; *(LAS u32x4*)(RAW + (rr + 1) * RS + cgp * 128 + c8 * 16) = rw[k]; }
                if (tid < 48) { const int rr = tid / 24, rem = tid % 24, cgp = rem >> 3, c8 = rem & 7; const int lph = c * 64 + (rr ? 64 : -1);
                    *(LAS u32x4*)(RAW + (rr ? 65 : 0) * RS + cgp * 128 + c8 * 16) = (lph >= 0 && lph < L) ? rw[3] : (u32x4){0u, 0u, 0u, 0u}; }
            }
            if (wid == 0) { const float dt = softplusf_(dtraw + dtb);
                const float cum = wave_scan_add(dt * nega, lane); DTV[lane] = dt; CUM[lane] = cum;
                const float clv = __int_as_float(__builtin_amdgcn_readlane(__float_as_int(cum), 63)); EWV[lane] = __expf(clv - cum); }
            __syncthreads();
            if (cc + 1 < 132) SSD_ISSUE(cc + 1);
            {
                const float cl = CUM[63];
                float xt[8], bw[8];
#pragma unroll
                for (int g = 0; g < 3; ++g) {
                    float prev = bf2f(*(const LAS bf16_t*)(RAW + (o * 8 + 0) * RS + g * 128 + d * 2)), cur = bf2f(*(const LAS bf16_t*)(RAW + (o * 8 + 1) * RS + g * 128 + d * 2));
#pragma unroll
                    for (int i = 0; i < 8; ++i) {
                        const int t = o * 8 + i; const float nxt = bf2f(*(const LAS bf16_t*)(RAW + (t + 2) * RS + g * 128 + d * 2)); const float dtv_ = DTV[t], ewv_ = EWV[t];
                        const float v = siluf_(w0[g] * prev + w1[g] * cur + w2[g] * nxt + wb[g]); prev = cur; cur = nxt;
                        if (g == 0) { *(LAS bf16_t*)(XS + t * LDT + d * 2) = f2bf(v); xt[i] = v * dtv_; }
                        else if (g == 1) { *(LAS bf16_t*)(BM + t * LDT + d * 2) = f2bf(v); bw[i] = v * ewv_; }
                        else { *(LAS bf16_t*)(CM + t * LDT + d * 2) = f2bf(v); }
                    }
                }
                u32x4 w; w.x = cvt_pk_bf16(xt[0], xt[1]); w.y = cvt_pk_bf16(xt[2], xt[3]); w.z = cvt_pk_bf16(xt[4], xt[5]); w.w = cvt_pk_bf16(xt[6], xt[7]);
                *(LAS u32x4*)(XT + d * LDT + o * 16) = w;
                w.x = cvt_pk_bf16(bw[0], bw[1]); w.y = cvt_pk_bf16(bw[2], bw[3]); w.z = cvt_pk_bf16(bw[4], bw[5]); w.w = cvt_pk_bf16(bw[6], bw[7]);
                *(LAS u32x4*)(BWT + d * LDT + o * 16) = w;
            }
            __syncthreads();
            f32x4 yacc[2];
            {
                const int t = tm * 16 + fr; const float ct = CUM[t]; const float ect = __expf(ct);
#pragma unroll
                for (int i = 0; i < 2; ++i) {
                    const int tn = tn0 + i; f32x4 a = (f32x4){0.f, 0.f, 0.f, 0.f};
                    mma_tile<true, 2, LDT, LDT>(a, CM, tm * 16, BM, tn * 16, fr, fq);
                    const int s0 = tn * 16 + fq * 4; const f32x4 cs = *(const LAS f32x4*)(CUM + s0);
#pragma unroll
                    for (int jx = 0; jx < 4; ++jx) a[jx] = (s0 + jx <= t) ? a[jx] * __expf(ct - cs[jx]) : 0.f;
                    u32x2 w; w.x = cvt_pk_bf16(a[0], a[1]); w.y = cvt_pk_bf16(a[2], a[3]);
                    *(LAS u32x2*)(SC + t * LDT + s0 * 2) = w;
                    yacc[i] = (f32x4){0.f, 0.f, 0.f, 0.f};
                    mma_tile<true, 2, LDT, LDT>(yacc[i], CM, tm * 16, ST, tn * 16, fr, fq);
                    yacc[i] *= ect;
                }
            }
            __syncthreads();
            {
                const int t = tm * 16 + fr; const int lp = c * 64 + t, p = dir ? (L - 1 - lp) : lp;
                bf16_t* orow = OUT + (size_t)tok_row(seg, b, p, true) * 1024 + 256 + h * 64;
#pragma unroll
                for (int i = 0; i < 2; ++i) {
                    const int tn = tn0 + i, p0 = tn * 16 + fq * 4;
                    mma_tile<true, 2, LDT, LDT>(yacc[i], SC, tm * 16, XT, tn * 16, fr, fq);
                    {
                        const u32x2 xs = *(const LAS u32x2*)(XS + t * LDT + p0 * 2);
                        yacc[i][0] += dskv * bflo(xs.x); yacc[i][1] += dskv * bfhi(xs.x); yacc[i][2] += dskv * bflo(xs.y); yacc[i][3] += dskv * bfhi(xs.y); }
                    u32x2 w; w.x = cvt_pk_bf16(yacc[i][0], yacc[i][1]); w.y = cvt_pk_bf16(yacc[i][2], yacc[i][3]);
                    *(u32x2*)(orow + p0) = w;
                }
                const float ecl_in = CUM[63]; const float ecl = __expf(ecl_in);
#pragma unroll
                for (int i = 0; i < 2; ++i) {
                    const int tn = tn0 + i;
                    sacc[i] *= ecl;
                    mma_tile<false, 2, LDT, LDT>(sacc[i], BWT, tm * 16, XT, tn * 16, fr, fq);
                    u32x2 w; w.x = cvt_pk_bf16(sacc[i][0], sacc[i][1]); w.y = cvt_pk_bf16(sacc[i][2], sacc[i][3]);
                    *(LAS u32x2*)(ST + (tn * 16 + fr) * LDT + (tm * 16 + fq * 4) * 2) = w;
                }
            }
            __syncthreads();
        }
    }
}

__device__ __forceinline__ void scan_mlstm(CPR P, int l, int b, int h, int dir, lds_t lds) {
    const int tid = opaque_tid(), lane = tid & 63, wid = tid >> 6, fr = lane & 15, fq = lane >> 4;
    const bf16_t* PB = (const bf16_t*)(P.ws + WS_PB); const float* PG = (const float*)(P.ws + WS_PG);
    bf16_t* OUT = (bf16_t*)(P.ws + (dir ? WS_H2 : WS_H));
    lds_t QM = lds, KM = lds + 9216, KWT = lds + 18432, WM = lds + 27648, VT = lds + 36864, CT = lds + 48384, RAW = lds + 59904;
    LAS float* FV = (LAS float*)(lds + 77856); LAS float* AV = (LAS float*)(lds + 78112); LAS float* MV = (LAS float*)(lds + 78368); LAS float* DEN = (LAS float*)(lds + 78624); LAS float* KWE = (LAS float*)(lds + 79648);
    constexpr int RS = 272;
    const int d = tid & 63, o = tid >> 6;
    const float* cw = P.in[I_MLCW] + (size_t)l * 3 * 512; const float* cb = P.in[I_MLCB] + (size_t)l * 512;
    const int chv[2] = {h * 64 + d, 256 + h * 64 + d};
    float w0[2], w1[2], w2[2], wb[2];
#pragma unroll
    for (int g = 0; g < 2; ++g) { w0[g] = cw[(dir ? 2 : 0) * 512 + chv[g]]; w1[g] = cw[512 + chv[g]]; w2[g] = cw[(dir ? 0 : 2) * 512 + chv[g]]; wb[g] = cb[chv[g]]; }
    const float gbi = P.in[I_MLGB][l * 16 + dir * 8 + h], gbf = P.in[I_MLGB][l * 16 + dir * 8 + 4 + h];
    for (int i = tid; i < 11520 / 4; i += 512) ((LAS unsigned*)CT)[i] = 0u;
    for (int i = tid; i < 16 * LDT / 4; i += 512) ((LAS unsigned*)(VT + 64 * LDT))[i] = (i < LDT / 4) ? 0x3F803F80u : 0u;
    f32x4 cacc[3] = {(f32x4){0.f, 0.f, 0.f, 0.f}, (f32x4){0.f, 0.f, 0.f, 0.f}, (f32x4){0.f, 0.f, 0.f, 0.f}};
    float m_s = 0.f;
    const int tm = wid >> 1, tn0 = (wid & 1) * 2; const bool extra = (wid & 1) == 0;
    __syncthreads();
    u32x4 rw[3], v8; float graw_i = 0.f, graw_f = 0.f;
#define ML_LD(dst_, lp_) do { int lpp_ = (lp_); lpp_ = lpp_ < 0 ? 0 : (lpp_ >= L_ ? L_ - 1 : lpp_); const int p_ = dir ? (L_ - 1 - lpp_) : lpp_; \
        dst_ = *(const u32x4*)(PB + (size_t)tok_row(sg_, b, p_, false) * NINP + ML_Q + cgp_ * 256 + h * 64 + c8_ * 8); } while (0)
#define ML_ISSUE(cc_) do { const int sg_ = (cc_) >= 4, c_ = sg_ ? (cc_) - 4 : (cc_), L_ = sg_ ? SEQ : CTXL; \
        _Pragma("unroll") for (int k_ = 0; k_ < 2; ++k_) { const int idx_ = tid + 512 * k_; const int rr_ = idx_ >> 4, rem_ = idx_ & 15, cgp_ = rem_ >> 3, c8_ = rem_ & 7; ML_LD(rw[k_], c_ * 64 + rr_); } \
        { const int th_ = tid & 31; const int rr_ = th_ >> 4, rem_ = th_ & 15, cgp_ = rem_ >> 3, c8_ = rem_ & 7; ML_LD(rw[2], c_ * 64 + (rr_ ? 64 : -1)); } \
        { const int t_ = tid >> 3, c8_ = tid & 7; const int lp_ = c_ * 64 + t_, p_ = dir ? (L_ - 1 - lp_) : lp_; v8 = *(const u32x4*)(PB + (size_t)tok_row(sg_, b, p_, false) * NINP + ML_V + h * 64 + c8_ * 8); } \
        { const int lp_ = c_ * 64 + lane, p_ = dir ? (L_ - 1 - lp_) : lp_; const float* pg_ = PG + (size_t)tok_row(sg_, b, p_, false) * PGW + 64 + dir * 8 + h; graw_i = pg_[0]; graw_f = pg_[4]; } } while (0)
    ML_ISSUE(0);
#pragma unroll 1
    for (int cc = 0; cc < 132; ++cc) {
        {
            const int seg = cc >= 4, c = seg ? cc - 4 : cc, L = seg ? SEQ : CTXL;
            asm volatile("s_waitcnt vmcnt(0)" ::: "memory");
            {
#pragma unroll
                for (int k = 0; k < 2; ++k) { const int idx = tid + 512 * k; const int rr = idx >> 4, rem = idx & 15, cgp = rem >> 3, c8 = rem & 7; *(LAS u32x4*)(RAW + (rr + 1) * RS + cgp * 128 + c8 * 16) = rw[k]; }
                if (tid < 32) { const int rr = tid >> 4, rem = tid & 15, cgp = rem >> 3, c8 = rem & 7; const int lph = c * 64 + (rr ? 64 : -1);
                    *(LAS u32x4*)(RAW + (rr ? 65 : 0) * RS + cgp * 128 + c8 * 16) = (lph >= 0 && lph < L) ? rw[2] : (u32x4){0u, 0u, 0u, 0u}; }
                const int t = tid >> 3, c8 = tid & 7;
#pragma unroll
                for (int i = 0; i < 4; ++i) { *(LAS bf16_t*)(VT + (c8 * 8 + 2 * i) * LDT + t * 2) = (bf16_t)(v8[i] & 0xffffu); *(LAS bf16_t*)(VT + (c8 * 8 + 2 * i + 1) * LDT + t * 2) = (bf16_t)(v8[i] >> 16); }
            }
            if (wid == 0) {
                const float ig = graw_i + gbi, lf = logsigf_(graw_f + gbf);
                const float F = wave_scan_add(lf, lane); const float a = ig - F; const float M = fmaxf(wave_scan_max(a, lane), m_s);
                FV[lane] = F; AV[lane] = a; MV[lane] = M;
                const float m63 = __int_as_float(__builtin_amdgcn_readlane(__float_as_int(M), 63)); KWE[lane] = __expf(a - m63); }
            __syncthreads();
            if (cc + 1 < 132) ML_ISSUE(cc + 1);
            {
                const float M63 = MV[63];
                float kw[8];
#pragma unroll
                for (int g = 0; g < 2; ++g) {
                    float prev = bf2f(*(const LAS bf16_t*)(RAW + (o * 8 + 0) * RS + g * 128 + d * 2)), cur = bf2f(*(const LAS bf16_t*)(RAW + (o * 8 + 1) * RS + g * 128 + d * 2));
#pragma unroll
                    for (int i = 0; i < 8; ++i) {
                        const int t = o * 8 + i; const float nxt = bf2f(*(const LAS bf16_t*)(RAW + (t + 2) * RS + g * 128 + d * 2));
                        const float v = siluf_(w0[g] * prev + w1[g] * cur + w2[g] * nxt + wb[g]); prev = cur; cur = nxt;
                        if (g == 0) { *(LAS bf16_t*)(QM + t * LDT + d * 2) = f2bf(v); }
                        else { const float kk = v * 0.125f; *(LAS bf16_t*)(KM + t * LDT + d * 2) = f2bf(kk); kw[i] = kk * KWE[t]; }
                    }
                }
                u32x4 w; w.x = cvt_pk_bf16(kw[0], kw[1]); w.y = cvt_pk_bf16(kw[2], kw[3]); w.z = cvt_pk_bf16(kw[4], kw[5]); w.w = cvt_pk_bf16(kw[6], kw[7]);
                *(LAS u32x4*)(KWT + d * LDT + o * 16) = w;
            }
            __syncthreads();
            f32x4 hacc[3];
            const int trow = tm * 16 + fr; const float Mt = MV[trow];
            {
                const float winter = __expf(m_s - Mt);
#pragma unroll
                for (int i = 0; i < 2; ++i) {
                    const int tn = tn0 + i; f32x4 a = (f32x4){0.f, 0.f, 0.f, 0.f};
                    mma_tile<true, 2, LDT, LDT>(a, QM, tm * 16, KM, tn * 16, fr, fq);
                    const int s0 = tn * 16 + fq * 4; const f32x4 as = *(const LAS f32x4*)(AV + s0);
#pragma unroll
                    for (int jx = 0; jx < 4; ++jx) a[jx] = (s0 + jx <= trow) ? a[jx] * __expf(as[jx] - Mt) : 0.f;
                    u32x2 w; w.x = cvt_pk_bf16(a[0], a[1]); w.y = cvt_pk_bf16(a[2], a[3]);
                    *(LAS u32x2*)(WM + trow * LDT + s0 * 2) = w;
                    hacc[i] = (f32x4){0.f, 0.f, 0.f, 0.f};
                    mma_tile<true, 2, LDT, LDT>(hacc[i], QM, tm * 16, CT, tn * 16, fr, fq);
                    hacc[i] *= winter;
                }
                hacc[2] = (f32x4){0.f, 0.f, 0.f, 0.f};
                if (extra) { mma_tile<true, 2, LDT, LDT>(hacc[2], QM, tm * 16, CT, 64, fr, fq); hacc[2] *= winter; }
            }
            __syncthreads();
#pragma unroll
            for (int i = 0; i < 2; ++i) mma_tile<true, 2, LDT, LDT>(hacc[i], WM, tm * 16, VT, (tn0 + i) * 16, fr, fq);
            if (extra) { mma_tile<true, 2, LDT, LDT>(hacc[2], WM, tm * 16, VT, 64, fr, fq); DEN[fq * 64 + trow] = hacc[2][0]; }
            __syncthreads();
            {
                const int lp = c * 64 + trow, p = dir ? (L - 1 - lp) : lp;
                bf16_t* orow = OUT + (size_t)tok_row(seg, b, p, false) * 1024 + 512 + h * 64;
                const float den = DEN[trow], mt = FV[trow] + Mt; const float inv = 1.0f / fmaxf(fabsf(den), __expf(-mt));
#pragma unroll
                for (int i = 0; i < 2; ++i) {
                    u32x2 w; w.x = cvt_pk_bf16(hacc[i][0] * inv, hacc[i][1] * inv); w.y = cvt_pk_bf16(hacc[i][2] * inv, hacc[i][3] * inv);
                    *(u32x2*)(orow + (tn0 + i) * 16 + fq * 4) = w;
                }
                const float M63 = MV[63]; const float decay = __expf(m_s - M63);
#pragma unroll
                for (int i = 0; i < 2; ++i) {
                    const int tn = tn0 + i;
                    cacc[i] *= decay;
                    mma_tile<false, 2, LDT, LDT>(cacc[i], KWT, tm * 16, VT, tn * 16, fr, fq);
                    u32x2 w; w.x = cvt_pk_bf16(cacc[i][0], cacc[i][1]); w.y = cvt_pk_bf16(cacc[i][2], cacc[i][3]);
                    *(LAS u32x2*)(CT + (tn * 16 + fr) * LDT + (tm * 16 + fq * 4) * 2) = w;
                }
                if (extra) {
                    cacc[2] *= decay;
                    mma_tile<false, 2, LDT, LDT>(cacc[2], KWT, tm * 16, VT, 64, fr, fq);
                    u32x2 w; w.x = cvt_pk_bf16(cacc[2][0], cacc[2][1]); w.y = cvt_pk_bf16(cacc[2][2], cacc[2][3]);
                    *(LAS u32x2*)(CT + (64 + fr) * LDT + (tm * 16 + fq * 4) * 2) = w;
                }
                m_s = FV[63] + M63;
            }
            __syncthreads();
        }
    }
}

__device__ __forceinline__ void scan_s5(CPR P, int l, int b, int g, int dir, lds_t lds) {
    const int tid = opaque_tid(), lane = tid & 63, wid = tid >> 6, fr = lane & 15, fq = lane >> 4;
    const bf16_t* PB = (const bf16_t*)(P.ws + WS_PB);
    bf16_t* OUT = (bf16_t*)(P.ws + (dir ? WS_H2 : WS_H));
    constexpr int US = 80, HS = 272;
    lds_t UA = lds, BB = lds + 5120, HB = lds + 49152, CB = lds + 66560;
    LAS float* BU = (LAS float*)(lds + 15360); LAS float* EO = (LAS float*)(lds + 70912);
    const int n = tid & 63, o = tid >> 6;
    const int pidx = ((l * 2 + dir) * 16 + g) * 64 + n;
    const float are = fminf(P.in[I_S5ARE][pidx], -1e-4f), aim = P.in[I_S5AIM][pidx], step = expf(P.in[I_S5LS][(l * 2 + dir) * 16 + g]);
    const float mag = expf(are * step), abr = mag * cosf(aim * step), abi = mag * sinf(aim * step);
    {
        const float den = are * are + aim * aim, nr = abr - 1.0f, ni = abi;
        const float cre = (nr * are + ni * aim) / den, cim = (ni * are - nr * aim) / den;
#pragma unroll
        for (int jj = 0; jj < 2; ++jj) {
            const int j = o * 2 + jj;
            const float bre = P.in[I_S5BRE][(size_t)((l * 16 + g) * 64 + n) * 16 + j], bim = P.in[I_S5BIM][(size_t)((l * 16 + g) * 64 + n) * 16 + j];
            *(LAS bf16_t*)(BB + n * US + j * 2) = f2bf(cre * bre - cim * bim);
            *(LAS bf16_t*)(BB + (64 + n) * US + j * 2) = f2bf(cre * bim + cim * bre);
            *(LAS bf16_t*)(BB + n * US + (16 + j) * 2) = 0; *(LAS bf16_t*)(BB + (64 + n) * US + (16 + j) * 2) = 0;
            *(LAS bf16_t*)(UA + n * US + (16 + j) * 2) = 0;
            const float cr = P.in[I_S5CRE][(size_t)((l * 16 + g) * 16 + j) * 64 + n], ci = P.in[I_S5CIM][(size_t)((l * 16 + g) * 16 + j) * 64 + n];
            *(LAS bf16_t*)(CB + j * HS + n * 2) = f2bf(cr); *(LAS bf16_t*)(CB + j * HS + (64 + n) * 2) = f2bf(-ci);
        }
    }
    float a8r = abr, a8i = abi;
#pragma unroll
    for (int s = 0; s < 3; ++s) { const float r2 = a8r * a8r - a8i * a8i, i2 = 2.0f * a8r * a8i; a8r = r2; a8i = i2; }
    float h0r = 0.f, h0i = 0.f;
    __syncthreads();
    u32x4 u8 = (u32x4){0u, 0u, 0u, 0u};
#define S5_ISSUE(cc_) do { { const int sg_ = (cc_) >= 4, c_ = sg_ ? (cc_) - 4 : (cc_), L_ = sg_ ? SEQ : CTXL; const int t_ = (tid & 127) >> 1, hf_ = tid & 1; const int lp_ = c_ * 64 + t_, p_ = dir ? (L_ - 1 - lp_) : lp_; \
        u8 = *(const u32x4*)(PB + (size_t)tok_row(sg_, b, p_, true) * NINP + S50 + g * 16 + hf_ * 8); } } while (0)
    S5_ISSUE(0);
#pragma unroll 1
    for (int cc = 0; cc < 132; ++cc) {
        {
            const int seg = cc >= 4, c = seg ? cc - 4 : cc, L = seg ? SEQ : CTXL;
            asm volatile("s_waitcnt vmcnt(0)" ::: "memory");
            if (tid < 128) { const int t = tid >> 1, hf = tid & 1; *(LAS u32x4*)(UA + t * US + hf * 16) = u8; }
            __syncthreads();
            if (cc + 1 < 132) S5_ISSUE(cc + 1);
            {   const int tm = wid >> 1;
#pragma unroll
                for (int i = 0; i < 4; ++i) { const int tn = (wid & 1) * 4 + i; f32x4 a = (f32x4){0.f, 0.f, 0.f, 0.f};
                    mma_tile<false, 1, US, US>(a, UA, tm * 16, BB, tn * 16, fr, fq);
#pragma unroll
                    for (int jx = 0; jx < 4; ++jx) BU[(tm * 16 + fq * 4 + jx) * 132 + tn * 16 + fr] = a[jx]; }
            }
            __syncthreads();
            float hr[8], hi[8];
            {   float r = 0.f, im = 0.f;
#pragma unroll
                for (int i = 0; i < 8; ++i) { const int t = o * 8 + i; const float br = BU[t * 132 + n], bi = BU[t * 132 + 64 + n];
                    const float nr = abr * r - abi * im + br, ni = abr * im + abi * r + bi; r = nr; im = ni; hr[i] = r; hi[i] = im; }
                EO[o * 128 + n] = r; EO[o * 128 + 64 + n] = im;
            }
            __syncthreads();
            {   float cr = h0r, ci = h0i, mr = 0.f, mi = 0.f;
#pragma unroll
                for (int o2 = 0; o2 < 8; ++o2) { if (o2 == o) { mr = cr; mi = ci; }
                    const float er = EO[o2 * 128 + n], ei = EO[o2 * 128 + 64 + n];
                    const float nr = a8r * cr - a8i * ci + er, ni = a8r * ci + a8i * cr + ei; cr = nr; ci = ni; }
                h0r = cr; h0i = ci;
                float pr = abr, pi = abi;
#pragma unroll
                for (int i = 0; i < 8; ++i) { const int t = o * 8 + i;
                    const float vr = hr[i] + pr * mr - pi * mi, vi = hi[i] + pr * mi + pi * mr;
                    *(LAS bf16_t*)(HB + t * HS + n * 2) = f2bf(vr); *(LAS bf16_t*)(HB + t * HS + (64 + n) * 2) = f2bf(vi);
                    const float qr = pr * abr - pi * abi, qi = pr * abi + pi * abr; pr = qr; pi = qi; }
            }
            __syncthreads();
            if (wid < 4) { const int tm = wid; f32x4 a = (f32x4){0.f, 0.f, 0.f, 0.f};
                mma_tile<true, 4, HS, HS>(a, HB, tm * 16, CB, 0, fr, fq);
                const int t = tm * 16 + fr; const int lp = c * 64 + t, p = dir ? (L - 1 - lp) : lp;
                u32x2 w; w.x = cvt_pk_bf16(a[0], a[1]); w.y = cvt_pk_bf16(a[2], a[3]);
                __hip_atomic_store((unsigned long long*)(OUT + (size_t)tok_row(seg, b, p, true) * 1024 + 768 + g * 16 + fq * 4), ((unsigned long long)w.y << 32) | w.x, __ATOMIC_RELAXED, __HIP_MEMORY_SCOPE_AGENT); }
        }
    }
    __syncthreads();
}

__device__ __forceinline__ void phase_mixers(CPR P, int l, lds_t lds) {
#pragma unroll 1
    for (int item = blockIdx.x; item < 224; item += gridDim.x) {
        if (item < 32) scan_gla(P, l, item >> 3, (item >> 1) & 3, item & 1, lds);
        else if (item < 64) { const int i = item - 32; scan_ssd(P, l, i >> 3, (i >> 1) & 3, i & 1, lds); }
        else if (item < 96) { const int i = item - 64; scan_mlstm(P, l, i >> 3, (i >> 1) & 3, i & 1, lds); }
        else { const int i = item - 96; scan_s5(P, l, i >> 5, (i >> 1) & 15, i & 1, lds); }
        __syncthreads();
    }
    if ((int)blockIdx.x >= 224 && l + 1 < DEPTH) phase_convert(P, lds, l + 1, 224, (int)gridDim.x - 224);
}

__device__ __forceinline__ void phase_post(CPR P, int l) {
    const int tid_ = opaque_tid(); const int lane = tid_ & 63, wid = tid_ >> 6, c4 = lane * 4;
    bf16_t* H = (bf16_t*)(P.ws + WS_H); const bf16_t* H2 = (const bf16_t*)(P.ws + WS_H2); const bf16_t* PB = (const bf16_t*)(P.ws + WS_PB);
    bf16_t* GB = (bf16_t*)(P.ws + WS_GB);
    const f32x4 gg = *(const f32x4*)(P.in[I_GLAG] + l * 256 + c4), gs = *(const f32x4*)(P.in[I_SSDG] + l * 256 + c4), gm = *(const f32x4*)(P.in[I_MLG] + l * 256 + c4), sd = *(const f32x4*)(P.in[I_S5D] + l * 256 + c4);
    for (int row = blockIdx.x * 8 + wid; row < NT; row += gridDim.x * 8) {
        bf16_t* hrow = H + (size_t)row * 1024; const bf16_t* orow = H2 + (size_t)row * 1024; const bf16_t* pr = PB + (size_t)row * NINP;
        u32x2 f[4], bk[4];
#pragma unroll
        for (int q = 0; q < 4; ++q) { f[q] = *(const u32x2*)(hrow + q * 256 + c4); bk[q] = *(const u32x2*)(orow + q * 256 + c4); }
        const u32x2 rr = *(const u32x2*)(pr + GLA_R + c4), zz = *(const u32x2*)(pr + SSD_Z + c4), oo = *(const u32x2*)(pr + ML_O + c4), pp = *(const u32x2*)(pr + S50 + c4);
        float v[4][4];
#pragma unroll
        for (int q = 0; q < 4; ++q) { v[q][0] = bflo(f[q].x) + bflo(bk[q].x); v[q][1] = bfhi(f[q].x) + bfhi(bk[q].x); v[q][2] = bflo(f[q].y) + bflo(bk[q].y); v[q][3] = bfhi(f[q].y) + bfhi(bk[q].y); }
        const float rv[4] = {bflo(rr.x), bfhi(rr.x), bflo(rr.y), bfhi(rr.y)}, zv[4] = {bflo(zz.x), bfhi(zz.x), bflo(zz.y), bfhi(zz.y)};
        const float ov[4] = {bflo(oo.x), bfhi(oo.x), bflo(oo.y), bfhi(oo.y)}, pv[4] = {bflo(pp.x), bfhi(pp.x), bflo(pp.y), bfhi(pp.y)};
        float ss = v[0][0] * v[0][0] + v[0][1] * v[0][1] + v[0][2] * v[0][2] + v[0][3] * v[0][3];
        ss = row16_sum(ss);
        float rs = rsqrtf(ss * (1.0f / 64.0f) + EPS);
        { u32x2 w; w.x = cvt_pk_bf16(v[0][0] * rs * gg[0] * siluf_(rv[0]), v[0][1] * rs * gg[1] * siluf_(rv[1])); w.y = cvt_pk_bf16(v[0][2] * rs * gg[2] * siluf_(rv[2]), v[0][3] * rs * gg[3] * siluf_(rv[3]));
          *(u32x2*)(hrow + c4) = w; }
        float y[4];
#pragma unroll
        for (int i = 0; i < 4; ++i) y[i] = v[1][i] * siluf_(zv[i]);
        ss = y[0] * y[0] + y[1] * y[1] + y[2] * y[2] + y[3] * y[3];
        ss = wave_sum(ss);
        rs = rsqrtf(ss * (1.0f / 256.0f) + EPS);
        { u32x2 w; w.x = cvt_pk_bf16(y[0] * rs * gs[0], y[1] * rs * gs[1]); w.y = cvt_pk_bf16(y[2] * rs * gs[2], y[3] * rs * gs[3]); *(u32x2*)(hrow + 256 + c4) = w; }
        ss = v[2][0] * v[2][0] + v[2][1] * v[2][1] + v[2][2] * v[2][2] + v[2][3] * v[2][3];
        ss = row16_sum(ss);
        rs = rsqrtf(ss * (1.0f / 64.0f) + EPS);
        { u32x2 w; w.x = cvt_pk_bf16(v[2][0] * rs * gm[0] * sigmoidf_(ov[0]), v[2][1] * rs * gm[1] * sigmoidf_(ov[1])); w.y = cvt_pk_bf16(v[2][2] * rs * gm[2] * sigmoidf_(ov[2]), v[2][3] * rs * gm[3] * sigmoidf_(ov[3]));
          *(u32x2*)(hrow + 512 + c4) = w; }
        { u32x2 w; w.x = cvt_pk_bf16(geluf_(v[3][0] + sd[0] * pv[0]), geluf_(v[3][1] + sd[1] * pv[1])); w.y = cvt_pk_bf16(geluf_(v[3][2] + sd[2] * pv[2]), geluf_(v[3][3] + sd[3] * pv[3]));
          *(u32x2*)(GB + (size_t)row * 256 + c4) = w; }
    }
}

#define XB_TMO      128
#define XB_XCNT(j)  (256  + 64 * (j))
#define XB_XSUB(j)  (1280 + 64 * (j))
#define XB_XGEN(j)  (2304 + 64 * (j))
#define XB_TOP      3328
#define XB_TOPGEN   3392
#define XCD_BAR_WORDS 3456
#define XB_SPIN_CAP (1u << 22)
__device__ __forceinline__ unsigned xb_ld(unsigned* p)              { return __hip_atomic_load(p, __ATOMIC_RELAXED, __HIP_MEMORY_SCOPE_AGENT); }
__device__ __forceinline__ unsigned xb_add(unsigned* p, unsigned v) { return __hip_atomic_fetch_add(p, v, __ATOMIC_RELAXED, __HIP_MEMORY_SCOPE_AGENT); }
__device__ __forceinline__ unsigned xb_xcc_id() { return (unsigned)__builtin_amdgcn_s_getreg((3 << 11) | 20) & 0xFu; }
#define XB_SPIN(cond, bar) do { unsigned _sp = 0; while (cond) { __builtin_amdgcn_s_sleep(1); \
    if ((++_sp & 255u) == 0u) { if (xb_ld(&(bar)[XB_TMO])) break; if (_sp > XB_SPIN_CAP) { atomicAdd(&(bar)[XB_TMO], 1u); break; } } } } while (0)
struct XcdBarrier { unsigned* bar; unsigned x; volatile LAS unsigned* st; };
__device__ __forceinline__ XcdBarrier xcd_barrier_post(unsigned* bar, volatile LAS unsigned* st) {
    XcdBarrier b; b.bar = bar; b.x = xb_xcc_id(); b.st = st;
    if (threadIdx.x == 0) (void)xb_add(&bar[XB_XCNT(b.x)], 1u);
    return b;
}
__device__ __forceinline__ void xcd_barrier_complete(unsigned* bar, unsigned x, unsigned& nloc, unsigned& nx) {
    const unsigned G = gridDim.x * gridDim.y * gridDim.z;
    unsigned sum, cnt, mine, sp = 0u;
    for (;;) {
        sum = 0u; cnt = 0u; mine = 0u;
#pragma unroll
        for (unsigned j = 0; j < 16; ++j) { const unsigned c = xb_ld(&bar[XB_XCNT(j)]); sum += c; cnt += (c > 0u) ? 1u : 0u; mine = (j == x) ? c : mine; }
        if (sum == G) break;
        __builtin_amdgcn_s_sleep(1);
        if ((++sp & 255u) == 0u) { if (xb_ld(&bar[XB_TMO])) break; if (sp > XB_SPIN_CAP) { atomicAdd(&bar[XB_TMO], 1u); break; } }
    }
    nloc = mine > 0u ? mine : 1u; nx = cnt > 0u ? cnt : 1u;
}
__device__ __forceinline__ void xcd_barrier(const XcdBarrier& b) {
    asm volatile("s_waitcnt vmcnt(0)" ::: "memory");
    __syncthreads();
    if (threadIdx.x == 0) {
        unsigned* bar = b.bar;
        __builtin_amdgcn_s_waitcnt(0);
        unsigned nloc = b.st[0], nx = b.st[1];
        if (nloc == 0u) { xcd_barrier_complete(bar, b.x, nloc, nx); b.st[0] = nloc; b.st[1] = nx; }
        const unsigned old = xb_add(&bar[XB_XSUB(b.x)], 1u);
        const unsigned gen = old / nloc;
        if (old + 1u == (gen + 1u) * nloc) {
            __builtin_amdgcn_fence(__ATOMIC_RELEASE, "agent");
            asm volatile("s_waitcnt vmcnt(0)" ::: "memory");
            const unsigned og = xb_add(&bar[XB_TOP], 1u);
            const unsigned tg = og / nx;
            if (og + 1u == (tg + 1u) * nx) xb_add(&bar[XB_TOPGEN], 1u);
            else XB_SPIN(xb_ld(&bar[XB_TOPGEN]) == tg, bar);
            __builtin_amdgcn_fence(__ATOMIC_ACQUIRE, "agent");
            xb_add(&bar[XB_XGEN(b.x)], 1u);
            asm volatile("s_waitcnt vmcnt(0)" ::: "memory");
        } else {
            XB_SPIN(xb_ld(&bar[XB_XGEN(b.x)]) == gen, bar);
            __builtin_amdgcn_fence(__ATOMIC_ACQUIRE, "agent");
            asm volatile("s_waitcnt vmcnt(0)" ::: "memory");
        }
    }
    __syncthreads();
}
__device__ __forceinline__ void gsync(cg::grid_group& grid) {
    asm volatile("s_waitcnt vmcnt(0) lgkmcnt(0)" ::: "memory");
    __builtin_amdgcn_fence(__ATOMIC_RELEASE, "agent");
    asm volatile("s_waitcnt vmcnt(0)" ::: "memory");
    grid.sync();
    __builtin_amdgcn_fence(__ATOMIC_ACQUIRE, "agent");
    asm volatile("s_waitcnt vmcnt(0)" ::: "memory");
    __syncthreads();
}
__global__ void __launch_bounds__(512, 2) fwd_megakernel(Params Pk) {
    extern __shared__ __attribute__((aligned(16))) unsigned char smem[];
    lds_t lds = (lds_t)smem;
    cg::grid_group grid = cg::this_grid();
    volatile LAS unsigned* xst = (volatile LAS unsigned*)(lds + 131072);
    if (threadIdx.x == 0) { xst[0] = 0u; xst[1] = 0u; xst[2] = 0u; xst[3] = 0u; }
    __syncthreads();
    const XcdBarrier xb = xcd_barrier_post((unsigned*)(getP()->ws + WS_BAR), xst);
    phase_mods(*getP(), lds);
    phase_convert(*getP(), lds, 0, 0, (int)gridDim.x);
    xcd_barrier(xb);
    if (getP()->ws == nullptr) gsync(grid);
#pragma unroll 1
    for (int l = 0; l < DEPTH; ++l) {
#pragma unroll 1
        for (int j = 0; j < 3; ++j) {
            phase_modnorm(*getP(), l, j, l == 0 && j == 0);
            xcd_barrier(xb);
            CPR P = *getP();
            bf16_t* H = (bf16_t*)(P.ws + WS_H); bf16_t* PBp = (bf16_t*)(P.ws + WS_PB);
            const float* mods_l = (const float*)(P.ws + WS_MODS) + (size_t)l * 5 * 9216;
            pg8::Gemm g2;
            if (j != 1) {
                const int s = j >> 1;
                pg8::Gemm g; g.A = H; g.Bt = (const bf16_t*)(P.ws + WS_WFI) + (size_t)(l * 2 + s) * 5632 * 1024; g.M = NT; g.N = 5632; g.K = 1024; g.lda = 1024; g.ldb = 1024;
                pg8::StaticOrder S; S.init(g.M, g.N, (int)gridDim.x, (int)blockIdx.x);
                EpiSwiGLU E; E.O = PBp;
                pg8::gemm_phase(lds, g, S, E);
                xcd_barrier(xb);
                g2.A = PBp; g2.Bt = (const bf16_t*)(P.ws + WS_WFO) + (size_t)(l * 2 + s) * 1024 * DFF; g2.M = NLAT; g2.N = 1024; g2.K = DFF; g2.lda = DFF; g2.ldb = DFF;
            } else {
                {
                    pg8::Gemm g; g.A = H; g.Bt = (const bf16_t*)(P.ws + WS_WIN) + (size_t)l * NINP * 1024; g.M = NT; g.N = NINP; g.K = 1024; g.lda = 1024; g.ldb = 1024;
                    pg8::StaticOrder S; S.init(g.M, g.N, (int)gridDim.x, (int)blockIdx.x);
                    EpiInProj E; E.Pb = PBp; E.Pg = (float*)(P.ws + WS_PG);
                    pg8::gemm_phase(lds, g, S, E);
                }
                xcd_barrier(xb);
                phase_mixers(*getP(), l, lds);
                xcd_barrier(xb);
                phase_post(*getP(), l);
                xcd_barrier(xb);
                {
                    pg8::Gemm g; g.A = (const bf16_t*)(P.ws + WS_GB); g.Bt = (const bf16_t*)(P.ws + WS_WGLU) + (size_t)l * 256 * 256; g.M = NT; g.N = 256; g.K = 256; g.lda = 256; g.ldb = 256;
                    pg8::StaticOrder S; S.init(g.M, g.N, (int)gridDim.x, (int)blockIdx.x);
                    EpiGLU E; E.G = (const bf16_t*)(P.ws + WS_GB); E.bglu = P.in[I_S5BGLU] + l * 256; E.O = H;
                    pg8::gemm_phase(lds, g, S, E);
                }
                xcd_barrier(xb);
                g2.A = H; g2.Bt = (const bf16_t*)(P.ws + WS_WOUT) + (size_t)l * 1024 * 1024; g2.M = NLAT; g2.N = 1024; g2.K = 1024; g2.lda = 1024; g2.ldb = 1024;
            }
            {
                pg8::StaticOrder S; S.init(g2.M, g2.N, (int)gridDim.x, (int)blockIdx.x);
                EpiResid E; E.xlat = P.out; E.xctx = (float*)(P.ws + WS_CTXX); E.gate_l = mods_l + (3 * j + 2) * 1024; E.coef = (j == 1) ? 1.0f : 0.5f;
                pg8::gemm_phase(lds, g2, S, E);
                pg8::Gemm g3 = g2; g3.A = g2.A + (size_t)NLAT * g2.lda; g3.M = NCTX; g3.K = 256;
                pg8::SplitKOrder S3; S3.init(g3.M, g3.N, g2.K / 256, (int)gridDim.x, (int)blockIdx.x);
                EpiSlab E3; E3.slab = (float*)(P.ws + WS_SLAB);
                pg8::gemm_phase(lds, g3, S3, E3);
            }
            xcd_barrier(xb);
        }
    }
    phase_final(*getP());
}

extern "C" void kernel_launch(void* const* d_in, const int* in_sizes, int n_in, void* d_out, int out_size, void* d_ws, size_t ws_size, hipStream_t stream) {
    constexpr int LDS_BYTES = 131072 + 64;
    static int grid = 0;
    if (grid == 0) {
        if (n_in != 35 || ws_size < WS_END) { fprintf(stderr, "kernel_launch: expected 35 inputs and >= %zu bytes of workspace; got %d, %zu\n", (size_t)WS_END, n_in, ws_size); grid = -1; return; }
        int dev = 0, cus = 0, per_cu = 0;
        hipGetDevice(&dev);
        hipDeviceGetAttribute(&cus, hipDeviceAttributeMultiprocessorCount, dev);
        if (hipFuncSetAttribute((const void*)fwd_megakernel, hipFuncAttributeMaxDynamicSharedMemorySize, LDS_BYTES) != hipSuccess) { fprintf(stderr, "kernel_launch: hipFuncSetAttribute failed\n"); grid = -1; return; }
        if (hipOccupancyMaxActiveBlocksPerMultiprocessor(&per_cu, (const void*)fwd_megakernel, 512, LDS_BYTES) != hipSuccess || per_cu < 1) { fprintf(stderr, "kernel_launch: occupancy query says %d blocks per CU\n", per_cu); per_cu = 1; }
        (void)hipGetLastError();
        grid = cus;
    }
    if (grid < 0) return;
    Params p{};
    for (int i = 0; i < 35; ++i) p.in[i] = (const float*)d_in[i];
    p.out = (float*)d_out; p.ws = (unsigned char*)d_ws;
    if (hipMemsetAsync((char*)d_ws + WS_BAR, 0, SZ_BAR, stream) != hipSuccess) { fprintf(stderr, "kernel_launch: memset of the barrier words failed\n"); return; }
    void* args[] = {&p};
    hipError_t e = hipLaunchCooperativeKernel((const void*)fwd_megakernel, dim3(grid), dim3(512), args, LDS_BYTES, stream);
    if (e != hipSuccess) fprintf(stderr, "cooperative launch failed: %s (grid %d)\n", hipGetErrorString(e), grid);
}
```

```cpp
#include <hip/hip_runtime.h>
#include <hip/hip_cooperative_groups.h>
#include <cstdio>
namespace cg = cooperative_groups;

#define LAS __attribute__((address_space(3)))
typedef unsigned short bf16_t;
typedef short bf16x8 __attribute__((ext_vector_type(8)));
typedef float f32x4 __attribute__((ext_vector_type(4)));
typedef unsigned u32x4 __attribute__((ext_vector_type(4)));
typedef unsigned u32x2 __attribute__((ext_vector_type(2)));
typedef LAS unsigned char* lds_t;

constexpr int DM = 1024, NB = 4, SEQ = 8192, DEPTH = 4, CTXL = 256;
constexpr int NLAT = NB * SEQ, NCTX = NB * CTXL, NT = NLAT + NCTX;
constexpr int DFF = 2816, NIN = 3128, NINP = 3328;
constexpr int GLA_Q = 0, GLA_K = 256, GLA_V = 512, GLA_R = 768;
constexpr int SSD_X = 1056, SSD_B = 1312, SSD_C = 1440, SSD_Z = 1568;
constexpr int ML_Q = 1832, ML_V = 2344, ML_O = 2600;
constexpr int S50 = 2872;
constexpr int PGW = 96;
constexpr float EPS = 1e-6f;

constexpr size_t SZ_WFI = (size_t)DEPTH * 2 * 5632 * 1024 * 2;
constexpr size_t SZ_WFO = (size_t)DEPTH * 2 * 1024 * 2816 * 2;
constexpr size_t SZ_WIN = (size_t)DEPTH * NINP * 1024 * 2;
constexpr size_t SZ_WOUT = (size_t)DEPTH * 1024 * 1024 * 2;
constexpr size_t SZ_WGLU = (size_t)DEPTH * 256 * 256 * 2;
constexpr size_t SZ_MODS = (size_t)DEPTH * 5 * 9216 * 4;
constexpr size_t SZ_CTXX = (size_t)NCTX * 1024 * 4;
constexpr size_t SZ_H = (size_t)NT * 1024 * 2;
constexpr size_t SZ_PB = (size_t)NT * NINP * 2;
constexpr size_t SZ_PG = (size_t)NT * PGW * 4;
constexpr size_t SZ_GB = (size_t)NT * 256 * 2;
constexpr size_t WS_WFI = 0;
constexpr size_t WS_WFO = WS_WFI + SZ_WFI;
constexpr size_t WS_WIN = WS_WFO + SZ_WFO;
constexpr size_t WS_WOUT = WS_WIN + SZ_WIN;
constexpr size_t WS_WGLU = WS_WOUT + SZ_WOUT;
constexpr size_t WS_MODS = WS_WGLU + SZ_WGLU;
constexpr size_t WS_CTXX = WS_MODS + SZ_MODS;
constexpr size_t WS_H = WS_CTXX + SZ_CTXX;
constexpr size_t WS_H2 = WS_H + SZ_H;
constexpr size_t WS_PB = WS_H2 + SZ_H;
constexpr size_t WS_PG = WS_PB + SZ_PB;
constexpr size_t WS_GB = WS_PG + SZ_PG;
constexpr size_t WS_BAR = WS_GB + SZ_GB;
constexpr size_t SZ_BAR = 16384;
constexpr size_t WS_SLAB = WS_BAR + SZ_BAR;
constexpr size_t SZ_SLAB = (size_t)11 * NCTX * 1024 * 4;
constexpr size_t WS_END = WS_SLAB + SZ_SLAB;

struct Params {
    const float* in[35];
    float* out;
    unsigned char* ws;
};
typedef const __attribute__((address_space(4))) Params* cparams_t;
#define CPR const __attribute__((address_space(4))) Params&
__device__ __forceinline__ cparams_t getP() { cparams_t p = (cparams_t)__builtin_amdgcn_kernarg_segment_ptr(); asm volatile("" : "+s"(p)); return p; }
enum { I_X = 0, I_C, I_CTX, I_CCTX, I_WMOD, I_BMOD, I_GNORM, I_FFNWIN, I_FFNWOUT, I_WIN, I_WOUT, I_GLAW, I_GLAB, I_GLAG,
       I_SSDCW, I_SSDCB, I_SSDALOG, I_SSDDTB, I_SSDD, I_SSDG, I_MLCW, I_MLCB, I_MLGB, I_MLG, I_S5ARE, I_S5AIM, I_S5LS,
       I_S5BRE, I_S5BIM, I_S5CRE, I_S5CIM, I_S5D, I_S5WGLU, I_S5BGLU, I_GFINAL };

__device__ __forceinline__ float bf2f(unsigned b) { return __uint_as_float(b << 16); }
typedef __bf16 bf16x2_t __attribute__((ext_vector_type(2)));
typedef float f32x2_t __attribute__((ext_vector_type(2)));
__device__ __forceinline__ unsigned cvt_pk_bf16(float lo, float hi) { const f32x2_t f = {lo, hi}; return __builtin_bit_cast(unsigned, __builtin_convertvector(f, bf16x2_t)); }
__device__ __forceinline__ bf16_t f2bf(float f) { return (bf16_t)(cvt_pk_bf16(f, 0.f) & 0xffffu); }
__device__ __forceinline__ float bflo(unsigned w) { return __uint_as_float(w << 16); }
__device__ __forceinline__ float bfhi(unsigned w) { return __uint_as_float(w & 0xffff0000u); }
__device__ __forceinline__ float sigmoidf_(float x) { return 1.0f / (1.0f + __expf(-x)); }
__device__ __forceinline__ float siluf_(float x) { return x * sigmoidf_(x); }
__device__ __forceinline__ float logsigf_(float x) { return fminf(x, 0.f) - __logf(1.0f + __expf(-fabsf(x))); }
__device__ __forceinline__ float softplusf_(float x) { return fmaxf(x, 0.f) + __logf(1.0f + __expf(-fabsf(x))); }
__device__ __forceinline__ float geluf_(float x) { const float u = 0.7978845608028654f * (x + 0.044715f * x * x * x); return x * sigmoidf_(2.0f * u); }

__device__ __forceinline__ int tok_row(int seg, int b, int p, bool colmajor) {
    if (seg == 0) return NLAT + b * CTXL + p;
    return b * SEQ + (colmajor ? ((p & 127) * 64 + (p >> 7)) : p);
}

__device__ __forceinline__ int opaque_tid() { int t = threadIdx.x; asm volatile("" : "+v"(t) :: "memory"); return t; }
__device__ __forceinline__ float shfl_idx(float v, int srclane) { return __int_as_float(__builtin_amdgcn_ds_bpermute(srclane << 2, __float_as_int(v))); }
template <bool TRANS, int KSTEPS, int SA, int SB, bool SAFE = false>
__device__ __forceinline__ void mma_tile(f32x4& acc, lds_t As, int arow0, lds_t Bs, int brow0, int fr, int fq) {
#pragma unroll
    for (int kk = 0; kk < KSTEPS; ++kk) {
        const bf16x8 a = *(const LAS bf16x8*)(As + (arow0 + fr) * SA + kk * 64 + fq * 16);
        const bf16x8 b = *(const LAS bf16x8*)(Bs + (brow0 + fr) * SB + kk * 64 + fq * 16);
        if (SAFE) asm volatile("s_waitcnt lgkmcnt(0)" ::: "memory");
        if (TRANS) acc = __builtin_amdgcn_mfma_f32_16x16x32_bf16(b, a, acc, 0, 0, 0);
        else acc = __builtin_amdgcn_mfma_f32_16x16x32_bf16(a, b, acc, 0, 0, 0);
    }
}
constexpr int LDT = 144;

namespace pg8 {
constexpr int BM = 256, BK = 64, HALF = 128, HTB = HALF * BK * 2, STAGE_BYTES = 8 * HTB, NXCD = 8, WGM = 8;
__device__ __forceinline__ int lds_byte(int r, int c) { const int st = (r >> 4) * 2 + (c >> 5), rr = r & 15, cc = c & 31, ob = rr * 64 + cc * 2; return st * 1024 + (ob ^ (((ob >> 9) & 1) << 5)); }
__device__ __forceinline__ void stage_rc(int b, int& R, int& C) { const int st = b / 1024, sb = b % 1024, swz = sb ^ (((sb >> 9) & 1) << 5); R = (st >> 1) * 16 + swz / 64; C = (st & 1) * 32 + (swz % 64) / 2; }
__device__ __forceinline__ int perm32(int rho) { const int n = rho >> 4, i = rho & 15; return 8 * (i >> 2) + 4 * n + (i & 3); }
struct Unit { int pm, pn, ks; };
struct Gemm { const bf16_t* A; const bf16_t* Bt; int M, N, K, lda, ldb; };
struct StaticOrder {
    int nM, nN, nwg, G, c;
    __device__ void init(int M, int N, int G_, int c_) { nM = M / BM; nN = N / BM; nwg = nM * nN; G = G_; c = c_; }
    __device__ bool next(int i, Unit& u) const {
        const long L = (long)i * G + c; if (L >= nwg) return false;
        int wgid = (int)L; { const int q = nwg / NXCD, r = nwg % NXCD, xcd = wgid % NXCD, off = wgid / NXCD; wgid = (xcd < r ? xcd * (q + 1) : r * (q + 1) + (xcd - r) * q) + off; }
        const int nig = WGM * nN, gid = wgid / nig, fm = gid * WGM, gsz = (nM - fm) < WGM ? (nM - fm) : WGM;
        u.pm = fm + ((wgid % nig) % gsz); u.pn = (wgid % nig) / gsz; u.ks = 0; return true;
    }
};
struct SplitKOrder {
    int nN, nks, n, G, c;
    __device__ void init(int M, int N, int nks_, int G_, int c_) { nN = N / BM; nks = nks_; n = (M / BM) * nN * nks; G = G_; c = c_; }
    __device__ bool next(int i, Unit& u) const { const long L = (long)i * G + c; if (L >= n) return false; const int l = (int)L; u.ks = l % nks; const int r = l / nks; u.pn = r % nN; u.pm = r / nN; return true; }
};
template <class Epi, class Sched>
__device__ __forceinline__ void gemm_phase(lds_t lds, const Gemm g, const Sched& S, const Epi& E) {
    const int tid = opaque_tid(), wid = __builtin_amdgcn_readfirstlane(tid >> 6), lane = tid & 63, wr = wid >> 2, wc = wid & 3, fr = lane & 15, fq = lane >> 4;
    const int K = g.K, nt = K / BK;
    unsigned voffA[2], voffB[2];
#pragma unroll
    for (int i = 0; i < 2; ++i) { int R, C; stage_rc(tid * 16 + i * 8192, R, C); const int Rb = Epi::PERM ? ((R & ~31) + perm32(R & 31)) : R;
        voffA[i] = (unsigned)(R * g.lda + C) * 2u; voffB[i] = (unsigned)(Rb * g.ldb + C) * 2u; }
    const size_t kstep = (size_t)(BK * 2);
    const size_t hstepA = (size_t)HALF * g.lda * 2, hstepB = (size_t)HALF * g.ldb * 2;
    const size_t tstepA = 2 * hstepA, tstepB = 2 * hstepB, kslice = (size_t)K * 2;
    const unsigned ldsw = (unsigned)wid * 1024u;
    const int aoff = lds_byte(wr * 64 + fr, fq * 8), boff = lds_byte(wc * 32 + fr, fq * 8);
#define PG8_SA(b, h) (((b) * 2 + (h)) * HTB)
#define PG8_SB(b, h) ((4 + (b) * 2 + (h)) * HTB)
#define PG8_STAGE(bufoff, gbase, voff) do { _Pragma("unroll") for (int _i = 0; _i < 2; ++_i) \
        __builtin_amdgcn_global_load_lds((const unsigned*)((const char*)(gbase) + (voff)[_i]), (LAS unsigned*)(lds + (bufoff) + ldsw + _i * 8192), 16, 0, 0); } while (0)
#define PG8_LDA(dst, b, h) do { _Pragma("unroll") for (int m = 0; m < 4; ++m) _Pragma("unroll") for (int k = 0; k < 2; ++k) dst[m][k] = *(const LAS bf16x8*)(lds + PG8_SA(b, h) + aoff + m * 2048 + k * 1024); } while (0)
#define PG8_LDB(dst, b, h) do { _Pragma("unroll") for (int n = 0; n < 2; ++n) _Pragma("unroll") for (int k = 0; k < 2; ++k) dst[n][k] = *(const LAS bf16x8*)(lds + PG8_SB(b, h) + boff + n * 2048 + k * 1024); } while (0)
#define PG8_MMA(ai, bj, At, Bt) do { __builtin_amdgcn_s_setprio(1); _Pragma("unroll") for (int m = 0; m < 4; ++m) _Pragma("unroll") for (int n = 0; n < 2; ++n) _Pragma("unroll") for (int k = 0; k < 2; ++k) \
        acc[ai][bj][m][n] = __builtin_amdgcn_mfma_f32_16x16x32_bf16(Bt[n][k], At[m][k], acc[ai][bj][m][n], 0, 0, 0); __builtin_amdgcn_s_setprio(0); } while (0)
#define PG8_WAIT_V(n) asm volatile("s_waitcnt vmcnt(" #n ")" ::: "memory")
#define PG8_WAIT_L(n) asm volatile("s_waitcnt lgkmcnt(" #n ")" ::: "memory")
#define PG8_BAR __builtin_amdgcn_s_barrier()
#define PG8_SCHED __builtin_amdgcn_sched_barrier(0)
    Unit cur, nxt; int ui = 0;
    if (!S.next(0, cur)) return;
    f32x4 acc[2][2][4][2];
#pragma unroll
    for (int a = 0; a < 2; ++a)
#pragma unroll
        for (int b = 0; b < 2; ++b)
#pragma unroll
            for (int m = 0; m < 4; ++m)
#pragma unroll
                for (int n = 0; n < 2; ++n) acc[a][b][m][n] = (f32x4){0.f, 0.f, 0.f, 0.f};
    bf16x8 At[4][2], B0[2][2], B1[2][2];
    const char* cA = (const char*)g.A + (size_t)cur.pm * tstepA + (size_t)cur.ks * kslice; const char* cB = (const char*)g.Bt + (size_t)cur.pn * tstepB + (size_t)cur.ks * kslice;
    PG8_STAGE(PG8_SB(0, 0), cB, voffB); PG8_STAGE(PG8_SA(0, 0), cA, voffA); PG8_STAGE(PG8_SB(0, 1), cB + hstepB, voffB); PG8_STAGE(PG8_SA(0, 1), cA + hstepA, voffA);
    if (wr == 1) PG8_BAR;
    PG8_WAIT_V(4); PG8_BAR;
    PG8_STAGE(PG8_SB(1, 0), cB + kstep, voffB); PG8_STAGE(PG8_SA(1, 0), cA + kstep, voffA); PG8_STAGE(PG8_SB(1, 1), cB + hstepB + kstep, voffB);
    PG8_WAIT_V(6); PG8_BAR;
    for (;;) {
        const bool has_next = S.next(ui + 1, nxt);
        const char* nA = has_next ? (const char*)g.A + (size_t)nxt.pm * tstepA + (size_t)nxt.ks * kslice : cA; const char* nB = has_next ? (const char*)g.Bt + (size_t)nxt.pn * tstepB + (size_t)nxt.ks * kslice : cB;
        for (int t = 0; t < nt; t += 2) {
            const bool last = (t == nt - 2);
            const char* a1 = cA + (size_t)(t + 1) * kstep;
            const char* a2 = last ? nA : cA + (size_t)(t + 2) * kstep; const char* b2 = last ? nB : cB + (size_t)(t + 2) * kstep;
            const char* a3 = a2 + kstep; const char* b3 = b2 + kstep;
            PG8_LDB(B0, 0, 0); PG8_SCHED; PG8_LDA(At, 0, 0); PG8_STAGE(PG8_SA(1, 1), a1 + hstepA, voffA);
            PG8_WAIT_L(8); PG8_BAR; PG8_WAIT_L(0); PG8_MMA(0, 0, At, B0); PG8_BAR; PG8_SCHED;
            PG8_LDB(B1, 0, 1); PG8_STAGE(PG8_SB(0, 0), b2, voffB);
            PG8_BAR; PG8_WAIT_L(0); PG8_MMA(0, 1, At, B1); PG8_BAR;
            PG8_LDA(At, 0, 1); PG8_STAGE(PG8_SA(0, 0), a2, voffA);
            PG8_BAR; PG8_WAIT_L(0); PG8_MMA(1, 0, At, B0); PG8_BAR; PG8_SCHED;
            PG8_STAGE(PG8_SB(0, 1), b2 + hstepB, voffB);
            PG8_WAIT_V(6); PG8_BAR; PG8_MMA(1, 1, At, B1); PG8_BAR;
            PG8_LDB(B0, 1, 0); PG8_SCHED; PG8_LDA(At, 1, 0); PG8_STAGE(PG8_SA(0, 1), a2 + hstepA, voffA);
            PG8_WAIT_L(8); PG8_BAR; PG8_WAIT_L(0); PG8_MMA(0, 0, At, B0); PG8_BAR; PG8_SCHED;
            PG8_LDB(B1, 1, 1); PG8_STAGE(PG8_SB(1, 0), b3, voffB);
            PG8_BAR; PG8_WAIT_L(0); PG8_MMA(0, 1, At, B1); PG8_BAR;
            PG8_LDA(At, 1, 1); PG8_STAGE(PG8_SA(1, 0), a3, voffA);
            PG8_BAR; PG8_WAIT_L(0); PG8_MMA(1, 0, At, B0); PG8_BAR; PG8_SCHED;
            PG8_STAGE(PG8_SB(1, 1), b3 + hstepB, voffB);
            PG8_WAIT_V(6); PG8_BAR; PG8_MMA(1, 1, At, B1); PG8_BAR;
        }
        { const int t2 = opaque_tid(); E(acc, cur, wr, wc, t2 & 15, (t2 & 63) >> 4); }
        if (!has_next) break;
#pragma unroll
        for (int a = 0; a < 2; ++a)
#pragma unroll
            for (int b = 0; b < 2; ++b)
#pragma unroll
                for (int m = 0; m < 4; ++m)
#pragma unroll
                    for (int n = 0; n < 2; ++n) acc[a][b][m][n] = (f32x4){0.f, 0.f, 0.f, 0.f};
        cur = nxt; cA = nA; cB = nB; ++ui;
    }
    PG8_WAIT_V(0);
    if (wr == 0) PG8_BAR;
    PG8_BAR;
#undef PG8_SA
#undef PG8_SB
#undef PG8_STAGE
#undef PG8_LDA
#undef PG8_LDB
#undef PG8_MMA
#undef PG8_WAIT_V
#undef PG8_WAIT_L
#undef PG8_BAR
#undef PG8_SCHED
}
}
using pg8::Unit;

struct EpiSwiGLU {
    static constexpr bool PERM = true;
    bf16_t* O;
    __device__ __forceinline__ void operator()(const f32x4 (&acc)[2][2][4][2], const Unit& u, int wr, int wc, int fr, int fq) const {
        const int row0 = u.pm * 256 + wr * 64 + fr, col0 = u.pn * 128 + wc * 32 + 8 * fq;
#pragma unroll
        for (int ai = 0; ai < 2; ++ai)
#pragma unroll
            for (int m = 0; m < 4; ++m) {
                bf16_t* rowp = O + (size_t)(row0 + ai * 128 + m * 16) * DFF + col0;
                const f32x4 g0 = acc[ai][0][m][0], g1 = acc[ai][0][m][1], u0 = acc[ai][1][m][0], u1 = acc[ai][1][m][1];
                u32x4 w;
                w.x = cvt_pk_bf16(siluf_(g0[0]) * u0[0], siluf_(g0[1]) * u0[1]);
                w.y = cvt_pk_bf16(siluf_(g0[2]) * u0[2], siluf_(g0[3]) * u0[3]);
                w.z = cvt_pk_bf16(siluf_(g1[0]) * u1[0], siluf_(g1[1]) * u1[1]);
                w.w = cvt_pk_bf16(siluf_(g1[2]) * u1[2], siluf_(g1[3]) * u1[3]);
                *(u32x4*)rowp = w;
                asm volatile("" ::: "memory");
            }
    }
};
struct EpiResid {
    static constexpr bool PERM = false;
    float* xlat; float* xctx; const float* gate_l; float coef;
    __device__ __forceinline__ void operator()(const f32x4 (&acc)[2][2][4][2], const Unit& u, int wr, int wc, int fr, int fq) const {
        float* base; int mod;
        if (u.pm < 128) { base = xlat + (size_t)u.pm * 256 * 1024; mod = u.pm >> 5; } else { base = xctx + (size_t)(u.pm - 128) * 256 * 1024; mod = 4; }
        const int col0 = u.pn * 256 + wc * 32 + 4 * fq;
        const float* gp = gate_l + mod * 9216 + col0;
        float* rbase = base + (size_t)(wr * 64 + fr) * 1024 + col0;
#pragma unroll
        for (int bj = 0; bj < 2; ++bj) {
            f32x4 xv[2][2][4];
#pragma unroll
            for (int n = 0; n < 2; ++n)
#pragma unroll
                for (int ai = 0; ai < 2; ++ai)
#pragma unroll
                    for (int m = 0; m < 4; ++m) xv[n][ai][m] = *(const f32x4*)(rbase + (size_t)(ai * 128 + m * 16) * 1024 + bj * 128 + n * 16);
            const f32x4 gv0 = *(const f32x4*)(gp + bj * 128) * coef, gv1 = *(const f32x4*)(gp + bj * 128 + 16) * coef;
#pragma unroll
            for (int n = 0; n < 2; ++n)
#pragma unroll
                for (int ai = 0; ai < 2; ++ai)
#pragma unroll
                    for (int m = 0; m < 4; ++m)
                        *(f32x4*)(rbase + (size_t)(ai * 128 + m * 16) * 1024 + bj * 128 + n * 16) = xv[n][ai][m] + (n == 0 ? gv0 : gv1) * acc[ai][bj][m][n];
            asm volatile("" ::: "memory");
        }
    }
};
struct EpiSlab {
    static constexpr bool PERM = false;
    float* slab;
    __device__ __forceinline__ void operator()(const f32x4 (&acc)[2][2][4][2], const Unit& u, int wr, int wc, int fr, int fq) const {
        float* base = slab + ((size_t)u.ks * NCTX + (size_t)u.pm * 256) * 1024;
        const int col0 = u.pn * 256 + wc * 32 + 4 * fq;
#pragma unroll
        for (int ai = 0; ai < 2; ++ai)
#pragma unroll
            for (int m = 0; m < 4; ++m) {
                float* rowp = base + (size_t)(wr * 64 + fr + ai * 128 + m * 16) * 1024 + col0;
#pragma unroll
                for (int bj = 0; bj < 2; ++bj)
#pragma unroll
                    for (int n = 0; n < 2; ++n) *(f32x4*)(rowp + bj * 128 + n * 16) = acc[ai][bj][m][n];
                asm volatile("" ::: "memory");
            }
    }
};
struct EpiInProj {
    static constexpr bool PERM = true;
    bf16_t* Pb; float* Pg;
    __device__ __forceinline__ void operator()(const f32x4 (&acc)[2][2][4][2], const Unit& u, int wr, int wc, int fr, int fq) const {
        const int row0 = u.pm * 256 + wr * 64 + fr;
#pragma unroll
        for (int bj = 0; bj < 2; ++bj) {
            const int c0 = u.pn * 256 + bj * 128 + wc * 32 + 8 * fq;
            int gi = -1;
            if (c0 >= 1024 && c0 < 1056) gi = c0 - 1024; else if (c0 >= 1824 && c0 < 1832) gi = 32 + c0 - 1824; else if (c0 >= 2856 && c0 < 2872) gi = 64 + c0 - 2856;
#pragma unroll
            for (int ai = 0; ai < 2; ++ai)
#pragma unroll
                for (int m = 0; m < 4; ++m) {
                    const size_t row = (size_t)(row0 + ai * 128 + m * 16);
                    const f32x4 v0 = acc[ai][bj][m][0], v1 = acc[ai][bj][m][1];
                    u32x4 w; w.x = cvt_pk_bf16(v0[0], v0[1]); w.y = cvt_pk_bf16(v0[2], v0[3]); w.z = cvt_pk_bf16(v1[0], v1[1]); w.w = cvt_pk_bf16(v1[2], v1[3]);
                    *(u32x4*)(Pb + row * NINP + c0) = w;
                    if (gi >= 0) { *(f32x4*)(Pg + row * PGW + gi) = v0; *(f32x4*)(Pg + row * PGW + gi + 4) = v1; }
                    asm volatile("" ::: "memory");
                }
        }
    }
};
struct EpiGLU {
    static constexpr bool PERM = true;
    const bf16_t* G; const float* bglu; bf16_t* O;
    __device__ __forceinline__ void operator()(const f32x4 (&acc)[2][2][4][2], const Unit& u, int wr, int wc, int fr, int fq) const {
        const int row0 = u.pm * 256 + wr * 64 + fr;
#pragma unroll
        for (int bj = 0; bj < 2; ++bj) {
            const int c0 = bj * 128 + wc * 32 + 8 * fq;
            const f32x4 bb0 = *(const f32x4*)(bglu + c0), bb1 = *(const f32x4*)(bglu + c0 + 4);
            u32x4 gw[2][4];
#pragma unroll
            for (int ai = 0; ai < 2; ++ai)
#pragma unroll
                for (int m = 0; m < 4; ++m) gw[ai][m] = *(const u32x4*)(G + (size_t)(row0 + ai * 128 + m * 16) * 256 + c0);
#pragma unroll
            for (int ai = 0; ai < 2; ++ai)
#pragma unroll
                for (int m = 0; m < 4; ++m) {
                    const size_t row = (size_t)(row0 + ai * 128 + m * 16);
                    const f32x4 v0 = acc[ai][bj][m][0] + bb0, v1 = acc[ai][bj][m][1] + bb1; const u32x4 g4 = gw[ai][m];
                    u32x4 w;
                    w.x = cvt_pk_bf16(bflo(g4.x) * sigmoidf_(v0[0]), bfhi(g4.x) * sigmoidf_(v0[1]));
                    w.y = cvt_pk_bf16(bflo(g4.y) * sigmoidf_(v0[2]), bfhi(g4.y) * sigmoidf_(v0[3]));
                    w.z = cvt_pk_bf16(bflo(g4.z) * sigmoidf_(v1[0]), bfhi(g4.z) * sigmoidf_(v1[1]));
                    w.w = cvt_pk_bf16(bflo(g4.w) * sigmoidf_(v1[2]), bfhi(g4.w) * sigmoidf_(v1[3]));
                    *(u32x4*)(O + row * 1024 + 768 + c0) = w;
                }
            asm volatile("" ::: "memory");
        }
    }
};

__device__ __forceinline__ void phase_mods(CPR P, lds_t lds) {
    const int tid = opaque_tid();
    LAS float* sc = (LAS float*)lds;
    LAS float* red = sc + 5120;
    const float* c = P.in[I_C]; const float* cc = P.in[I_CCTX]; const float* wmod = P.in[I_WMOD]; const float* bmod = P.in[I_BMOD];
    float* mods = (float*)(P.ws + WS_MODS);
    for (int i = tid; i < 5120; i += 512) { const int v = i >> 10, k = i & 1023; const float x = v < 4 ? c[v * 1024 + k] : cc[k]; sc[i] = siluf_(x); }
    __syncthreads();
    for (int item = blockIdx.x; item < 288; item += gridDim.x) {
        const int l = item / 72, col0 = (item % 72) * 128, c4 = (tid & 31) * 4, kg = tid >> 5;
        f32x4 acc[5];
#pragma unroll
        for (int v = 0; v < 5; ++v) acc[v] = (f32x4){0.f, 0.f, 0.f, 0.f};
        const float* wp = wmod + ((size_t)l * 1024 + kg * 64) * 9216 + col0 + c4;
#pragma unroll 8
        for (int kk = 0; kk < 64; ++kk) {
            const f32x4 w = *(const f32x4*)(wp + (size_t)kk * 9216);
#pragma unroll
            for (int v = 0; v < 5; ++v) { const float s = sc[v * 1024 + kg * 64 + kk]; acc[v] += w * s; }
        }
#pragma unroll
        for (int v = 0; v < 5; ++v) *(LAS f32x4*)(red + (kg * 5 + v) * 128 + c4) = acc[v];
        __syncthreads();
        for (int o = tid; o < 640; o += 512) {
            const int v = o >> 7, cx = o & 127; float s = 0.f;
#pragma unroll
            for (int k2 = 0; k2 < 16; ++k2) s += red[(k2 * 5 + v) * 128 + cx];
            mods[(size_t)(l * 5 + v) * 9216 + col0 + cx] = s + bmod[l * 9216 + col0 + cx];
        }
        __syncthreads();
    }
}

__device__ __forceinline__ void conv_tile(const float* src, int src_ld, int col0, int ncv, int k0, bf16_t* dst, int dst_ld, int drow0, LAS float* tile) {
    const int tid = opaque_tid();
    { const int r = tid >> 4, c4 = (tid & 15) * 4;
#pragma unroll
      for (int i = 0; i < 2; ++i) { const int k = r + 32 * i; f32x4 v = (f32x4){0.f, 0.f, 0.f, 0.f};
          if (c4 < ncv) v = *(const f32x4*)(src + (size_t)(k0 + k) * src_ld + col0 + c4);
          tile[k * 65 + c4 + 0] = v[0]; tile[k * 65 + c4 + 1] = v[1]; tile[k * 65 + c4 + 2] = v[2]; tile[k * 65 + c4 + 3] = v[3]; } }
    __syncthreads();
    { const int n = tid >> 3, k8 = (tid & 7) * 8; u32x4 w;
      w.x = cvt_pk_bf16(tile[(k8 + 0) * 65 + n], tile[(k8 + 1) * 65 + n]); w.y = cvt_pk_bf16(tile[(k8 + 2) * 65 + n], tile[(k8 + 3) * 65 + n]);
      w.z = cvt_pk_bf16(tile[(k8 + 4) * 65 + n], tile[(k8 + 5) * 65 + n]); w.w = cvt_pk_bf16(tile[(k8 + 6) * 65 + n], tile[(k8 + 7) * 65 + n]);
      *(u32x4*)(dst + (size_t)(drow0 + n) * dst_ld + k0 + k8) = w; }
    __syncthreads();
}
__device__ __forceinline__ void phase_convert(CPR P, lds_t lds, int l, int b0, int nb) {
    LAS float* tile = (LAS float*)lds;
    constexpr int PER_LAYER = 2 * 1408 + 2 * 704 + 832 + 256 + 16;
    for (int idx = (int)blockIdx.x - b0; idx < PER_LAYER; idx += nb) {
        int t = idx;
        if (t < 2816) {
            const int s = t / 1408; t %= 1408; const int rt = t >> 4, kt = t & 15, drow0 = rt * 64, t256 = drow0 >> 8, cc = drow0 & 255, j0 = t256 * 128 + (cc & 127);
            const int scol = (cc < 128) ? j0 : DFF + j0;
            conv_tile(P.in[I_FFNWIN] + (size_t)(l * 2 + s) * 1024 * 5632, 5632, scol, 64, kt * 64, (bf16_t*)(P.ws + WS_WFI) + (size_t)(l * 2 + s) * 5632 * 1024, 1024, drow0, tile);
        } else if (t < 4224) {
            t -= 2816; const int s = t / 704; t %= 704; const int rt = t / 44, kt = t % 44;
            conv_tile(P.in[I_FFNWOUT] + (size_t)(l * 2 + s) * DFF * 1024, 1024, rt * 64, 64, kt * 64, (bf16_t*)(P.ws + WS_WFO) + (size_t)(l * 2 + s) * 1024 * DFF, DFF, rt * 64, tile);
        } else if (t < 5056) {
            t -= 4224; const int rt = t >> 4, kt = t & 15;
            conv_tile(P.in[I_WIN] + (size_t)l * 1024 * NIN, NIN, rt * 64, NIN - rt * 64, kt * 64, (bf16_t*)(P.ws + WS_WIN) + (size_t)l * NINP * 1024, 1024, rt * 64, tile);
        } else if (t < 5312) {
            t -= 5056; const int rt = t >> 4, kt = t & 15;
            conv_tile(P.in[I_WOUT] + (size_t)l * 1024 * 1024, 1024, rt * 64, 64, kt * 64, (bf16_t*)(P.ws + WS_WOUT) + (size_t)l * 1024 * 1024, 1024, rt * 64, tile);
        } else {
            t -= 5312; const int rt = t >> 2, kt = t & 3;
            conv_tile(P.in[I_S5WGLU] + (size_t)l * 256 * 256, 256, rt * 64, 64, kt * 64, (bf16_t*)(P.ws + WS_WGLU) + (size_t)l * 256 * 256, 256, rt * 64, tile);
        }
    }
}

template <int CTRL> __device__ __forceinline__ float dpp_mov(float x) { return __int_as_float(__builtin_amdgcn_update_dpp(0, __float_as_int(x), CTRL, 0xf, 0xf, false)); }
__device__ __forceinline__ float wave_scan_add(float x, int lane) {
    const int rl = lane & 15; float t;
    t = dpp_mov<0x111>(x) + x; if (rl >= 1) x = t;
    t = dpp_mov<0x112>(x) + x; if (rl >= 2) x = t;
    t = dpp_mov<0x114>(x) + x; if (rl >= 4) x = t;
    t = dpp_mov<0x118>(x) + x; if (rl >= 8) x = t;
    t = dpp_mov<0x142>(x) + x; if ((lane & 31) >= 16) x = t;
    t = dpp_mov<0x143>(x) + x; if (lane >= 32) x = t;
    return x;
}
__device__ __forceinline__ float wave_scan_max(float x, int lane) {
    const int rl = lane & 15; float t;
    t = fmaxf(dpp_mov<0x111>(x), x); if (rl >= 1) x = t;
    t = fmaxf(dpp_mov<0x112>(x), x); if (rl >= 2) x = t;
    t = fmaxf(dpp_mov<0x114>(x), x); if (rl >= 4) x = t;
    t = fmaxf(dpp_mov<0x118>(x), x); if (rl >= 8) x = t;
    t = fmaxf(dpp_mov<0x142>(x), x); if ((lane & 31) >= 16) x = t;
    t = fmaxf(dpp_mov<0x143>(x), x); if (lane >= 32) x = t;
    return x;
}

__device__ __forceinline__ float row16_sum(float s) { s += dpp_mov<0xB1>(s); s += dpp_mov<0x4E>(s); s += dpp_mov<0x124>(s); s += dpp_mov<0x128>(s); return s; }
__device__ __forceinline__ float wave_sum(float s) { s = row16_sum(s);
    const int si = __float_as_int(s);
    return __int_as_float(__builtin_amdgcn_readlane(si, 0)) + __int_as_float(__builtin_amdgcn_readlane(si, 16)) + __int_as_float(__builtin_amdgcn_readlane(si, 32)) + __int_as_float(__builtin_amdgcn_readlane(si, 48)); }

__device__ __forceinline__ void phase_modnorm(CPR P, int l, int j, bool first) {
    const int jp = (j + 2) % 3, lp = (j == 0) ? l - 1 : l, nks = first ? 0 : (jp == 1 ? 4 : 11); const float coefp = (jp == 1) ? 1.0f : 0.5f;
    const float* slab = (const float*)(P.ws + WS_SLAB);
    const float* gatep = (const float*)(P.ws + WS_MODS) + (size_t)(lp < 0 ? 0 : lp) * 5 * 9216 + 4 * 9216 + (3 * jp + 2) * 1024;
    const int tid_ = opaque_tid(); const int lane = tid_ & 63, wid = tid_ >> 6;
    const float* mods_l = (const float*)(P.ws + WS_MODS) + (size_t)l * 5 * 9216;
    const float* gn = P.in[I_GNORM] + (size_t)(l * 3 + j) * 1024;
    float* xctx = (float*)(P.ws + WS_CTXX);
    bf16_t* H = (bf16_t*)(P.ws + WS_H);
    const float* xlat_src = first ? P.in[I_X] : P.out; const float* xctx_src = first ? P.in[I_CTX] : xctx;
    f32x4 gv[4], sh[4], scl[4], xn[4];
#pragma unroll
    for (int i = 0; i < 4; ++i) { gv[i] = *(const f32x4*)(gn + lane * 4 + 256 * i); sh[i] = gv[i]; scl[i] = gv[i]; xn[i] = gv[i]; }
    const int stride = gridDim.x * 8; int row = blockIdx.x * 8 + wid; int curmod = -1;
#define MN_LOAD(r_) do { const float* s_ = ((r_) < NLAT) ? xlat_src + (size_t)(r_) * 1024 : xctx_src + (size_t)((r_) - NLAT) * 1024; \
        _Pragma("unroll") for (int i_ = 0; i_ < 4; ++i_) xn[i_] = *(const f32x4*)(s_ + lane * 4 + 256 * i_); } while (0)
    if (row < NT) MN_LOAD(row);
    for (; row < NT; row += stride) {
        float* dst; int mod;
        if (row < NLAT) { dst = P.out + (size_t)row * 1024; mod = row >> 13; } else { dst = xctx + (size_t)(row - NLAT) * 1024; mod = 4; }
        f32x4 xv[4];
#pragma unroll
        for (int i = 0; i < 4; ++i) xv[i] = xn[i];
        if (row + stride < NT) MN_LOAD(row + stride);
        if (row >= NLAT && nks > 0) {
#pragma unroll
            for (int i = 0; i < 4; ++i) {
                f32x4 s = (f32x4){0.f, 0.f, 0.f, 0.f};
                for (int ks = 0; ks < nks; ++ks) s += *(const f32x4*)(slab + ((size_t)ks * NCTX + (row - NLAT)) * 1024 + lane * 4 + 256 * i);
                xv[i] += *(const f32x4*)(gatep + lane * 4 + 256 * i) * coefp * s;
                *(f32x4*)(dst + lane * 4 + 256 * i) = xv[i];
            }
        }
        float ss = 0.f;
#pragma unroll
        for (int i = 0; i < 4; ++i) ss += xv[i][0] * xv[i][0] + xv[i][1] * xv[i][1] + xv[i][2] * xv[i][2] + xv[i][3] * xv[i][3];
        if (first) {
#pragma unroll
            for (int i = 0; i < 4; ++i) *(f32x4*)(dst + lane * 4 + 256 * i) = xv[i];
        }
        if (mod != curmod) {
            const float* mp = mods_l + (size_t)mod * 9216 + (3 * j) * 1024;
#pragma unroll
            for (int i = 0; i < 4; ++i) { sh[i] = *(const f32x4*)(mp + lane * 4 + 256 * i); scl[i] = *(const f32x4*)(mp + 1024 + lane * 4 + 256 * i) + 1.0f; }
            curmod = mod;
        }
        const float rstd = rsqrtf(wave_sum(ss) * (1.0f / 1024.0f) + EPS);
#pragma unroll
        for (int i = 0; i < 4; ++i) {
            const f32x4 hv = xv[i] * rstd * gv[i] * scl[i] + sh[i];
            u32x2 w; w.x = cvt_pk_bf16(hv[0], hv[1]); w.y = cvt_pk_bf16(hv[2], hv[3]);
            *(u32x2*)(H + (size_t)row * 1024 + lane * 4 + 256 * i) = w;
        }
    }
#undef MN_LOAD
}
__device__ __forceinline__ void phase_final(CPR P) {
    const int tid_ = opaque_tid(); const int lane = tid_ & 63, wid = tid_ >> 6;
    const float* gn = P.in[I_GFINAL];
    f32x4 gv[4];
#pragma unroll
    for (int i = 0; i < 4; ++i) gv[i] = *(const f32x4*)(gn + lane * 4 + 256 * i);
    for (int row = blockIdx.x * 8 + wid; row < NLAT; row += gridDim.x * 8) {
        float* p = P.out + (size_t)row * 1024;
        f32x4 xv[4]; float ss = 0.f;
#pragma unroll
        for (int i = 0; i < 4; ++i) { xv[i] = *(const f32x4*)(p + lane * 4 + 256 * i); ss += xv[i][0] * xv[i][0] + xv[i][1] * xv[i][1] + xv[i][2] * xv[i][2] + xv[i][3] * xv[i][3]; }
        const float rstd = rsqrtf(wave_sum(ss) * (1.0f / 1024.0f) + EPS);
#pragma unroll
        for (int i = 0; i < 4; ++i) *(f32x4*)(p + lane * 4 + 256 * i) = xv[i] * rstd * gv[i];
    }
}

__device__ __forceinline__ void scan_gla(CPR P, int l, int b, int h, int dir, lds_t lds) {
    const int tid = opaque_tid(), lane = tid & 63, wid = tid >> 6, fr = lane & 15, fq = lane >> 4;
    const bf16_t* PB = (const bf16_t*)(P.ws + WS_PB); const float* PG = (const float*)(P.ws + WS_PG);
    bf16_t* OUT = (bf16_t*)(P.ws + (dir ? WS_H2 : WS_H));
    lds_t QR = lds, KR = lds + 9216, VT = lds + 18432, QT = lds + 27648, KT = lds + 36864, KWT = lds + 46080, ATT = lds + 55296, ST = lds + 64512;
    LAS float* LR = (LAS float*)(lds + 73728); LAS float* TOT = (LAS float*)(lds + 77824); LAS float* DEC = (LAS float*)(lds + 79872);
    const int d = tid & 63, o = tid >> 6;
    float wreg[16];
#pragma unroll
    for (int r = 0; r < 16; ++r) wreg[r] = P.in[I_GLAW][(size_t)((l * 2 + dir) * 16 + r) * 256 + h * 64 + d];
    const float bias = P.in[I_GLAB][(l * 2 + dir) * 256 + h * 64 + d];
    for (int i = tid; i < 9216 / 4; i += 512) ((LAS unsigned*)ST)[i] = 0u;
    f32x4 sacc[2] = {(f32x4){0.f, 0.f, 0.f, 0.f}, (f32x4){0.f, 0.f, 0.f, 0.f}};
    const int tm = wid >> 1, tn0 = (wid & 1) * 2;
    __syncthreads();
    u32x4 q8, k8, v8; f32x4 lr4 = (f32x4){0.f, 0.f, 0.f, 0.f};
#define GLA_ISSUE(cc_) do { const int sg_ = (cc_) >= 4, c_ = sg_ ? (cc_) - 4 : (cc_), L_ = sg_ ? SEQ : CTXL; const int t_ = tid >> 3, c8_ = tid & 7; const int lp_ = c_ * 64 + t_, p_ = dir ? (L_ - 1 - lp_) : lp_; \
        const bf16_t* pr_ = PB + (size_t)tok_row(sg_, b, p_, false) * NINP + h * 64 + c8_ * 8; \
        q8 = *(const u32x4*)(pr_ + GLA_Q); k8 = *(const u32x4*)(pr_ + GLA_K); v8 = *(const u32x4*)(pr_ + GLA_V); \
        { const int t2_ = (tid & 255) >> 2, r4_ = tid & 3; const int lp2_ = c_ * 64 + t2_, p2_ = dir ? (L_ - 1 - lp2_) : lp2_; \
            lr4 = *(const f32x4*)(PG + (size_t)tok_row(sg_, b, p2_, false) * PGW + dir * 16 + r4_ * 4); } } while (0)
    constexpr int D_GA = 80384, D_LR = 108032 - 73728;
#define GLA_STAGE(pp_) do { lds_t QRp_ = QR + (pp_) * D_GA; lds_t KRp_ = KR + (pp_) * D_GA; lds_t VTp_ = VT + (pp_) * D_GA; LAS float* LRp_ = LR + (pp_) * (D_LR / 4); \
        asm volatile("s_waitcnt vmcnt(0)" ::: "memory"); \
        { const int t_ = tid >> 3, c8_ = tid & 7; \
          *(LAS u32x4*)(QRp_ + t_ * LDT + c8_ * 16) = q8; *(LAS u32x4*)(KRp_ + t_ * LDT + c8_ * 16) = k8; \
          _Pragma("unroll") for (int i_ = 0; i_ < 4; ++i_) { *(LAS bf16_t*)(VTp_ + (c8_ * 8 + 2 * i_) * LDT + t_ * 2) = (bf16_t)(v8[i_] & 0xffffu); *(LAS bf16_t*)(VTp_ + (c8_ * 8 + 2 * i_ + 1) * LDT + t_ * 2) = (bf16_t)(v8[i_] >> 16); } \
          if (tid < 256) { const int t2_ = tid >> 2, r4_ = tid & 3; *(LAS f32x4*)(LRp_ + t2_ * 16 + r4_ * 4) = lr4; } } } while (0)
    GLA_ISSUE(0);
    GLA_STAGE(0);
    GLA_ISSUE(1);
    __syncthreads();
#pragma unroll 1
    for (int cc = 0; cc < 132; ++cc) {
        {
            const int seg = cc >= 4, c = seg ? cc - 4 : cc, L = seg ? SEQ : CTXL; const int pb = cc & 1;
            lds_t QRc = QR + pb * D_GA; lds_t KRc = KR + pb * D_GA; lds_t VTc = VT + pb * D_GA; LAS float* LRc = LR + pb * (D_LR / 4);
            float bl[8]; float run = 0.f;
#pragma unroll
            for (int i = 0; i < 8; ++i) {
                const int t = o * 8 + i; float dot = bias;
#pragma unroll
                for (int r4 = 0; r4 < 4; ++r4) { const f32x4 x = *(const LAS f32x4*)(LRc + t * 16 + r4 * 4); dot += x[0] * wreg[4 * r4] + x[1] * wreg[4 * r4 + 1] + x[2] * wreg[4 * r4 + 2] + x[3] * wreg[4 * r4 + 3]; }
                run += logsigf_(dot) * (1.0f / 16.0f); bl[i] = run;
            }
            TOT[o * 64 + d] = run;
            __syncthreads();
            {
                float pre = 0.f, tot = 0.f;
#pragma unroll
                for (int o2 = 0; o2 < 8; ++o2) { const float v = TOT[o2 * 64 + d]; if (o2 < o) pre += v; tot += v; }
                float kw[8]; const float et = __expf(tot);
#pragma unroll
                for (int i = 0; i < 8; ++i) {
                    const int t = o * 8 + i; const float bb = pre + bl[i]; const float enb = __expf(-bb);
                    const float qv = bf2f(*(const LAS bf16_t*)(QRc + t * LDT + d * 2)), kv = bf2f(*(const LAS bf16_t*)(KRc + t * LDT + d * 2));
                    *(LAS bf16_t*)(QT + t * LDT + d * 2) = f2bf(qv * 0.125f * __expf(bb));
                    *(LAS bf16_t*)(KT + t * LDT + d * 2) = f2bf(kv * enb);
                    kw[i] = kv * (et * enb);
                }
                u32x4 w; w.x = cvt_pk_bf16(kw[0], kw[1]); w.y = cvt_pk_bf16(kw[2], kw[3]); w.z = cvt_pk_bf16(kw[4], kw[5]); w.w = cvt_pk_bf16(kw[6], kw[7]);
                *(LAS u32x4*)(KWT + d * LDT + o * 16) = w;
                if (o == 0) DEC[d] = et;
            }
            __syncthreads();
            f32x4 oacc[2];
#pragma unroll
            for (int i = 0; i < 2; ++i) {
                const int tn = tn0 + i; f32x4 a = (f32x4){0.f, 0.f, 0.f, 0.f};
                mma_tile<true, 2, LDT, LDT>(a, QT, tm * 16, KT, tn * 16, fr, fq);
                const int t = tm * 16 + fr, s0 = tn * 16 + fq * 4;
#pragma unroll
                for (int jx = 0; jx < 4; ++jx) a[jx] = (s0 + jx <= t) ? a[jx] : 0.f;
                u32x2 w; w.x = cvt_pk_bf16(a[0], a[1]); w.y = cvt_pk_bf16(a[2], a[3]);
                *(LAS u32x2*)(ATT + t * LDT + s0 * 2) = w;
                oacc[i] = (f32x4){0.f, 0.f, 0.f, 0.f};
                mma_tile<true, 2, LDT, LDT>(oacc[i], QT, tm * 16, ST, tn * 16, fr, fq);
            }
            __syncthreads();
            {
                const int t = tm * 16 + fr; const int lp = c * 64 + t, p = dir ? (L - 1 - lp) : lp;
                bf16_t* orow = OUT + (size_t)tok_row(seg, b, p, false) * 1024 + 0 + h * 64;
#pragma unroll
                for (int i = 0; i < 2; ++i) {
                    const int tn = tn0 + i;
                    mma_tile<true, 2, LDT, LDT>(oacc[i], ATT, tm * 16, VTc, tn * 16, fr, fq);
                    u32x2 w; w.x = cvt_pk_bf16(oacc[i][0], oacc[i][1]); w.y = cvt_pk_bf16(oacc[i][2], oacc[i][3]);
                    *(u32x2*)(orow + tn * 16 + fq * 4) = w;
                }
                const f32x4 dv = *(const LAS f32x4*)(DEC + tm * 16 + fq * 4);
#pragma unroll
                for (int i = 0; i < 2; ++i) {
                    const int tn = tn0 + i;
                    sacc[i] *= dv;
                    mma_tile<false, 2, LDT, LDT>(sacc[i], KWT, tm * 16, VTc, tn * 16, fr, fq);
                    u32x2 w; w.x = cvt_pk_bf16(sacc[i][0], sacc[i][1]); w.y = cvt_pk_bf16(sacc[i][2], sacc[i][3]);
                    *(LAS u32x2*)(ST + (tn * 16 + fr) * LDT + (tm * 16 + fq * 4) * 2) = w;
                }
            }
            if (cc + 1 < 132) { GLA_STAGE(pb ^ 1); if (cc + 2 < 132) GLA_ISSUE(cc + 2); }
            __syncthreads();
        }
    }
}

__device__ __forceinline__ void scan_ssd(CPR P, int l, int b, int h, int dir, lds_t lds) {
    const int tid = opaque_tid(), lane = tid & 63, wid = tid >> 6, fr = lane & 15, fq = lane >> 4;
    const bf16_t* PB = (const bf16_t*)(P.ws + WS_PB); const float* PG = (const float*)(P.ws + WS_PG);
    bf16_t* OUT = (bf16_t*)(P.ws + (dir ? WS_H2 : WS_H));
    lds_t CM = lds, BM = lds + 9216, XT = lds + 18432, BWT = lds + 27648, SC = lds + 36864, ST = lds + 46080, XS = lds + 55296, RAW = lds + 64512;
    LAS float* CUM = (LAS float*)(lds + 90912); LAS float* DTV = (LAS float*)(lds + 91168); LAS float* EWV = (LAS float*)(lds + 91424);
    constexpr int RS = 400;
    const int d = tid & 63, o = tid >> 6, g2 = h >> 1;
    const float* cw = P.in[I_SSDCW] + (size_t)l * 3 * 512; const float* cb = P.in[I_SSDCB] + (size_t)l * 512;
    const int chv[3] = {h * 64 + d, 256 + g2 * 64 + d, 384 + g2 * 64 + d};
    float w0[3], w1[3], w2[3], wb[3];
#pragma unroll
    for (int g = 0; g < 3; ++g) { w0[g] = cw[(dir ? 2 : 0) * 512 + chv[g]]; w1[g] = cw[512 + chv[g]]; w2[g] = cw[(dir ? 0 : 2) * 512 + chv[g]]; wb[g] = cb[chv[g]]; }
    const float dtb = P.in[I_SSDDTB][(l * 2 + dir) * 4 + h], nega = -__expf(P.in[I_SSDALOG][(l * 2 + dir) * 4 + h]), dsk = P.in[I_SSDD][l * 4 + h]; const float dskv = dir == 0 ? dsk : 0.f;
    for (int i = tid; i < 9216 / 4; i += 512) ((LAS unsigned*)ST)[i] = 0u;
    f32x4 sacc[2] = {(f32x4){0.f, 0.f, 0.f, 0.f}, (f32x4){0.f, 0.f, 0.f, 0.f}};
    const int tm = wid >> 1, tn0 = (wid & 1) * 2;
    __syncthreads();
    u32x4 rw[4]; float dtraw = 0.f;
#define SSD_LD(dst_, lp_) do { int lpp_ = (lp_); lpp_ = lpp_ < 0 ? 0 : (lpp_ >= L_ ? L_ - 1 : lpp_); const int p_ = dir ? (L_ - 1 - lpp_) : lpp_; \
        const int col_ = cgp_ == 0 ? SSD_X + h * 64 : (cgp_ == 1 ? SSD_B + g2 * 64 : SSD_C + g2 * 64); dst_ = *(const u32x4*)(PB + (size_t)tok_row(sg_, b, p_, true) * NINP + col_ + c8_ * 8); } while (0)
#define SSD_ISSUE(cc_) do { const int sg_ = (cc_) >= 4, c_ = sg_ ? (cc_) - 4 : (cc_), L_ = sg_ ? SEQ : CTXL; \
        _Pragma("unroll") for (int k_ = 0; k_ < 3; ++k_) { const int idx_ = tid + 512 * k_; const int rr_ = idx_ / 24, rem_ = idx_ % 24, cgp_ = rem_ >> 3, c8_ = rem_ & 7; SSD_LD(rw[k_], c_ * 64 + rr_); } \
        { const int th_ = tid % 48; const int rr_ = th_ / 24, rem_ = th_ % 24, cgp_ = rem_ >> 3, c8_ = rem_ & 7; SSD_LD(rw[3], c_ * 64 + (rr_ ? 64 : -1)); } \
        { const int lp_ = c_ * 64 + lane, p_ = dir ? (L_ - 1 - lp_) : lp_; dtraw = PG[(size_t)tok_row(sg_, b, p_, true) * PGW + 32 + dir * 4 + h]; } } while (0)
    constexpr int D_SB = 91904 - 64512;
#define SSD_STAGE(cn_, pp_) do { const int sgS_ = (cn_) >= 4, cS_ = sgS_ ? (cn_) - 4 : (cn_), LS_ = sgS_ ? SEQ : CTXL; \
        lds_t RAWp_ = RAW + (pp_) * D_SB; LAS float* CUMp_ = CUM + (pp_) * (D_SB / 4); LAS float* DTVp_ = DTV + (pp_) * (D_SB / 4); LAS float* EWVp_ = EWV + (pp_) * (D_SB / 4); \
        asm volatile("s_waitcnt vmcnt(0)" ::: "memory"); \
        _Pragma("unroll") for (int k_ = 0; k_ < 3; ++k_) { const int idx_ = tid + 512 * k_; const int rr_ = idx_ / 24, rem_ = idx_ % 24, cgp_ = rem_ >> 3, c8_ = rem_ & 7; *(LAS u32x4*)(RAWp_ + (rr_ + 1) * RS + cgp_ * 128 + c8_ * 16) = rw[k_]; } \
        if (tid < 48) { const int rr_ = tid / 24, rem_ = tid % 24, cgp_ = rem_ >> 3, c8_ = rem_ & 7; const int lph_ = cS_ * 64 + (rr_ ? 64 : -1); \
            *(LAS u32x4*)(RAWp_ + (rr_ ? 65 : 0) * RS + cgp_ * 128 + c8_ * 16) = (lph_ >= 0 && lph_ < LS_) ? rw[3] : (u32x4){0u, 0u, 0u, 0u}; } \
        if (wid == 0) { const float dt_ = softplusf_(dtraw + dtb); const float cum_ = wave_scan_add(dt_ * nega, lane); DTVp_[lane] = dt_; CUMp_[lane] = cum_; \
            const float clv_ = __int_as_float(__builtin_amdgcn_readlane(__float_as_int(cum_), 63)); EWVp_[lane] = __expf(clv_ - cum_); } } while (0)
    SSD_ISSUE(0);
    SSD_STAGE(0, 0);
    SSD_ISSUE(1);
    __syncthreads();
#pragma unroll 1
    for (int cc = 0; cc < 132; ++cc) {
        {
            const int seg = cc >= 4, c = seg ? cc - 4 : cc, L = seg ? SEQ : CTXL; const int pb = cc & 1;
            lds_t RAWc = RAW + pb * D_SB; LAS float* CUMc = CUM + pb * (D_SB / 4); LAS float* DTVc = DTV + pb * (D_SB / 4); LAS float* EWVc = EWV + pb * (D_SB / 4);
            {
                float xt[8], bw[8];
#pragma unroll
                for (int g = 0; g < 3; ++g) {
                    float prev = bf2f(*(const LAS bf16_t*)(RAWc + (o * 8 + 0) * RS + g * 128 + d * 2)), cur = bf2f(*(const LAS bf16_t*)(RAWc + (o * 8 + 1) * RS + g * 128 + d * 2));
#pragma unroll
                    for (int i = 0; i < 8; ++i) {
                        const int t = o * 8 + i; const float nxt = bf2f(*(const LAS bf16_t*)(RAWc + (t + 2) * RS + g * 128 + d * 2)); const float dtv_ = DTVc[t], ewv_ = EWVc[t];
                        const float v = siluf_(w0[g] * prev + w1[g] * cur + w2[g] * nxt + wb[g]); prev = cur; cur = nxt;
                        if (g == 0) { *(LAS bf16_t*)(XS + t * LDT + d * 2) = f2bf(v); xt[i] = v * dtv_; }
                        else if (g == 1) { *(LAS bf16_t*)(BM + t * LDT + d * 2) = f2bf(v); bw[i] = v * ewv_; }
                        else { *(LAS bf16_t*)(CM + t * LDT + d * 2) = f2bf(v); }
                    }
                }
                u32x4 w; w.x = cvt_pk_bf16(xt[0], xt[1]); w.y = cvt_pk_bf16(xt[2], xt[3]); w.z = cvt_pk_bf16(xt[4], xt[5]); w.w = cvt_pk_bf16(xt[6], xt[7]);
                *(LAS u32x4*)(XT + d * LDT + o * 16) = w;
                w.x = cvt_pk_bf16(bw[0], bw[1]); w.y = cvt_pk_bf16(bw[2], bw[3]); w.z = cvt_pk_bf16(bw[4], bw[5]); w.w = cvt_pk_bf16(bw[6], bw[7]);
                *(LAS u32x4*)(BWT + d * LDT + o * 16) = w;
            }
            __syncthreads();
            f32x4 yacc[2];
            {
                const int t = tm * 16 + fr; const float ct = CUMc[t]; const float ect = __expf(ct);
#pragma unroll
                for (int i = 0; i < 2; ++i) {
                    const int tn = tn0 + i; f32x4 a = (f32x4){0.f, 0.f, 0.f, 0.f};
                    mma_tile<true, 2, LDT, LDT>(a, CM, tm * 16, BM, tn * 16, fr, fq);
                    const int s0 = tn * 16 + fq * 4; const f32x4 cs = *(const LAS f32x4*)(CUMc + s0);
#pragma unroll
                    for (int jx = 0; jx < 4; ++jx) a[jx] = (s0 + jx <= t) ? a[jx] * __expf(ct - cs[jx]) : 0.f;
                    u32x2 w; w.x = cvt_pk_bf16(a[0], a[1]); w.y = cvt_pk_bf16(a[2], a[3]);
                    *(LAS u32x2*)(SC + t * LDT + s0 * 2) = w;
                    yacc[i] = (f32x4){0.f, 0.f, 0.f, 0.f};
                    mma_tile<true, 2, LDT, LDT>(yacc[i], CM, tm * 16, ST, tn * 16, fr, fq);
                    yacc[i] *= ect;
                }
            }
            __syncthreads();
            {
                const int t = tm * 16 + fr; const int lp = c * 64 + t, p = dir ? (L - 1 - lp) : lp;
                bf16_t* orow = OUT + (size_t)tok_row(seg, b, p, true) * 1024 + 256 + h * 64;
#pragma unroll
                for (int i = 0; i < 2; ++i) {
                    const int tn = tn0 + i, p0 = tn * 16 + fq * 4;
                    mma_tile<true, 2, LDT, LDT>(yacc[i], SC, tm * 16, XT, tn * 16, fr, fq);
                    {
                        const u32x2 xs = *(const LAS u32x2*)(XS + t * LDT + p0 * 2);
                        yacc[i][0] += dskv * bflo(xs.x); yacc[i][1] += dskv * bfhi(xs.x); yacc[i][2] += dskv * bflo(xs.y); yacc[i][3] += dskv * bfhi(xs.y); }
                    u32x2 w; w.x = cvt_pk_bf16(yacc[i][0], yacc[i][1]); w.y = cvt_pk_bf16(yacc[i][2], yacc[i][3]);
                    *(u32x2*)(orow + p0) = w;
                }
                const float ecl_in = CUMc[63]; const float ecl = __expf(ecl_in);
#pragma unroll
                for (int i = 0; i < 2; ++i) {
                    const int tn = tn0 + i;
                    sacc[i] *= ecl;
                    mma_tile<false, 2, LDT, LDT>(sacc[i], BWT, tm * 16, XT, tn * 16, fr, fq);
                    u32x2 w; w.x = cvt_pk_bf16(sacc[i][0], sacc[i][1]); w.y = cvt_pk_bf16(sacc[i][2], sacc[i][3]);
                    *(LAS u32x2*)(ST + (tn * 16 + fr) * LDT + (tm * 16 + fq * 4) * 2) = w;
                }
            }
            if (cc + 1 < 132) { SSD_STAGE(cc + 1, pb ^ 1); if (cc + 2 < 132) SSD_ISSUE(cc + 2); }
            __syncthreads();
        }
    }
}

__device__ __forceinline__ void scan_mlstm(CPR P, int l, int b, int h, int dir, lds_t lds) {
    const int tid = opaque_tid(), lane = tid & 63, wid = tid >> 6, fr = lane & 15, fq = lane >> 4;
    const bf16_t* PB = (const bf16_t*)(P.ws + WS_PB); const float* PG = (const float*)(P.ws + WS_PG);
    bf16_t* OUT = (bf16_t*)(P.ws + (dir ? WS_H2 : WS_H));
    lds_t QM = lds, KM = lds + 9216, KWT = lds + 18432, WM = lds + 27648, VT = lds + 36864, CT = lds + 48384, RAW = lds + 59904;
    LAS float* FV = (LAS float*)(lds + 77856); LAS float* AV = (LAS float*)(lds + 78112); LAS float* MV = (LAS float*)(lds + 78368); LAS float* DEN = (LAS float*)(lds + 78624); LAS float* KWE = (LAS float*)(lds + 79648);
    constexpr int RS = 272;
    const int d = tid & 63, o = tid >> 6;
    const float* cw = P.in[I_MLCW] + (size_t)l * 3 * 512; const float* cb = P.in[I_MLCB] + (size_t)l * 512;
    const int chv[2] = {h * 64 + d, 256 + h * 64 + d};
    float w0[2], w1[2], w2[2], wb[2];
#pragma unroll
    for (int g = 0; g < 2; ++g) { w0[g] = cw[(dir ? 2 : 0) * 512 + chv[g]]; w1[g] = cw[512 + chv[g]]; w2[g] = cw[(dir ? 0 : 2) * 512 + chv[g]]; wb[g] = cb[chv[g]]; }
    const float gbi = P.in[I_MLGB][l * 16 + dir * 8 + h], gbf = P.in[I_MLGB][l * 16 + dir * 8 + 4 + h];
    for (int i = tid; i < 11520 / 4; i += 512) ((LAS unsigned*)CT)[i] = 0u;
    constexpr int D_VT = 80000 - 36864, D_RAW = 91520 - 59904, D_G = 31744;
    for (int i = tid; i < 16 * LDT / 4; i += 512) { const unsigned v = (i < LDT / 4) ? 0x3F803F80u : 0u; ((LAS unsigned*)(VT + 64 * LDT))[i] = v; ((LAS unsigned*)(VT + D_VT + 64 * LDT))[i] = v; }
    f32x4 cacc[3] = {(f32x4){0.f, 0.f, 0.f, 0.f}, (f32x4){0.f, 0.f, 0.f, 0.f}, (f32x4){0.f, 0.f, 0.f, 0.f}};
    float m_s = 0.f;
    const int tm = wid >> 1, tn0 = (wid & 1) * 2; const bool extra = (wid & 1) == 0;
    __syncthreads();
    u32x4 rw[3], v8; float graw_i = 0.f, graw_f = 0.f;
#define ML_LD(dst_, lp_) do { int lpp_ = (lp_); lpp_ = lpp_ < 0 ? 0 : (lpp_ >= L_ ? L_ - 1 : lpp_); const int p_ = dir ? (L_ - 1 - lpp_) : lpp_; \
        dst_ = *(const u32x4*)(PB + (size_t)tok_row(sg_, b, p_, false) * NINP + ML_Q + cgp_ * 256 + h * 64 + c8_ * 8); } while (0)
#define ML_ISSUE(cc_) do { const int sg_ = (cc_) >= 4, c_ = sg_ ? (cc_) - 4 : (cc_), L_ = sg_ ? SEQ : CTXL; \
        _Pragma("unroll") for (int k_ = 0; k_ < 2; ++k_) { const int idx_ = tid + 512 * k_; const int rr_ = idx_ >> 4, rem_ = idx_ & 15, cgp_ = rem_ >> 3, c8_ = rem_ & 7; ML_LD(rw[k_], c_ * 64 + rr_); } \
        { const int th_ = tid & 31; const int rr_ = th_ >> 4, rem_ = th_ & 15, cgp_ = rem_ >> 3, c8_ = rem_ & 7; ML_LD(rw[2], c_ * 64 + (rr_ ? 64 : -1)); } \
        { const int t_ = tid >> 3, c8_ = tid & 7; const int lp_ = c_ * 64 + t_, p_ = dir ? (L_ - 1 - lp_) : lp_; v8 = *(const u32x4*)(PB + (size_t)tok_row(sg_, b, p_, false) * NINP + ML_V + h * 64 + c8_ * 8); } \
        { const int lp_ = c_ * 64 + lane, p_ = dir ? (L_ - 1 - lp_) : lp_; const float* pg_ = PG + (size_t)tok_row(sg_, b, p_, false) * PGW + 64 + dir * 8 + h; graw_i = pg_[0]; graw_f = pg_[4]; } } while (0)
#define ML_STAGE(cn_, pp_) do { const int sgS_ = (cn_) >= 4, cS_ = sgS_ ? (cn_) - 4 : (cn_), LS_ = sgS_ ? SEQ : CTXL; \
        lds_t RAWp_ = RAW + (pp_) * D_RAW; lds_t VTp_ = VT + (pp_) * D_VT; LAS float* FVp_ = FV + (pp_) * (D_G / 4); LAS float* AVp_ = AV + (pp_) * (D_G / 4); LAS float* MVp_ = MV + (pp_) * (D_G / 4); LAS float* KWEp_ = KWE + (pp_) * (D_G / 4); \
        asm volatile("s_waitcnt vmcnt(0)" ::: "memory"); \
        _Pragma("unroll") for (int k_ = 0; k_ < 2; ++k_) { const int idx_ = tid + 512 * k_; const int rr_ = idx_ >> 4, rem_ = idx_ & 15, cgp_ = rem_ >> 3, c8_ = rem_ & 7; *(LAS u32x4*)(RAWp_ + (rr_ + 1) * RS + cgp_ * 128 + c8_ * 16) = rw[k_]; } \
        if (tid < 32) { const int rr_ = tid >> 4, rem_ = tid & 15, cgp_ = rem_ >> 3, c8_ = rem_ & 7; const int lph_ = cS_ * 64 + (rr_ ? 64 : -1); \
            *(LAS u32x4*)(RAWp_ + (rr_ ? 65 : 0) * RS + cgp_ * 128 + c8_ * 16) = (lph_ >= 0 && lph_ < LS_) ? rw[2] : (u32x4){0u, 0u, 0u, 0u}; } \
        { const int t_ = tid >> 3, c8_ = tid & 7; \
          _Pragma("unroll") for (int i_ = 0; i_ < 4; ++i_) { *(LAS bf16_t*)(VTp_ + (c8_ * 8 + 2 * i_) * LDT + t_ * 2) = (bf16_t)(v8[i_] & 0xffffu); *(LAS bf16_t*)(VTp_ + (c8_ * 8 + 2 * i_ + 1) * LDT + t_ * 2) = (bf16_t)(v8[i_] >> 16); } } \
        if (wid == 0) { const float ig_ = graw_i + gbi, lf_ = logsigf_(graw_f + gbf); \
            const float F_ = wave_scan_add(lf_, lane); const float a_ = ig_ - F_; const float M_ = fmaxf(wave_scan_max(a_, lane), m_s); \
            FVp_[lane] = F_; AVp_[lane] = a_; MVp_[lane] = M_; \
            const float m63_ = __int_as_float(__builtin_amdgcn_readlane(__float_as_int(M_), 63)); KWEp_[lane] = __expf(a_ - m63_); } } while (0)
    ML_ISSUE(0);
    ML_STAGE(0, 0);
    ML_ISSUE(1);
    __syncthreads();
#pragma unroll 1
    for (int cc = 0; cc < 132; ++cc) {
        {
            const int seg = cc >= 4, c = seg ? cc - 4 : cc, L = seg ? SEQ : CTXL; const int pb = cc & 1;
            lds_t RAWc = RAW + pb * D_RAW; lds_t VTc = VT + pb * D_VT; LAS float* FVc = FV + pb * (D_G / 4); LAS float* AVc = AV + pb * (D_G / 4); LAS float* MVc = MV + pb * (D_G / 4); LAS float* KWEc = KWE + pb * (D_G / 4);
            {
                float kw[8];
#pragma unroll
                for (int g = 0; g < 2; ++g) {
                    float prev = bf2f(*(const LAS bf16_t*)(RAWc + (o * 8 + 0) * RS + g * 128 + d * 2)), cur = bf2f(*(const LAS bf16_t*)(RAWc + (o * 8 + 1) * RS + g * 128 + d * 2));
#pragma unroll
                    for (int i = 0; i < 8; ++i) {
                        const int t = o * 8 + i; const float nxt = bf2f(*(const LAS bf16_t*)(RAWc + (t + 2) * RS + g * 128 + d * 2));
                        const float v = siluf_(w0[g] * prev + w1[g] * cur + w2[g] * nxt + wb[g]); prev = cur; cur = nxt;
                        if (g == 0) { *(LAS bf16_t*)(QM + t * LDT + d * 2) = f2bf(v); }
                        else { const float kk = v * 0.125f; *(LAS bf16_t*)(KM + t * LDT + d * 2) = f2bf(kk); kw[i] = kk * KWEc[t]; }
                    }
                }
                u32x4 w; w.x = cvt_pk_bf16(kw[0], kw[1]); w.y = cvt_pk_bf16(kw[2], kw[3]); w.z = cvt_pk_bf16(kw[4], kw[5]); w.w = cvt_pk_bf16(kw[6], kw[7]);
                *(LAS u32x4*)(KWT + d * LDT + o * 16) = w;
            }
            __syncthreads();
            f32x4 hacc[3];
            const int trow = tm * 16 + fr; const float Mt = MVc[trow];
            {
                const float winter = __expf(m_s - Mt);
#pragma unroll
                for (int i = 0; i < 2; ++i) {
                    const int tn = tn0 + i; f32x4 a = (f32x4){0.f, 0.f, 0.f, 0.f};
                    mma_tile<true, 2, LDT, LDT>(a, QM, tm * 16, KM, tn * 16, fr, fq);
                    const int s0 = tn * 16 + fq * 4; const f32x4 as = *(const LAS f32x4*)(AVc + s0);
#pragma unroll
                    for (int jx = 0; jx < 4; ++jx) a[jx] = (s0 + jx <= trow) ? a[jx] * __expf(as[jx] - Mt) : 0.f;
                    u32x2 w; w.x = cvt_pk_bf16(a[0], a[1]); w.y = cvt_pk_bf16(a[2], a[3]);
                    *(LAS u32x2*)(WM + trow * LDT + s0 * 2) = w;
                    hacc[i] = (f32x4){0.f, 0.f, 0.f, 0.f};
                    mma_tile<true, 2, LDT, LDT>(hacc[i], QM, tm * 16, CT, tn * 16, fr, fq);
                    hacc[i] *= winter;
                }
                hacc[2] = (f32x4){0.f, 0.f, 0.f, 0.f};
                if (extra) { mma_tile<true, 2, LDT, LDT>(hacc[2], QM, tm * 16, CT, 64, fr, fq); hacc[2] *= winter; }
            }
            __syncthreads();
#pragma unroll
            for (int i = 0; i < 2; ++i) mma_tile<true, 2, LDT, LDT>(hacc[i], WM, tm * 16, VTc, (tn0 + i) * 16, fr, fq);
            if (extra) { mma_tile<true, 2, LDT, LDT>(hacc[2], WM, tm * 16, VTc, 64, fr, fq); DEN[fq * 64 + trow] = hacc[2][0]; }
            __syncthreads();
            {
                const int lp = c * 64 + trow, p = dir ? (L - 1 - lp) : lp;
                bf16_t* orow = OUT + (size_t)tok_row(seg, b, p, false) * 1024 + 512 + h * 64;
                const float den = DEN[trow], mt = FVc[trow] + Mt; const float inv = 1.0f / fmaxf(fabsf(den), __expf(-mt));
#pragma unroll
                for (int i = 0; i < 2; ++i) {
                    u32x2 w; w.x = cvt_pk_bf16(hacc[i][0] * inv, hacc[i][1] * inv); w.y = cvt_pk_bf16(hacc[i][2] * inv, hacc[i][3] * inv);
                    *(u32x2*)(orow + (tn0 + i) * 16 + fq * 4) = w;
                }
                const float M63 = MVc[63]; const float decay = __expf(m_s - M63);
#pragma unroll
                for (int i = 0; i < 2; ++i) {
                    const int tn = tn0 + i;
                    cacc[i] *= decay;
                    mma_tile<false, 2, LDT, LDT>(cacc[i], KWT, tm * 16, VTc, tn * 16, fr, fq);
                    u32x2 w; w.x = cvt_pk_bf16(cacc[i][0], cacc[i][1]); w.y = cvt_pk_bf16(cacc[i][2], cacc[i][3]);
                    *(LAS u32x2*)(CT + (tn * 16 + fr) * LDT + (tm * 16 + fq * 4) * 2) = w;
                }
                if (extra) {
                    cacc[2] *= decay;
                    mma_tile<false, 2, LDT, LDT>(cacc[2], KWT, tm * 16, VTc, 64, fr, fq);
                    u32x2 w; w.x = cvt_pk_bf16(cacc[2][0], cacc[2][1]); w.y = cvt_pk_bf16(cacc[2][2], cacc[2][3]);
                    *(LAS u32x2*)(CT + (64 + fr) * LDT + (tm * 16 + fq * 4) * 2) = w;
                }
                m_s = FVc[63] + M63;
            }
            if (cc + 1 < 132) { ML_STAGE(cc + 1, pb ^ 1); if (cc + 2 < 132) ML_ISSUE(cc + 2); }
            __syncthreads();
        }
    }
}

__device__ __forceinline__ void scan_s5(CPR P, int l, int b, int g, int dir, lds_t lds) {
    const int tid = opaque_tid(), lane = tid & 63, wid = tid >> 6, fr = lane & 15, fq = lane >> 4;
    const bf16_t* PB = (const bf16_t*)(P.ws + WS_PB);
    bf16_t* OUT = (bf16_t*)(P.ws + (dir ? WS_H2 : WS_H));
    constexpr int US = 80, HS = 272;
    lds_t UA = lds, BB = lds + 5120, HB = lds + 49152, CB = lds + 66560;
    LAS float* BU = (LAS float*)(lds + 15360); LAS float* EO = (LAS float*)(lds + 70912);
    const int n = tid & 63, o = tid >> 6;
    const int pidx = ((l * 2 + dir) * 16 + g) * 64 + n;
    const float are = fminf(P.in[I_S5ARE][pidx], -1e-4f), aim = P.in[I_S5AIM][pidx], step = expf(P.in[I_S5LS][(l * 2 + dir) * 16 + g]);
    const float mag = expf(are * step), abr = mag * cosf(aim * step), abi = mag * sinf(aim * step);
    {
        const float den = are * are + aim * aim, nr = abr - 1.0f, ni = abi;
        const float cre = (nr * are + ni * aim) / den, cim = (ni * are - nr * aim) / den;
#pragma unroll
        for (int jj = 0; jj < 2; ++jj) {
            const int j = o * 2 + jj;
            const float bre = P.in[I_S5BRE][(size_t)((l * 16 + g) * 64 + n) * 16 + j], bim = P.in[I_S5BIM][(size_t)((l * 16 + g) * 64 + n) * 16 + j];
            *(LAS bf16_t*)(BB + n * US + j * 2) = f2bf(cre * bre - cim * bim);
            *(LAS bf16_t*)(BB + (64 + n) * US + j * 2) = f2bf(cre * bim + cim * bre);
            *(LAS bf16_t*)(BB + n * US + (16 + j) * 2) = 0; *(LAS bf16_t*)(BB + (64 + n) * US + (16 + j) * 2) = 0;
            *(LAS bf16_t*)(UA + n * US + (16 + j) * 2) = 0;
            const float cr = P.in[I_S5CRE][(size_t)((l * 16 + g) * 16 + j) * 64 + n], ci = P.in[I_S5CIM][(size_t)((l * 16 + g) * 16 + j) * 64 + n];
            *(LAS bf16_t*)(CB + j * HS + n * 2) = f2bf(cr); *(LAS bf16_t*)(CB + j * HS + (64 + n) * 2) = f2bf(-ci);
        }
    }
    float a8r = abr, a8i = abi;
#pragma unroll
    for (int s = 0; s < 3; ++s) { const float r2 = a8r * a8r - a8i * a8i, i2 = 2.0f * a8r * a8i; a8r = r2; a8i = i2; }
    float h0r = 0.f, h0i = 0.f;
    __syncthreads();
    u32x4 u8 = (u32x4){0u, 0u, 0u, 0u};
#define S5_ISSUE(cc_) do { { const int sg_ = (cc_) >= 4, c_ = sg_ ? (cc_) - 4 : (cc_), L_ = sg_ ? SEQ : CTXL; const int t_ = (tid & 127) >> 1, hf_ = tid & 1; const int lp_ = c_ * 64 + t_, p_ = dir ? (L_ - 1 - lp_) : lp_; \
        u8 = *(const u32x4*)(PB + (size_t)tok_row(sg_, b, p_, true) * NINP + S50 + g * 16 + hf_ * 8); } } while (0)
    S5_ISSUE(0);
#pragma unroll 1
    for (int cc = 0; cc < 132; ++cc) {
        {
            const int seg = cc >= 4, c = seg ? cc - 4 : cc, L = seg ? SEQ : CTXL;
            asm volatile("s_waitcnt vmcnt(0)" ::: "memory");
            if (tid < 128) { const int t = tid >> 1, hf = tid & 1; *(LAS u32x4*)(UA + t * US + hf * 16) = u8; }
            __syncthreads();
            if (cc + 1 < 132) S5_ISSUE(cc + 1);
            {   const int tm = wid >> 1;
#pragma unroll
                for (int i = 0; i < 4; ++i) { const int tn = (wid & 1) * 4 + i; f32x4 a = (f32x4){0.f, 0.f, 0.f, 0.f};
                    mma_tile<false, 1, US, US>(a, UA, tm * 16, BB, tn * 16, fr, fq);
#pragma unroll
                    for (int jx = 0; jx < 4; ++jx) BU[(tm * 16 + fq * 4 + jx) * 132 + tn * 16 + fr] = a[jx]; }
            }
            __syncthreads();
            float hr[8], hi[8];
            {   float r = 0.f, im = 0.f;
#pragma unroll
                for (int i = 0; i < 8; ++i) { const int t = o * 8 + i; const float br = BU[t * 132 + n], bi = BU[t * 132 + 64 + n];
                    const float nr = abr * r - abi * im + br, ni = abr * im + abi * r + bi; r = nr; im = ni; hr[i] = r; hi[i] = im; }
                EO[o * 128 + n] = r; EO[o * 128 + 64 + n] = im;
            }
            __syncthreads();
            {   float cr = h0r, ci = h0i, mr = 0.f, mi = 0.f;
#pragma unroll
                for (int o2 = 0; o2 < 8; ++o2) { if (o2 == o) { mr = cr; mi = ci; }
                    const float er = EO[o2 * 128 + n], ei = EO[o2 * 128 + 64 + n];
                    const float nr = a8r * cr - a8i * ci + er, ni = a8r * ci + a8i * cr + ei; cr = nr; ci = ni; }
                h0r = cr; h0i = ci;
                float pr = abr, pi = abi;
#pragma unroll
                for (int i = 0; i < 8; ++i) { const int t = o * 8 + i;
                    const float vr = hr[i] + pr * mr - pi * mi, vi = hi[i] + pr * mi + pi * mr;
                    *(LAS bf16_t*)(HB + t * HS + n * 2) = f2bf(vr); *(LAS bf16_t*)(HB + t * HS + (64 + n) * 2) = f2bf(vi);
                    const float qr = pr * abr - pi * abi, qi = pr * abi + pi * abr; pr = qr; pi = qi; }
            }
            __syncthreads();
            if (wid < 4) { const int tm = wid; f32x4 a = (f32x4){0.f, 0.f, 0.f, 0.f};
                mma_tile<true, 4, HS, HS>(a, HB, tm * 16, CB, 0, fr, fq);
                const int t = tm * 16 + fr; const int lp = c * 64 + t, p = dir ? (L - 1 - lp) : lp;
                u32x2 w; w.x = cvt_pk_bf16(a[0], a[1]); w.y = cvt_pk_bf16(a[2], a[3]);
                __hip_atomic_store((unsigned long long*)(OUT + (size_t)tok_row(seg, b, p, true) * 1024 + 768 + g * 16 + fq * 4), ((unsigned long long)w.y << 32) | w.x, __ATOMIC_RELAXED, __HIP_MEMORY_SCOPE_AGENT); }
        }
    }
    __syncthreads();
}

__device__ __forceinline__ void phase_mixers(CPR P, int l, lds_t lds) {
#pragma unroll 1
    for (int item = blockIdx.x; item < 224; item += gridDim.x) {
        if (item < 32) scan_gla(P, l, item >> 3, (item >> 1) & 3, item & 1, lds);
        else if (item < 64) { const int i = item - 32; scan_ssd(P, l, i >> 3, (i >> 1) & 3, i & 1, lds); }
        else if (item < 96) { const int i = item - 64; scan_mlstm(P, l, i >> 3, (i >> 1) & 3, i & 1, lds); }
        else { const int i = item - 96; scan_s5(P, l, i >> 5, (i >> 1) & 15, i & 1, lds); }
        __syncthreads();
    }
    if ((int)blockIdx.x >= 224 && l + 1 < DEPTH) phase_convert(P, lds, l + 1, 224, (int)gridDim.x - 224);
}

__device__ __forceinline__ void phase_post(CPR P, int l) {
    const int tid_ = opaque_tid(); const int lane = tid_ & 63, wid = tid_ >> 6, c4 = lane * 4;
    bf16_t* H = (bf16_t*)(P.ws + WS_H); const bf16_t* H2 = (const bf16_t*)(P.ws + WS_H2); const bf16_t* PB = (const bf16_t*)(P.ws + WS_PB);
    bf16_t* GB = (bf16_t*)(P.ws + WS_GB);
    const f32x4 gg = *(const f32x4*)(P.in[I_GLAG] + l * 256 + c4), gs = *(const f32x4*)(P.in[I_SSDG] + l * 256 + c4), gm = *(const f32x4*)(P.in[I_MLG] + l * 256 + c4), sd = *(const f32x4*)(P.in[I_S5D] + l * 256 + c4);
    for (int row = blockIdx.x * 8 + wid; row < NT; row += gridDim.x * 8) {
        bf16_t* hrow = H + (size_t)row * 1024; const bf16_t* orow = H2 + (size_t)row * 1024; const bf16_t* pr = PB + (size_t)row * NINP;
        u32x2 f[4], bk[4];
#pragma unroll
        for (int q = 0; q < 4; ++q) { f[q] = *(const u32x2*)(hrow + q * 256 + c4); bk[q] = *(const u32x2*)(orow + q * 256 + c4); }
        const u32x2 rr = *(const u32x2*)(pr + GLA_R + c4), zz = *(const u32x2*)(pr + SSD_Z + c4), oo = *(const u32x2*)(pr + ML_O + c4), pp = *(const u32x2*)(pr + S50 + c4);
        float v[4][4];
#pragma unroll
        for (int q = 0; q < 4; ++q) { v[q][0] = bflo(f[q].x) + bflo(bk[q].x); v[q][1] = bfhi(f[q].x) + bfhi(bk[q].x); v[q][2] = bflo(f[q].y) + bflo(bk[q].y); v[q][3] = bfhi(f[q].y) + bfhi(bk[q].y); }
        const float rv[4] = {bflo(rr.x), bfhi(rr.x), bflo(rr.y), bfhi(rr.y)}, zv[4] = {bflo(zz.x), bfhi(zz.x), bflo(zz.y), bfhi(zz.y)};
        const float ov[4] = {bflo(oo.x), bfhi(oo.x), bflo(oo.y), bfhi(oo.y)}, pv[4] = {bflo(pp.x), bfhi(pp.x), bflo(pp.y), bfhi(pp.y)};
        float ss = v[0][0] * v[0][0] + v[0][1] * v[0][1] + v[0][2] * v[0][2] + v[0][3] * v[0][3];
        ss = row16_sum(ss);
        float rs = rsqrtf(ss * (1.0f / 64.0f) + EPS);
        { u32x2 w; w.x = cvt_pk_bf16(v[0][0] * rs * gg[0] * siluf_(rv[0]), v[0][1] * rs * gg[1] * siluf_(rv[1])); w.y = cvt_pk_bf16(v[0][2] * rs * gg[2] * siluf_(rv[2]), v[0][3] * rs * gg[3] * siluf_(rv[3]));
          *(u32x2*)(hrow + c4) = w; }
        float y[4];
#pragma unroll
        for (int i = 0; i < 4; ++i) y[i] = v[1][i] * siluf_(zv[i]);
        ss = y[0] * y[0] + y[1] * y[1] + y[2] * y[2] + y[3] * y[3];
        ss = wave_sum(ss);
        rs = rsqrtf(ss * (1.0f / 256.0f) + EPS);
        { u32x2 w; w.x = cvt_pk_bf16(y[0] * rs * gs[0], y[1] * rs * gs[1]); w.y = cvt_pk_bf16(y[2] * rs * gs[2], y[3] * rs * gs[3]); *(u32x2*)(hrow + 256 + c4) = w; }
        ss = v[2][0] * v[2][0] + v[2][1] * v[2][1] + v[2][2] * v[2][2] + v[2][3] * v[2][3];
        ss = row16_sum(ss);
        rs = rsqrtf(ss * (1.0f / 64.0f) + EPS);
        { u32x2 w; w.x = cvt_pk_bf16(v[2][0] * rs * gm[0] * sigmoidf_(ov[0]), v[2][1] * rs * gm[1] * sigmoidf_(ov[1])); w.y = cvt_pk_bf16(v[2][2] * rs * gm[2] * sigmoidf_(ov[2]), v[2][3] * rs * gm[3] * sigmoidf_(ov[3]));
          *(u32x2*)(hrow + 512 + c4) = w; }
        { u32x2 w; w.x = cvt_pk_bf16(geluf_(v[3][0] + sd[0] * pv[0]), geluf_(v[3][1] + sd[1] * pv[1])); w.y = cvt_pk_bf16(geluf_(v[3][2] + sd[2] * pv[2]), geluf_(v[3][3] + sd[3] * pv[3]));
          *(u32x2*)(GB + (size_t)row * 256 + c4) = w; }
    }
}

#define XB_TMO      128
#define XB_XCNT(j)  (256  + 64 * (j))
#define XB_XSUB(j)  (1280 + 64 * (j))
#define XB_XGEN(j)  (2304 + 64 * (j))
#define XB_TOP      3328
#define XB_TOPGEN   3392
#define XCD_BAR_WORDS 3456
#define XB_SPIN_CAP (1u << 22)
__device__ __forceinline__ unsigned xb_ld(unsigned* p)              { return __hip_atomic_load(p, __ATOMIC_RELAXED, __HIP_MEMORY_SCOPE_AGENT); }
__device__ __forceinline__ unsigned xb_add(unsigned* p, unsigned v) { return __hip_atomic_fetch_add(p, v, __ATOMIC_RELAXED, __HIP_MEMORY_SCOPE_AGENT); }
__device__ __forceinline__ unsigned xb_xcc_id() { return (unsigned)__builtin_amdgcn_s_getreg((3 << 11) | 20) & 0xFu; }
#define XB_SPIN(cond, bar) do { unsigned _sp = 0; while (cond) { __builtin_amdgcn_s_sleep(1); \
    if ((++_sp & 255u) == 0u) { if (xb_ld(&(bar)[XB_TMO])) break; if (_sp > XB_SPIN_CAP) { atomicAdd(&(bar)[XB_TMO], 1u); break; } } } } while (0)
struct XcdBarrier { unsigned* bar; unsigned x; volatile LAS unsigned* st; };
__device__ __forceinline__ XcdBarrier xcd_barrier_post(unsigned* bar, volatile LAS unsigned* st) {
    XcdBarrier b; b.bar = bar; b.x = xb_xcc_id(); b.st = st;
    if (threadIdx.x == 0) (void)xb_add(&bar[XB_XCNT(b.x)], 1u);
    return b;
}
__device__ __forceinline__ void xcd_barrier_complete(unsigned* bar, unsigned x, unsigned& nloc, unsigned& nx) {
    const unsigned G = gridDim.x * gridDim.y * gridDim.z;
    unsigned sum, cnt, mine, sp = 0u;
    for (;;) {
        sum = 0u; cnt = 0u; mine = 0u;
#pragma unroll
        for (unsigned j = 0; j < 16; ++j) { const unsigned c = xb_ld(&bar[XB_XCNT(j)]); sum += c; cnt += (c > 0u) ? 1u : 0u; mine = (j == x) ? c : mine; }
        if (sum == G) break;
        __builtin_amdgcn_s_sleep(1);
        if ((++sp & 255u) == 0u) { if (xb_ld(&bar[XB_TMO])) break; if (sp > XB_SPIN_CAP) { atomicAdd(&bar[XB_TMO], 1u); break; } }
    }
    nloc = mine > 0u ? mine : 1u; nx = cnt > 0u ? cnt : 1u;
}
__device__ __forceinline__ void xcd_barrier(const XcdBarrier& b) {
    asm volatile("s_waitcnt vmcnt(0)" ::: "memory");
    __syncthreads();
    if (threadIdx.x == 0) {
        unsigned* bar = b.bar;
        __builtin_amdgcn_s_waitcnt(0);
        unsigned nloc = b.st[0], nx = b.st[1];
        if (nloc == 0u) { xcd_barrier_complete(bar, b.x, nloc, nx); b.st[0] = nloc; b.st[1] = nx; }
        const unsigned old = xb_add(&bar[XB_XSUB(b.x)], 1u);
        const unsigned gen = old / nloc;
        if (old + 1u == (gen + 1u) * nloc) {
            __builtin_amdgcn_fence(__ATOMIC_RELEASE, "agent");
            asm volatile("s_waitcnt vmcnt(0)" ::: "memory");
            const unsigned og = xb_add(&bar[XB_TOP], 1u);
            const unsigned tg = og / nx;
            if (og + 1u == (tg + 1u) * nx) xb_add(&bar[XB_TOPGEN], 1u);
            else XB_SPIN(xb_ld(&bar[XB_TOPGEN]) == tg, bar);
            __builtin_amdgcn_fence(__ATOMIC_ACQUIRE, "agent");
            xb_add(&bar[XB_XGEN(b.x)], 1u);
            asm volatile("s_waitcnt vmcnt(0)" ::: "memory");
        } else {
            XB_SPIN(xb_ld(&bar[XB_XGEN(b.x)]) == gen, bar);
            __builtin_amdgcn_fence(__ATOMIC_ACQUIRE, "agent");
            asm volatile("s_waitcnt vmcnt(0)" ::: "memory");
        }
    }
    __syncthreads();
}
__device__ __forceinline__ void gsync(cg::grid_group& grid) {
    asm volatile("s_waitcnt vmcnt(0) lgkmcnt(0)" ::: "memory");
    __builtin_amdgcn_fence(__ATOMIC_RELEASE, "agent");
    asm volatile("s_waitcnt vmcnt(0)" ::: "memory");
    grid.sync();
    __builtin_amdgcn_fence(__ATOMIC_ACQUIRE, "agent");
    asm volatile("s_waitcnt vmcnt(0)" ::: "memory");
    __syncthreads();
}
__global__ void __launch_bounds__(512, 2) fwd_megakernel(Params Pk) {
    extern __shared__ __attribute__((aligned(16))) unsigned char smem[];
    lds_t lds = (lds_t)smem;
    cg::grid_group grid = cg::this_grid();
    volatile LAS unsigned* xst = (volatile LAS unsigned*)(lds + 131072);
    if (threadIdx.x == 0) { xst[0] = 0u; xst[1] = 0u; xst[2] = 0u; xst[3] = 0u; }
    __syncthreads();
    const XcdBarrier xb = xcd_barrier_post((unsigned*)(getP()->ws + WS_BAR), xst);
    phase_mods(*getP(), lds);
    phase_convert(*getP(), lds, 0, 0, (int)gridDim.x);
    xcd_barrier(xb);
    if (getP()->ws == nullptr) gsync(grid);
#pragma unroll 1
    for (int l = 0; l < DEPTH; ++l) {
#pragma unroll 1
        for (int j = 0; j < 3; ++j) {
            phase_modnorm(*getP(), l, j, l == 0 && j == 0);
            xcd_barrier(xb);
            CPR P = *getP();
            bf16_t* H = (bf16_t*)(P.ws + WS_H); bf16_t* PBp = (bf16_t*)(P.ws + WS_PB);
            const float* mods_l = (const float*)(P.ws + WS_MODS) + (size_t)l * 5 * 9216;
            pg8::Gemm g2;
            if (j != 1) {
                const int s = j >> 1;
                pg8::Gemm g; g.A = H; g.Bt = (const bf16_t*)(P.ws + WS_WFI) + (size_t)(l * 2 + s) * 5632 * 1024; g.M = NT; g.N = 5632; g.K = 1024; g.lda = 1024; g.ldb = 1024;
                pg8::StaticOrder S; S.init(g.M, g.N, (int)gridDim.x, (int)blockIdx.x);
                EpiSwiGLU E; E.O = PBp;
                pg8::gemm_phase(lds, g, S, E);
                xcd_barrier(xb);
                g2.A = PBp; g2.Bt = (const bf16_t*)(P.ws + WS_WFO) + (size_t)(l * 2 + s) * 1024 * DFF; g2.M = NLAT; g2.N = 1024; g2.K = DFF; g2.lda = DFF; g2.ldb = DFF;
            } else {
                {
                    pg8::Gemm g; g.A = H; g.Bt = (const bf16_t*)(P.ws + WS_WIN) + (size_t)l * NINP * 1024; g.M = NT; g.N = NINP; g.K = 1024; g.lda = 1024; g.ldb = 1024;
                    pg8::StaticOrder S; S.init(g.M, g.N, (int)gridDim.x, (int)blockIdx.x);
                    EpiInProj E; E.Pb = PBp; E.Pg = (float*)(P.ws + WS_PG);
                    pg8::gemm_phase(lds, g, S, E);
                }
                xcd_barrier(xb);
                phase_mixers(*getP(), l, lds);
                xcd_barrier(xb);
                phase_post(*getP(), l);
                xcd_barrier(xb);
                {
                    pg8::Gemm g; g.A = (const bf16_t*)(P.ws + WS_GB); g.Bt = (const bf16_t*)(P.ws + WS_WGLU) + (size_t)l * 256 * 256; g.M = NT; g.N = 256; g.K = 256; g.lda = 256; g.ldb = 256;
                    pg8::StaticOrder S; S.init(g.M, g.N, (int)gridDim.x, (int)blockIdx.x);
                    EpiGLU E; E.G = (const bf16_t*)(P.ws + WS_GB); E.bglu = P.in[I_S5BGLU] + l * 256; E.O = H;
                    pg8::gemm_phase(lds, g, S, E);
                }
                xcd_barrier(xb);
                g2.A = H; g2.Bt = (const bf16_t*)(P.ws + WS_WOUT) + (size_t)l * 1024 * 1024; g2.M = NLAT; g2.N = 1024; g2.K = 1024; g2.lda = 1024; g2.ldb = 1024;
            }
            {
                pg8::StaticOrder S; S.init(g2.M, g2.N, (int)gridDim.x, (int)blockIdx.x);
                EpiResid E; E.xlat = P.out; E.xctx = (float*)(P.ws + WS_CTXX); E.gate_l = mods_l + (3 * j + 2) * 1024; E.coef = (j == 1) ? 1.0f : 0.5f;
                pg8::gemm_phase(lds, g2, S, E);
                pg8::Gemm g3 = g2; g3.A = g2.A + (size_t)NLAT * g2.lda; g3.M = NCTX; g3.K = 256;
                pg8::SplitKOrder S3; S3.init(g3.M, g3.N, g2.K / 256, (int)gridDim.x, (int)blockIdx.x);
                EpiSlab E3; E3.slab = (float*)(P.ws + WS_SLAB);
                pg8::gemm_phase(lds, g3, S3, E3);
            }
            xcd_barrier(xb);
        }
    }
    phase_final(*getP());
}

extern "C" void kernel_launch(void* const* d_in, const int* in_sizes, int n_in, void* d_out, int out_size, void* d_ws, size_t ws_size, hipStream_t stream) {
    constexpr int LDS_BYTES = 131072 + 64;
    static int grid = 0;
    if (grid == 0) {
        if (n_in != 35 || ws_size < WS_END) { fprintf(stderr, "kernel_launch: expected 35 inputs and >= %zu bytes of workspace; got %d, %zu\n", (size_t)WS_END, n_in, ws_size); grid = -1; return; }
        int dev = 0, cus = 0, per_cu = 0;
        hipGetDevice(&dev);
        hipDeviceGetAttribute(&cus, hipDeviceAttributeMultiprocessorCount, dev);
        if (hipFuncSetAttribute((const void*)fwd_megakernel, hipFuncAttributeMaxDynamicSharedMemorySize, LDS_BYTES) != hipSuccess) { fprintf(stderr, "kernel_launch: hipFuncSetAttribute failed\n"); grid = -1; return; }
        if (hipOccupancyMaxActiveBlocksPerMultiprocessor(&per_cu, (const void*)fwd_megakernel, 512, LDS_BYTES) != hipSuccess || per_cu < 1) { fprintf(stderr, "kernel_launch: occupancy query says %d blocks per CU\n", per_cu); per_cu = 1; }
        (void)hipGetLastError();
        grid = cus;
    }
    if (grid < 0) return;
    Params p{};
    for (int i = 0; i < 35; ++i) p.in[i] = (const float*)d_in[i];
    p.out = (float*)d_out; p.ws = (unsigned char*)d_ws;
    if (hipMemsetAsync((char*)d_ws + WS_BAR, 0, SZ_BAR, stream) != hipSuccess) { fprintf(stderr, "kernel_launch: memset of the barrier words failed\n"); return; }
    void* args[] = {&p};
    hipError_t e = hipLaunchCooperativeKernel((const void*)fwd_megakernel, dim3(grid), dim3(512), args, LDS_BYTES, stream);
    if (e != hipSuccess) fprintf(stderr, "cooperative launch failed: %s (grid %d)\n", hipGetErrorString(e), grid);
}
```

```cpp
#include <hip/hip_runtime.h>
#include <hip/hip_cooperative_groups.h>
#include <cstdio>
namespace cg = cooperative_groups;

#define LAS __attribute__((address_space(3)))
typedef unsigned short bf16_t;
typedef short bf16x8 __attribute__((ext_vector_type(8)));
typedef float f32x4 __attribute__((ext_vector_type(4)));
typedef unsigned u32x4 __attribute__((ext_vector_type(4)));
typedef unsigned u32x2 __attribute__((ext_vector_type(2)));
typedef LAS unsigned char* lds_t;

constexpr int DM = 1024, NB = 4, SEQ = 8192, DEPTH = 4, CTXL = 256;
constexpr int NLAT = NB * SEQ, NCTX = NB * CTXL, NT = NLAT + NCTX;
constexpr int DFF = 2816, NIN = 3128, NINP = 3328;
constexpr int GLA_Q = 0, GLA_K = 256, GLA_V = 512, GLA_R = 768;
constexpr int SSD_X = 1056, SSD_B = 1312, SSD_C = 1440, SSD_Z = 1568;
constexpr int ML_Q = 1832, ML_V = 2344, ML_O = 2600;
constexpr int S50 = 2872;
constexpr int PGW = 96;
constexpr float EPS = 1e-6f;

constexpr size_t SZ_WFI = (size_t)DEPTH * 2 * 5632 * 1024 * 2;
constexpr size_t SZ_WFO = (size_t)DEPTH * 2 * 1024 * 2816 * 2;
constexpr size_t SZ_WIN = (size_t)DEPTH * NINP * 1024 * 2;
constexpr size_t SZ_WOUT = (size_t)DEPTH * 1024 * 1024 * 2;
constexpr size_t SZ_WGLU = (size_t)DEPTH * 256 * 256 * 2;
constexpr size_t SZ_MODS = (size_t)DEPTH * 5 * 9216 * 4;
constexpr size_t SZ_CTXX = (size_t)NCTX * 1024 * 4;
constexpr size_t SZ_H = (size_t)NT * 1024 * 2;
constexpr size_t SZ_PB = (size_t)NT * NINP * 2;
constexpr size_t SZ_PG = (size_t)NT * PGW * 4;
constexpr size_t SZ_GB = (size_t)NT * 256 * 2;
constexpr size_t WS_WFI = 0;
constexpr size_t WS_WFO = WS_WFI + SZ_WFI;
constexpr size_t WS_WIN = WS_WFO + SZ_WFO;
constexpr size_t WS_WOUT = WS_WIN + SZ_WIN;
constexpr size_t WS_WGLU = WS_WOUT + SZ_WOUT;
constexpr size_t WS_MODS = WS_WGLU + SZ_WGLU;
constexpr size_t WS_CTXX = WS_MODS + SZ_MODS;
constexpr size_t WS_H = WS_CTXX + SZ_CTXX;
constexpr size_t WS_H2 = WS_H + SZ_H;
constexpr size_t WS_PB = WS_H2 + SZ_H;
constexpr size_t WS_PG = WS_PB + SZ_PB;
constexpr size_t WS_GB = WS_PG + SZ_PG;
constexpr size_t WS_BAR = WS_GB + SZ_GB;
constexpr size_t SZ_BAR = 16384;
constexpr size_t WS_SLAB = WS_BAR + SZ_BAR;
constexpr size_t SZ_SLAB = (size_t)11 * NCTX * 1024 * 4;
constexpr size_t WS_END = WS_SLAB + SZ_SLAB;

struct Params {
    const float* in[35];
    float* out;
    unsigned char* ws;
};
typedef const __attribute__((address_space(4))) Params* cparams_t;
#define CPR const __attribute__((address_space(4))) Params&
__device__ __forceinline__ cparams_t getP() { cparams_t p = (cparams_t)__builtin_amdgcn_kernarg_segment_ptr(); asm volatile("" : "+s"(p)); return p; }
enum { I_X = 0, I_C, I_CTX, I_CCTX, I_WMOD, I_BMOD, I_GNORM, I_FFNWIN, I_FFNWOUT, I_WIN, I_WOUT, I_GLAW, I_GLAB, I_GLAG,
       I_SSDCW, I_SSDCB, I_SSDALOG, I_SSDDTB, I_SSDD, I_SSDG, I_MLCW, I_MLCB, I_MLGB, I_MLG, I_S5ARE, I_S5AIM, I_S5LS,
       I_S5BRE, I_S5BIM, I_S5CRE, I_S5CIM, I_S5D, I_S5WGLU, I_S5BGLU, I_GFINAL };

__device__ __forceinline__ float bf2f(unsigned b) { return __uint_as_float(b << 16); }
typedef __bf16 bf16x2_t __attribute__((ext_vector_type(2)));
typedef float f32x2_t __attribute__((ext_vector_type(2)));
__device__ __forceinline__ unsigned cvt_pk_bf16(float lo, float hi) { const f32x2_t f = {lo, hi}; return __builtin_bit_cast(unsigned, __builtin_convertvector(f, bf16x2_t)); }
__device__ __forceinline__ bf16_t f2bf(float f) { return (bf16_t)(cvt_pk_bf16(f, 0.f) & 0xffffu); }
__device__ __forceinline__ float bflo(unsigned w) { return __uint_as_float(w << 16); }
__device__ __forceinline__ float bfhi(unsigned w) { return __uint_as_float(w & 0xffff0000u); }
__device__ __forceinline__ float sigmoidf_(float x) { return 1.0f / (1.0f + __expf(-x)); }
__device__ __forceinline__ float siluf_(float x) { return x * sigmoidf_(x); }
__device__ __forceinline__ float logsigf_(float x) { return fminf(x, 0.f) - __logf(1.0f + __expf(-fabsf(x))); }
__device__ __forceinline__ float softplusf_(float x) { return fmaxf(x, 0.f) + __logf(1.0f + __expf(-fabsf(x))); }
__device__ __forceinline__ float geluf_(float x) { const float u = 0.7978845608028654f * (x + 0.044715f * x * x * x); return x * sigmoidf_(2.0f * u); }

__device__ __forceinline__ int tok_row(int seg, int b, int p, bool colmajor) {
    if (seg == 0) return NLAT + b * CTXL + p;
    return b * SEQ + (colmajor ? ((p & 127) * 64 + (p >> 7)) : p);
}

__device__ __forceinline__ int opaque_tid() { int t = threadIdx.x; asm volatile("" : "+v"(t) :: "memory"); return t; }
__device__ __forceinline__ float shfl_idx(float v, int srclane) { return __int_as_float(__builtin_amdgcn_ds_bpermute(srclane << 2, __float_as_int(v))); }
template <bool TRANS, int KSTEPS, int SA, int SB, bool SAFE = false>
__device__ __forceinline__ void mma_tile(f32x4& acc, lds_t As, int arow0, lds_t Bs, int brow0, int fr, int fq) {
#pragma unroll
    for (int kk = 0; kk < KSTEPS; ++kk) {
        const bf16x8 a = *(const LAS bf16x8*)(As + (arow0 + fr) * SA + kk * 64 + fq * 16);
        const bf16x8 b = *(const LAS bf16x8*)(Bs + (brow0 + fr) * SB + kk * 64 + fq * 16);
        if (SAFE) asm volatile("s_waitcnt lgkmcnt(0)" ::: "memory");
        if (TRANS) acc = __builtin_amdgcn_mfma_f32_16x16x32_bf16(b, a, acc, 0, 0, 0);
        else acc = __builtin_amdgcn_mfma_f32_16x16x32_bf16(a, b, acc, 0, 0, 0);
    }
}
constexpr int LDT = 144;

namespace pg8 {
constexpr int BM = 256, BK = 64, HALF = 128, HTB = HALF * BK * 2, STAGE_BYTES = 8 * HTB, NXCD = 8, WGM = 8;
__device__ __forceinline__ int lds_byte(int r, int c) { const int st = (r >> 4) * 2 + (c >> 5), rr = r & 15, cc = c & 31, ob = rr * 64 + cc * 2; return st * 1024 + (ob ^ (((ob >> 9) & 1) << 5)); }
__device__ __forceinline__ void stage_rc(int b, int& R, int& C) { const int st = b / 1024, sb = b % 1024, swz = sb ^ (((sb >> 9) & 1) << 5); R = (st >> 1) * 16 + swz / 64; C = (st & 1) * 32 + (swz % 64) / 2; }
__device__ __forceinline__ int perm32(int rho) { const int n = rho >> 4, i = rho & 15; return 8 * (i >> 2) + 4 * n + (i & 3); }
struct Unit { int pm, pn, ks; };
struct Gemm { const bf16_t* A; const bf16_t* Bt; int M, N, K, lda, ldb; };
struct StaticOrder {
    int nM, nN, nwg, G, c;
    __device__ void init(int M, int N, int G_, int c_) { nM = M / BM; nN = N / BM; nwg = nM * nN; G = G_; c = c_; }
    __device__ bool next(int i, Unit& u) const {
        const long L = (long)i * G + c; if (L >= nwg) return false;
        int wgid = (int)L; { const int q = nwg / NXCD, r = nwg % NXCD, xcd = wgid % NXCD, off = wgid / NXCD; wgid = (xcd < r ? xcd * (q + 1) : r * (q + 1) + (xcd - r) * q) + off; }
        const int nig = WGM * nN, gid = wgid / nig, fm = gid * WGM, gsz = (nM - fm) < WGM ? (nM - fm) : WGM;
        u.pm = fm + ((wgid % nig) % gsz); u.pn = (wgid % nig) / gsz; u.ks = 0; return true;
    }
};
struct SplitKOrder {
    int nN, nks, n, G, c;
    __device__ void init(int M, int N, int nks_, int G_, int c_) { nN = N / BM; nks = nks_; n = (M / BM) * nN * nks; G = G_; c = c_; }
    __device__ bool next(int i, Unit& u) const { const long L = (long)i * G + c; if (L >= n) return false; const int l = (int)L; u.ks = l % nks; const int r = l / nks; u.pn = r % nN; u.pm = r / nN; return true; }
};
template <class Epi, class Sched>
__device__ __forceinline__ void gemm_phase(lds_t lds, const Gemm g, const Sched& S, const Epi& E) {
    const int tid = opaque_tid(), wid = __builtin_amdgcn_readfirstlane(tid >> 6), lane = tid & 63, wr = wid >> 2, wc = wid & 3, fr = lane & 15, fq = lane >> 4;
    const int K = g.K, nt = K / BK;
    unsigned voffA[2], voffB[2];
#pragma unroll
    for (int i = 0; i < 2; ++i) { int R, C; stage_rc(tid * 16 + i * 8192, R, C); const int Rb = Epi::PERM ? ((R & ~31) + perm32(R & 31)) : R;
        voffA[i] = (unsigned)(R * g.lda + C) * 2u; voffB[i] = (unsigned)(Rb * g.ldb + C) * 2u; }
    const size_t kstep = (size_t)(BK * 2);
    const size_t hstepA = (size_t)HALF * g.lda * 2, hstepB = (size_t)HALF * g.ldb * 2;
    const size_t tstepA = 2 * hstepA, tstepB = 2 * hstepB, kslice = (size_t)K * 2;
    const unsigned ldsw = (unsigned)wid * 1024u;
    const int aoff = lds_byte(wr * 64 + fr, fq * 8), boff = lds_byte(wc * 32 + fr, fq * 8);
#define PG8_SA(b, h) (((b) * 2 + (h)) * HTB)
#define PG8_SB(b, h) ((4 + (b) * 2 + (h)) * HTB)
#define PG8_STAGE(bufoff, gbase, voff) do { _Pragma("unroll") for (int _i = 0; _i < 2; ++_i) \
        __builtin_amdgcn_global_load_lds((const unsigned*)((const char*)(gbase) + (voff)[_i]), (LAS unsigned*)(lds + (bufoff) + ldsw + _i * 8192), 16, 0, 0); } while (0)
#define PG8_LDA(dst, b, h) do { _Pragma("unroll") for (int m = 0; m < 4; ++m) _Pragma("unroll") for (int k = 0; k < 2; ++k) dst[m][k] = *(const LAS bf16x8*)(lds + PG8_SA(b, h) + aoff + m * 2048 + k * 1024); } while (0)
#define PG8_LDB(dst, b, h) do { _Pragma("unroll") for (int n = 0; n < 2; ++n) _Pragma("unroll") for (int k = 0; k < 2; ++k) dst[n][k] = *(const LAS bf16x8*)(lds + PG8_SB(b, h) + boff + n * 2048 + k * 1024); } while (0)
#define PG8_MMA(ai, bj, At, Bt) do { __builtin_amdgcn_s_setprio(1); _Pragma("unroll") for (int m = 0; m < 4; ++m) _Pragma("unroll") for (int n = 0; n < 2; ++n) _Pragma("unroll") for (int k = 0; k < 2; ++k) \
        acc[ai][bj][m][n] = __builtin_amdgcn_mfma_f32_16x16x32_bf16(Bt[n][k], At[m][k], acc[ai][bj][m][n], 0, 0, 0); __builtin_amdgcn_s_setprio(0); } while (0)
#define PG8_WAIT_V(n) asm volatile("s_waitcnt vmcnt(" #n ")" ::: "memory")
#define PG8_WAIT_L(n) asm volatile("s_waitcnt lgkmcnt(" #n ")" ::: "memory")
#define PG8_BAR __builtin_amdgcn_s_barrier()
#define PG8_SCHED __builtin_amdgcn_sched_barrier(0)
    Unit cur, nxt; int ui = 0;
    if (!S.next(0, cur)) return;
    f32x4 acc[2][2][4][2];
#pragma unroll
    for (int a = 0; a < 2; ++a)
#pragma unroll
        for (int b = 0; b < 2; ++b)
#pragma unroll
            for (int m = 0; m < 4; ++m)
#pragma unroll
                for (int n = 0; n < 2; ++n) acc[a][b][m][n] = (f32x4){0.f, 0.f, 0.f, 0.f};
    bf16x8 At[4][2], B0[2][2], B1[2][2];
    const char* cA = (const char*)g.A + (size_t)cur.pm * tstepA + (size_t)cur.ks * kslice; const char* cB = (const char*)g.Bt + (size_t)cur.pn * tstepB + (size_t)cur.ks * kslice;
    PG8_STAGE(PG8_SB(0, 0), cB, voffB); PG8_STAGE(PG8_SA(0, 0), cA, voffA); PG8_STAGE(PG8_SB(0, 1), cB + hstepB, voffB); PG8_STAGE(PG8_SA(0, 1), cA + hstepA, voffA);
    if (wr == 1) PG8_BAR;
    PG8_WAIT_V(4); PG8_BAR;
    PG8_STAGE(PG8_SB(1, 0), cB + kstep, voffB); PG8_STAGE(PG8_SA(1, 0), cA + kstep, voffA); PG8_STAGE(PG8_SB(1, 1), cB + hstepB + kstep, voffB);
    PG8_WAIT_V(6); PG8_BAR;
    for (;;) {
        const bool has_next = S.next(ui + 1, nxt);
        const char* nA = has_next ? (const char*)g.A + (size_t)nxt.pm * tstepA + (size_t)nxt.ks * kslice : cA; const char* nB = has_next ? (const char*)g.Bt + (size_t)nxt.pn * tstepB + (size_t)nxt.ks * kslice : cB;
        for (int t = 0; t < nt; t += 2) {
            const bool last = (t == nt - 2);
            const char* a1 = cA + (size_t)(t + 1) * kstep;
            const char* a2 = last ? nA : cA + (size_t)(t + 2) * kstep; const char* b2 = last ? nB : cB + (size_t)(t + 2) * kstep;
            const char* a3 = a2 + kstep; const char* b3 = b2 + kstep;
            PG8_LDB(B0, 0, 0); PG8_SCHED; PG8_LDA(At, 0, 0); PG8_STAGE(PG8_SA(1, 1), a1 + hstepA, voffA);
            PG8_WAIT_L(8); PG8_BAR; PG8_WAIT_L(0); PG8_MMA(0, 0, At, B0); PG8_BAR; PG8_SCHED;
            PG8_LDB(B1, 0, 1); PG8_STAGE(PG8_SB(0, 0), b2, voffB);
            PG8_BAR; PG8_WAIT_L(0); PG8_MMA(0, 1, At, B1); PG8_BAR;
            PG8_LDA(At, 0, 1); PG8_STAGE(PG8_SA(0, 0), a2, voffA);
            PG8_BAR; PG8_WAIT_L(0); PG8_MMA(1, 0, At, B0); PG8_BAR; PG8_SCHED;
            PG8_STAGE(PG8_SB(0, 1), b2 + hstepB, voffB);
            PG8_WAIT_V(6); PG8_BAR; PG8_MMA(1, 1, At, B1); PG8_BAR;
            PG8_LDB(B0, 1, 0); PG8_SCHED; PG8_LDA(At, 1, 0); PG8_STAGE(PG8_SA(0, 1), a2 + hstepA, voffA);
            PG8_WAIT_L(8); PG8_BAR; PG8_WAIT_L(0); PG8_MMA(0, 0, At, B0); PG8_BAR; PG8_SCHED;
            PG8_LDB(B1, 1, 1); PG8_STAGE(PG8_SB(1, 0), b3, voffB);
            PG8_BAR; PG8_WAIT_L(0); PG8_MMA(0, 1, At, B1); PG8_BAR;
            PG8_LDA(At, 1, 1); PG8_STAGE(PG8_SA(1, 0), a3, voffA);
            PG8_BAR; PG8_WAIT_L(0); PG8_MMA(1, 0, At, B0); PG8_BAR; PG8_SCHED;
            PG8_STAGE(PG8_SB(1, 1), b3 + hstepB, voffB);
            PG8_WAIT_V(6); PG8_BAR; PG8_MMA(1, 1, At, B1); PG8_BAR;
        }
        { const int t2 = opaque_tid(); E(acc, cur, wr, wc, t2 & 15, (t2 & 63) >> 4); }
        if (!has_next) break;
#pragma unroll
        for (int a = 0; a < 2; ++a)
#pragma unroll
            for (int b = 0; b < 2; ++b)
#pragma unroll
                for (int m = 0; m < 4; ++m)
#pragma unroll
                    for (int n = 0; n < 2; ++n) acc[a][b][m][n] = (f32x4){0.f, 0.f, 0.f, 0.f};
        cur = nxt; cA = nA; cB = nB; ++ui;
    }
    PG8_WAIT_V(0);
    if (wr == 0) PG8_BAR;
    PG8_BAR;
#undef PG8_SA
#undef PG8_SB
#undef PG8_STAGE
#undef PG8_LDA
#undef PG8_LDB
#undef PG8_MMA
#undef PG8_WAIT_V
#undef PG8_WAIT_L
#undef PG8_BAR
#undef PG8_SCHED
}
}
using pg8::Unit;

struct EpiSwiGLU {
    static constexpr bool PERM = true;
    bf16_t* O;
    __device__ __forceinline__ void operator()(const f32x4 (&acc)[2][2][4][2], const Unit& u, int wr, int wc, int fr, int fq) const {
        const int row0 = u.pm * 256 + wr * 64 + fr, col0 = u.pn * 128 + wc * 32 + 8 * fq;
#pragma unroll
        for (int ai = 0; ai < 2; ++ai)
#pragma unroll
            for (int m = 0; m < 4; ++m) {
                bf16_t* rowp = O + (size_t)(row0 + ai * 128 + m * 16) * DFF + col0;
                const f32x4 g0 = acc[ai][0][m][0], g1 = acc[ai][0][m][1], u0 = acc[ai][1][m][0], u1 = acc[ai][1][m][1];
                u32x4 w;
                w.x = cvt_pk_bf16(siluf_(g0[0]) * u0[0], siluf_(g0[1]) * u0[1]);
                w.y = cvt_pk_bf16(siluf_(g0[2]) * u0[2], siluf_(g0[3]) * u0[3]);
                w.z = cvt_pk_bf16(siluf_(g1[0]) * u1[0], siluf_(g1[1]) * u1[1]);
                w.w = cvt_pk_bf16(siluf_(g1[2]) * u1[2], siluf_(g1[3]) * u1[3]);
                *(u32x4*)rowp = w;
                asm volatile("" ::: "memory");
            }
    }
};
struct EpiResid {
    static constexpr bool PERM = false;
    float* xlat; float* xctx; const float* gate_l; float coef;
    __device__ __forceinline__ void operator()(const f32x4 (&acc)[2][2][4][2], const Unit& u, int wr, int wc, int fr, int fq) const {
        float* base; int mod;
        if (u.pm < 128) { base = xlat + (size_t)u.pm * 256 * 1024; mod = u.pm >> 5; } else { base = xctx + (size_t)(u.pm - 128) * 256 * 1024; mod = 4; }
        const int col0 = u.pn * 256 + wc * 32 + 4 * fq;
        const float* gp = gate_l + mod * 9216 + col0;
        float* rbase = base + (size_t)(wr * 64 + fr) * 1024 + col0;
#pragma unroll
        for (int bj = 0; bj < 2; ++bj) {
            f32x4 xv[2][2][4];
#pragma unroll
            for (int n = 0; n < 2; ++n)
#pragma unroll
                for (int ai = 0; ai < 2; ++ai)
#pragma unroll
                    for (int m = 0; m < 4; ++m) xv[n][ai][m] = *(const f32x4*)(rbase + (size_t)(ai * 128 + m * 16) * 1024 + bj * 128 + n * 16);
            const f32x4 gv0 = *(const f32x4*)(gp + bj * 128) * coef, gv1 = *(const f32x4*)(gp + bj * 128 + 16) * coef;
#pragma unroll
            for (int n = 0; n < 2; ++n)
#pragma unroll
                for (int ai = 0; ai < 2; ++ai)
#pragma unroll
                    for (int m = 0; m < 4; ++m)
                        *(f32x4*)(rbase + (size_t)(ai * 128 + m * 16) * 1024 + bj * 128 + n * 16) = xv[n][ai][m] + (n == 0 ? gv0 : gv1) * acc[ai][bj][m][n];
            asm volatile("" ::: "memory");
        }
    }
};
struct EpiSlab {
    static constexpr bool PERM = false;
    float* slab;
    __device__ __forceinline__ void operator()(const f32x4 (&acc)[2][2][4][2], const Unit& u, int wr, int wc, int fr, int fq) const {
        float* base = slab + ((size_t)u.ks * NCTX + (size_t)u.pm * 256) * 1024;
        const int col0 = u.pn * 256 + wc * 32 + 4 * fq;
#pragma unroll
        for (int ai = 0; ai < 2; ++ai)
#pragma unroll
            for (int m = 0; m < 4; ++m) {
                float* rowp = base + (size_t)(wr * 64 + fr + ai * 128 + m * 16) * 1024 + col0;
#pragma unroll
                for (int bj = 0; bj < 2; ++bj)
#pragma unroll
                    for (int n = 0; n < 2; ++n) *(f32x4*)(rowp + bj * 128 + n * 16) = acc[ai][bj][m][n];
                asm volatile("" ::: "memory");
            }
    }
};
struct EpiInProj {
    static constexpr bool PERM = true;
    bf16_t* Pb; float* Pg;
    __device__ __forceinline__ void operator()(const f32x4 (&acc)[2][2][4][2], const Unit& u, int wr, int wc, int fr, int fq) const {
        const int row0 = u.pm * 256 + wr * 64 + fr;
#pragma unroll
        for (int bj = 0; bj < 2; ++bj) {
            const int c0 = u.pn * 256 + bj * 128 + wc * 32 + 8 * fq;
            int gi = -1;
            if (c0 >= 1024 && c0 < 1056) gi = c0 - 1024; else if (c0 >= 1824 && c0 < 1832) gi = 32 + c0 - 1824; else if (c0 >= 2856 && c0 < 2872) gi = 64 + c0 - 2856;
#pragma unroll
            for (int ai = 0; ai < 2; ++ai)
#pragma unroll
                for (int m = 0; m < 4; ++m) {
                    const size_t row = (size_t)(row0 + ai * 128 + m * 16);
                    const f32x4 v0 = acc[ai][bj][m][0], v1 = acc[ai][bj][m][1];
                    u32x4 w; w.x = cvt_pk_bf16(v0[0], v0[1]); w.y = cvt_pk_bf16(v0[2], v0[3]); w.z = cvt_pk_bf16(v1[0], v1[1]); w.w = cvt_pk_bf16(v1[2], v1[3]);
                    *(u32x4*)(Pb + row * NINP + c0) = w;
                    if (gi >= 0) { *(f32x4*)(Pg + row * PGW + gi) = v0; *(f32x4*)(Pg + row * PGW + gi + 4) = v1; }
                    asm volatile("" ::: "memory");
                }
        }
    }
};
struct EpiGLU {
    static constexpr bool PERM = true;
    const bf16_t* G; const float* bglu; bf16_t* O;
    __device__ __forceinline__ void operator()(const f32x4 (&acc)[2][2][4][2], const Unit& u, int wr, int wc, int fr, int fq) const {
        const int row0 = u.pm * 256 + wr * 64 + fr;
#pragma unroll
        for (int bj = 0; bj < 2; ++bj) {
            const int c0 = bj * 128 + wc * 32 + 8 * fq;
            const f32x4 bb0 = *(const f32x4*)(bglu + c0), bb1 = *(const f32x4*)(bglu + c0 + 4);
            u32x4 gw[2][4];
#pragma unroll
            for (int ai = 0; ai < 2; ++ai)
#pragma unroll
                for (int m = 0; m < 4; ++m) gw[ai][m] = *(const u32x4*)(G + (size_t)(row0 + ai * 128 + m * 16) * 256 + c0);
#pragma unroll
            for (int ai = 0; ai < 2; ++ai)
#pragma unroll
                for (int m = 0; m < 4; ++m) {
                    const size_t row = (size_t)(row0 + ai * 128 + m * 16);
                    const f32x4 v0 = acc[ai][bj][m][0] + bb0, v1 = acc[ai][bj][m][1] + bb1; const u32x4 g4 = gw[ai][m];
                    u32x4 w;
                    w.x = cvt_pk_bf16(bflo(g4.x) * sigmoidf_(v0[0]), bfhi(g4.x) * sigmoidf_(v0[1]));
                    w.y = cvt_pk_bf16(bflo(g4.y) * sigmoidf_(v0[2]), bfhi(g4.y) * sigmoidf_(v0[3]));
                    w.z = cvt_pk_bf16(bflo(g4.z) * sigmoidf_(v1[0]), bfhi(g4.z) * sigmoidf_(v1[1]));
                    w.w = cvt_pk_bf16(bflo(g4.w) * sigmoidf_(v1[2]), bfhi(g4.w) * sigmoidf_(v1[3]));
                    *(u32x4*)(O + row * 1024 + 768 + c0) = w;
                }
            asm volatile("" ::: "memory");
        }
    }
};

__device__ __forceinline__ void phase_mods(CPR P, lds_t lds) {
    const int tid = opaque_tid();
    LAS float* sc = (LAS float*)lds;
    LAS float* red = sc + 5120;
    const float* c = P.in[I_C]; const float* cc = P.in[I_CCTX]; const float* wmod = P.in[I_WMOD]; const float* bmod = P.in[I_BMOD];
    float* mods = (float*)(P.ws + WS_MODS);
    for (int i = tid; i < 5120; i += 512) { const int v = i >> 10, k = i & 1023; const float x = v < 4 ? c[v * 1024 + k] : cc[k]; sc[i] = siluf_(x); }
    __syncthreads();
    for (int item = blockIdx.x; item < 288; item += gridDim.x) {
        const int l = item / 72, col0 = (item % 72) * 128, c4 = (tid & 31) * 4, kg = tid >> 5;
        f32x4 acc[5];
#pragma unroll
        for (int v = 0; v < 5; ++v) acc[v] = (f32x4){0.f, 0.f, 0.f, 0.f};
        const float* wp = wmod + ((size_t)l * 1024 + kg * 64) * 9216 + col0 + c4;
#pragma unroll 8
        for (int kk = 0; kk < 64; ++kk) {
            const f32x4 w = *(const f32x4*)(wp + (size_t)kk * 9216);
#pragma unroll
            for (int v = 0; v < 5; ++v) { const float s = sc[v * 1024 + kg * 64 + kk]; acc[v] += w * s; }
        }
#pragma unroll
        for (int v = 0; v < 5; ++v) *(LAS f32x4*)(red + (kg * 5 + v) * 128 + c4) = acc[v];
        __syncthreads();
        for (int o = tid; o < 640; o += 512) {
            const int v = o >> 7, cx = o & 127; float s = 0.f;
#pragma unroll
            for (int k2 = 0; k2 < 16; ++k2) s += red[(k2 * 5 + v) * 128 + cx];
            mods[(size_t)(l * 5 + v) * 9216 + col0 + cx] = s + bmod[l * 9216 + col0 + cx];
        }
        __syncthreads();
    }
}

__device__ __forceinline__ void conv_tile(const float* src, int src_ld, int col0, int ncv, int k0, bf16_t* dst, int dst_ld, int drow0, LAS float* tile) {
    const int tid = opaque_tid();
    { const int r = tid >> 4, c4 = (tid & 15) * 4;
#pragma unroll
      for (int i = 0; i < 2; ++i) { const int k = r + 32 * i; f32x4 v = (f32x4){0.f, 0.f, 0.f, 0.f};
          if (c4 < ncv) v = *(const f32x4*)(src + (size_t)(k0 + k) * src_ld + col0 + c4);
          tile[k * 65 + c4 + 0] = v[0]; tile[k * 65 + c4 + 1] = v[1]; tile[k * 65 + c4 + 2] = v[2]; tile[k * 65 + c4 + 3] = v[3]; } }
    __syncthreads();
    { const int n = tid >> 3, k8 = (tid & 7) * 8; u32x4 w;
      w.x = cvt_pk_bf16(tile[(k8 + 0) * 65 + n], tile[(k8 + 1) * 65 + n]); w.y = cvt_pk_bf16(tile[(k8 + 2) * 65 + n], tile[(k8 + 3) * 65 + n]);
      w.z = cvt_pk_bf16(tile[(k8 + 4) * 65 + n], tile[(k8 + 5) * 65 + n]); w.w = cvt_pk_bf16(tile[(k8 + 6) * 65 + n], tile[(k8 + 7) * 65 + n]);
      *(u32x4*)(dst + (size_t)(drow0 + n) * dst_ld + k0 + k8) = w; }
    __syncthreads();
}
__device__ __forceinline__ void phase_convert(CPR P, lds_t lds, int l, int b0, int nb) {
    LAS float* tile = (LAS float*)lds;
    constexpr int PER_LAYER = 2 * 1408 + 2 * 704 + 832 + 256 + 16;
    for (int idx = (int)blockIdx.x - b0; idx < PER_LAYER; idx += nb) {
        int t = idx;
        if (t < 2816) {
            const int s = t / 1408; t %= 1408; const int rt = t >> 4, kt = t & 15, drow0 = rt * 64, t256 = drow0 >> 8, cc = drow0 & 255, j0 = t256 * 128 + (cc & 127);
            const int scol = (cc < 128) ? j0 : DFF + j0;
            conv_tile(P.in[I_FFNWIN] + (size_t)(l * 2 + s) * 1024 * 5632, 5632, scol, 64, kt * 64, (bf16_t*)(P.ws + WS_WFI) + (size_t)(l * 2 + s) * 5632 * 1024, 1024, drow0, tile);
        } else if (t < 4224) {
            t -= 2816; const int s = t / 704; t %= 704; const int rt = t / 44, kt = t % 44;
            conv_tile(P.in[I_FFNWOUT] + (size_t)(l * 2 + s) * DFF * 1024, 1024, rt * 64, 64, kt * 64, (bf16_t*)(P.ws + WS_WFO) + (size_t)(l * 2 + s) * 1024 * DFF, DFF, rt * 64, tile);
        } else if (t < 5056) {
            t -= 4224; const int rt = t >> 4, kt = t & 15;
            conv_tile(P.in[I_WIN] + (size_t)l * 1024 * NIN, NIN, rt * 64, NIN - rt * 64, kt * 64, (bf16_t*)(P.ws + WS_WIN) + (size_t)l * NINP * 1024, 1024, rt * 64, tile);
        } else if (t < 5312) {
            t -= 5056; const int rt = t >> 4, kt = t & 15;
            conv_tile(P.in[I_WOUT] + (size_t)l * 1024 * 1024, 1024, rt * 64, 64, kt * 64, (bf16_t*)(P.ws + WS_WOUT) + (size_t)l * 1024 * 1024, 1024, rt * 64, tile);
        } else {
            t -= 5312; const int rt = t >> 2, kt = t & 3;
            conv_tile(P.in[I_S5WGLU] + (size_t)l * 256 * 256, 256, rt * 64, 64, kt * 64, (bf16_t*)(P.ws + WS_WGLU) + (size_t)l * 256 * 256, 256, rt * 64, tile);
        }
    }
}

template <int CTRL> __device__ __forceinline__ float dpp_mov(float x) { return __int_as_float(__builtin_amdgcn_update_dpp(0, __float_as_int(x), CTRL, 0xf, 0xf, false)); }
__device__ __forceinline__ float wave_scan_add(float x, int lane) {
    const int rl = lane & 15; float t;
    t = dpp_mov<0x111>(x) + x; if (rl >= 1) x = t;
    t = dpp_mov<0x112>(x) + x; if (rl >= 2) x = t;
    t = dpp_mov<0x114>(x) + x; if (rl >= 4) x = t;
    t = dpp_mov<0x118>(x) + x; if (rl >= 8) x = t;
    t = dpp_mov<0x142>(x) + x; if ((lane & 31) >= 16) x = t;
    t = dpp_mov<0x143>(x) + x; if (lane >= 32) x = t;
    return x;
}
__device__ __forceinline__ float wave_scan_max(float x, int lane) {
    const int rl = lane & 15; float t;
    t = fmaxf(dpp_mov<0x111>(x), x); if (rl >= 1) x = t;
    t = fmaxf(dpp_mov<0x112>(x), x); if (rl >= 2) x = t;
    t = fmaxf(dpp_mov<0x114>(x), x); if (rl >= 4) x = t;
    t = fmaxf(dpp_mov<0x118>(x), x); if (rl >= 8) x = t;
    t = fmaxf(dpp_mov<0x142>(x), x); if ((lane & 31) >= 16) x = t;
    t = fmaxf(dpp_mov<0x143>(x), x); if (lane >= 32) x = t;
    return x;
}

__device__ __forceinline__ float row16_sum(float s) { s += dpp_mov<0xB1>(s); s += dpp_mov<0x4E>(s); s += dpp_mov<0x124>(s); s += dpp_mov<0x128>(s); return s; }
__device__ __forceinline__ float wave_sum(float s) { s = row16_sum(s);
    const int si = __float_as_int(s);
    return __int_as_float(__builtin_amdgcn_readlane(si, 0)) + __int_as_float(__builtin_amdgcn_readlane(si, 16)) + __int_as_float(__builtin_amdgcn_readlane(si, 32)) + __int_as_float(__builtin_amdgcn_readlane(si, 48)); }

__device__ __forceinline__ void phase_modnorm(CPR P, int l, int j, bool first) {
    const int jp = (j + 2) % 3, lp = (j == 0) ? l - 1 : l, nks = first ? 0 : (jp == 1 ? 4 : 11); const float coefp = (jp == 1) ? 1.0f : 0.5f;
    const float* slab = (const float*)(P.ws + WS_SLAB);
    const float* gatep = (const float*)(P.ws + WS_MODS) + (size_t)(lp < 0 ? 0 : lp) * 5 * 9216 + 4 * 9216 + (3 * jp + 2) * 1024;
    const int tid_ = opaque_tid(); const int lane = tid_ & 63, wid = tid_ >> 6;
    const float* mods_l = (const float*)(P.ws + WS_MODS) + (size_t)l * 5 * 9216;
    const float* gn = P.in[I_GNORM] + (size_t)(l * 3 + j) * 1024;
    float* xctx = (float*)(P.ws + WS_CTXX);
    bf16_t* H = (bf16_t*)(P.ws + WS_H);
    const float* xlat_src = first ? P.in[I_X] : P.out; const float* xctx_src = first ? P.in[I_CTX] : xctx;
    f32x4 gv[4], sh[4], scl[4], xn[4];
#pragma unroll
    for (int i = 0; i < 4; ++i) { gv[i] = *(const f32x4*)(gn + lane * 4 + 256 * i); sh[i] = gv[i]; scl[i] = gv[i]; xn[i] = gv[i]; }
    const int stride = gridDim.x * 8; int row = blockIdx.x * 8 + wid; int curmod = -1;
#define MN_LOAD(r_) do { const float* s_ = ((r_) < NLAT) ? xlat_src + (size_t)(r_) * 1024 : xctx_src + (size_t)((r_) - NLAT) * 1024; \
        _Pragma("unroll") for (int i_ = 0; i_ < 4; ++i_) xn[i_] = *(const f32x4*)(s_ + lane * 4 + 256 * i_); } while (0)
    if (row < NT) MN_LOAD(row);
    for (; row < NT; row += stride) {
        float* dst; int mod;
        if (row < NLAT) { dst = P.out + (size_t)row * 1024; mod = row >> 13; } else { dst = xctx + (size_t)(row - NLAT) * 1024; mod = 4; }
        f32x4 xv[4];
#pragma unroll
        for (int i = 0; i < 4; ++i) xv[i] = xn[i];
        if (row + stride < NT) MN_LOAD(row + stride);
        if (row >= NLAT && nks > 0) {
#pragma unroll
            for (int i = 0; i < 4; ++i) {
                f32x4 s = (f32x4){0.f, 0.f, 0.f, 0.f};
                for (int ks = 0; ks < nks; ++ks) s += *(const f32x4*)(slab + ((size_t)ks * NCTX + (row - NLAT)) * 1024 + lane * 4 + 256 * i);
                xv[i] += *(const f32x4*)(gatep + lane * 4 + 256 * i) * coefp * s;
                *(f32x4*)(dst + lane * 4 + 256 * i) = xv[i];
            }
        }
        float ss = 0.f;
#pragma unroll
        for (int i = 0; i < 4; ++i) ss += xv[i][0] * xv[i][0] + xv[i][1] * xv[i][1] + xv[i][2] * xv[i][2] + xv[i][3] * xv[i][3];
        if (first) {
#pragma unroll
            for (int i = 0; i < 4; ++i) *(f32x4*)(dst + lane * 4 + 256 * i) = xv[i];
        }
        if (mod != curmod) {
            const float* mp = mods_l + (size_t)mod * 9216 + (3 * j) * 1024;
#pragma unroll
            for (int i = 0; i < 4; ++i) { sh[i] = *(const f32x4*)(mp + lane * 4 + 256 * i); scl[i] = *(const f32x4*)(mp + 1024 + lane * 4 + 256 * i) + 1.0f; }
            curmod = mod;
        }
        const float rstd = rsqrtf(wave_sum(ss) * (1.0f / 1024.0f) + EPS);
#pragma unroll
        for (int i = 0; i < 4; ++i) {
            const f32x4 hv = xv[i] * rstd * gv[i] * scl[i] + sh[i];
            u32x2 w; w.x = cvt_pk_bf16(hv[0], hv[1]); w.y = cvt_pk_bf16(hv[2], hv[3]);
            *(u32x2*)(H + (size_t)row * 1024 + lane * 4 + 256 * i) = w;
        }
    }
#undef MN_LOAD
}
__device__ __forceinline__ void phase_final(CPR P) {
    const int tid_ = opaque_tid(); const int lane = tid_ & 63, wid = tid_ >> 6;
    const float* gn = P.in[I_GFINAL];
    f32x4 gv[4];
#pragma unroll
    for (int i = 0; i < 4; ++i) gv[i] = *(const f32x4*)(gn + lane * 4 + 256 * i);
    for (int row = blockIdx.x * 8 + wid; row < NLAT; row += gridDim.x * 8) {
        float* p = P.out + (size_t)row * 1024;
        f32x4 xv[4]; float ss = 0.f;
#pragma unroll
        for (int i = 0; i < 4; ++i) { xv[i] = *(const f32x4*)(p + lane * 4 + 256 * i); ss += xv[i][0] * xv[i][0] + xv[i][1] * xv[i][1] + xv[i][2] * xv[i][2] + xv[i][3] * xv[i][3]; }
        const float rstd = rsqrtf(wave_sum(ss) * (1.0f / 1024.0f) + EPS);
#pragma unroll
        for (int i = 0; i < 4; ++i) *(f32x4*)(p + lane * 4 + 256 * i) = xv[i] * rstd * gv[i];
    }
}

__device__ __forceinline__ void scan_gla(CPR P, int l, int b, int h, int dir, lds_t lds) {
    const int tid = opaque_tid(), lane = tid & 63, wid = tid >> 6, fr = lane & 15, fq = lane >> 4;
    const bf16_t* PB = (const bf16_t*)(P.ws + WS_PB); const float* PG = (const float*)(P.ws + WS_PG);
    bf16_t* OUT = (bf16_t*)(P.ws + (dir ? WS_H2 : WS_H));
    lds_t QR = lds, KR = lds + 9216, VT = lds + 18432, QT = lds + 27648, KT = lds + 36864, KWT = lds + 46080, ATT = lds + 55296, ST = lds + 64512;
    LAS float* LR = (LAS float*)(lds + 73728); LAS float* TOT = (LAS float*)(lds + 77824); LAS float* DEC = (LAS float*)(lds + 79872);
    const int d = tid & 63, o = tid >> 6;
    float wreg[16];
#pragma unroll
    for (int r = 0; r < 16; ++r) wreg[r] = P.in[I_GLAW][(size_t)((l * 2 + dir) * 16 + r) * 256 + h * 64 + d];
    const float bias = P.in[I_GLAB][(l * 2 + dir) * 256 + h * 64 + d];
    for (int i = tid; i < 9216 / 4; i += 512) ((LAS unsigned*)ST)[i] = 0u;
    f32x4 sacc[2] = {(f32x4){0.f, 0.f, 0.f, 0.f}, (f32x4){0.f, 0.f, 0.f, 0.f}};
    const int tm = wid >> 1, tn0 = (wid & 1) * 2;
    __syncthreads();
    u32x4 q8, k8, v8; f32x4 lr4 = (f32x4){0.f, 0.f, 0.f, 0.f};
#define GLA_ISSUE(cc_) do { const int sg_ = (cc_) >= 4, c_ = sg_ ? (cc_) - 4 : (cc_), L_ = sg_ ? SEQ : CTXL; const int t_ = tid >> 3, c8_ = tid & 7; const int lp_ = c_ * 64 + t_, p_ = dir ? (L_ - 1 - lp_) : lp_; \
        const bf16_t* pr_ = PB + (size_t)tok_row(sg_, b, p_, false) * NINP + h * 64 + c8_ * 8; \
        q8 = *(const u32x4*)(pr_ + GLA_Q); k8 = *(const u32x4*)(pr_ + GLA_K); v8 = *(const u32x4*)(pr_ + GLA_V); \
        { const int t2_ = (tid & 255) >> 2, r4_ = tid & 3; const int lp2_ = c_ * 64 + t2_, p2_ = dir ? (L_ - 1 - lp2_) : lp2_; \
            lr4 = *(const f32x4*)(PG + (size_t)tok_row(sg_, b, p2_, false) * PGW + dir * 16 + r4_ * 4); } } while (0)
    constexpr int D_GA = 80384, D_LR = 108032 - 73728;
#define GLA_STAGE(pp_) do { lds_t QRp_ = QR + (pp_) * D_GA; lds_t KRp_ = KR + (pp_) * D_GA; lds_t VTp_ = VT + (pp_) * D_GA; LAS float* LRp_ = LR + (pp_) * (D_LR / 4); \
        asm volatile("s_waitcnt vmcnt(0)" ::: "memory"); \
        { const int t_ = tid >> 3, c8_ = tid & 7; \
          *(LAS u32x4*)(QRp_ + t_ * LDT + c8_ * 16) = q8; *(LAS u32x4*)(KRp_ + t_ * LDT + c8_ * 16) = k8; \
          _Pragma("unroll") for (int i_ = 0; i_ < 4; ++i_) { *(LAS bf16_t*)(VTp_ + (c8_ * 8 + 2 * i_) * LDT + t_ * 2) = (bf16_t)(v8[i_] & 0xffffu); *(LAS bf16_t*)(VTp_ + (c8_ * 8 + 2 * i_ + 1) * LDT + t_ * 2) = (bf16_t)(v8[i_] >> 16); } \
          if (tid < 256) { const int t2_ = tid >> 2, r4_ = tid & 3; *(LAS f32x4*)(LRp_ + t2_ * 16 + r4_ * 4) = lr4; } } } while (0)
    constexpr int D_KW = 112128 - 46080, D_DEC = 121344 - 79872;
    float bl[8];
#define GLA_B1(pp_) do { LAS float* LRp_ = LR + (pp_) * (D_LR / 4); float run_ = 0.f; \
        _Pragma("unroll") for (int i_ = 0; i_ < 8; ++i_) { const int t_ = o * 8 + i_; float dot_ = bias; \
            _Pragma("unroll") for (int r4_ = 0; r4_ < 4; ++r4_) { const f32x4 x_ = *(const LAS f32x4*)(LRp_ + t_ * 16 + r4_ * 4); dot_ += x_[0] * wreg[4 * r4_] + x_[1] * wreg[4 * r4_ + 1] + x_[2] * wreg[4 * r4_ + 2] + x_[3] * wreg[4 * r4_ + 3]; } \
            run_ += logsigf_(dot_) * (1.0f / 16.0f); bl[i_] = run_; } \
        TOT[o * 64 + d] = run_; } while (0)
#define GLA_B2(pp_) do { lds_t QRp_ = QR + (pp_) * D_GA; lds_t KRp_ = KR + (pp_) * D_GA; float pre_ = 0.f, tot_ = 0.f; \
        _Pragma("unroll") for (int o2_ = 0; o2_ < 8; ++o2_) { const float v_ = TOT[o2_ * 64 + d]; if (o2_ < o) pre_ += v_; tot_ += v_; } \
        float kw_[8]; const float et_ = __expf(tot_); \
        _Pragma("unroll") for (int i_ = 0; i_ < 8; ++i_) { const int t_ = o * 8 + i_; const float bb_ = pre_ + bl[i_]; const float enb_ = __expf(-bb_); \
            const float qv_ = bf2f(*(const LAS bf16_t*)(QRp_ + t_ * LDT + d * 2)), kv_ = bf2f(*(const LAS bf16_t*)(KRp_ + t_ * LDT + d * 2)); \
            *(LAS bf16_t*)(QT + t_ * LDT + d * 2) = f2bf(qv_ * 0.125f * __expf(bb_)); *(LAS bf16_t*)(KT + t_ * LDT + d * 2) = f2bf(kv_ * enb_); kw_[i_] = kv_ * (et_ * enb_); } \
        u32x4 w_; w_.x = cvt_pk_bf16(kw_[0], kw_[1]); w_.y = cvt_pk_bf16(kw_[2], kw_[3]); w_.z = cvt_pk_bf16(kw_[4], kw_[5]); w_.w = cvt_pk_bf16(kw_[6], kw_[7]); \
        *(LAS u32x4*)(KWT + (pp_) * D_KW + d * LDT + o * 16) = w_; if (o == 0) (DEC + (pp_) * (D_DEC / 4))[d] = et_; } while (0)
    GLA_ISSUE(0);
    GLA_STAGE(0);
    GLA_ISSUE(1);
    __syncthreads();
    GLA_B1(0);
    __syncthreads();
    GLA_B2(0);
    __syncthreads();
#pragma unroll 1
    for (int cc = 0; cc < 132; ++cc) {
        {
            const int seg = cc >= 4, c = seg ? cc - 4 : cc, L = seg ? SEQ : CTXL; const int pb = cc & 1;
            lds_t VTc = VT + pb * D_GA; lds_t KWTc = KWT + pb * D_KW; LAS float* DECc = DEC + pb * (D_DEC / 4);
            f32x4 oacc[2];
#pragma unroll
            for (int i = 0; i < 2; ++i) {
                const int tn = tn0 + i; f32x4 a = (f32x4){0.f, 0.f, 0.f, 0.f};
                mma_tile<true, 2, LDT, LDT>(a, QT, tm * 16, KT, tn * 16, fr, fq);
                const int t = tm * 16 + fr, s0 = tn * 16 + fq * 4;
#pragma unroll
                for (int jx = 0; jx < 4; ++jx) a[jx] = (s0 + jx <= t) ? a[jx] : 0.f;
                u32x2 w; w.x = cvt_pk_bf16(a[0], a[1]); w.y = cvt_pk_bf16(a[2], a[3]);
                *(LAS u32x2*)(ATT + t * LDT + s0 * 2) = w;
                oacc[i] = (f32x4){0.f, 0.f, 0.f, 0.f};
                mma_tile<true, 2, LDT, LDT>(oacc[i], QT, tm * 16, ST, tn * 16, fr, fq);
            }
            if (cc + 1 < 132) { GLA_STAGE(pb ^ 1); if (cc + 2 < 132) GLA_ISSUE(cc + 2); }
            __syncthreads();
            {
                const int t = tm * 16 + fr; const int lp = c * 64 + t, p = dir ? (L - 1 - lp) : lp;
                bf16_t* orow = OUT + (size_t)tok_row(seg, b, p, false) * 1024 + 0 + h * 64;
#pragma unroll
                for (int i = 0; i < 2; ++i) {
                    const int tn = tn0 + i;
                    mma_tile<true, 2, LDT, LDT>(oacc[i], ATT, tm * 16, VTc, tn * 16, fr, fq);
                    u32x2 w; w.x = cvt_pk_bf16(oacc[i][0], oacc[i][1]); w.y = cvt_pk_bf16(oacc[i][2], oacc[i][3]);
                    *(u32x2*)(orow + tn * 16 + fq * 4) = w;
                }
            }
            GLA_B1(pb ^ 1);
            __syncthreads();
            {
                const f32x4 dv = *(const LAS f32x4*)(DECc + tm * 16 + fq * 4);
#pragma unroll
                for (int i = 0; i < 2; ++i) {
                    const int tn = tn0 + i;
                    sacc[i] *= dv;
                    mma_tile<false, 2, LDT, LDT>(sacc[i], KWTc, tm * 16, VTc, tn * 16, fr, fq);
                    u32x2 w; w.x = cvt_pk_bf16(sacc[i][0], sacc[i][1]); w.y = cvt_pk_bf16(sacc[i][2], sacc[i][3]);
                    *(LAS u32x2*)(ST + (tn * 16 + fr) * LDT + (tm * 16 + fq * 4) * 2) = w;
                }
            }
            GLA_B2(pb ^ 1);
            __syncthreads();
        }
    }
}

__device__ __forceinline__ void scan_ssd(CPR P, int l, int b, int h, int dir, lds_t lds) {
    const int tid = opaque_tid(), lane = tid & 63, wid = tid >> 6, fr = lane & 15, fq = lane >> 4;
    const bf16_t* PB = (const bf16_t*)(P.ws + WS_PB); const float* PG = (const float*)(P.ws + WS_PG);
    bf16_t* OUT = (bf16_t*)(P.ws + (dir ? WS_H2 : WS_H));
    lds_t CM = lds, BM = lds + 9216, XT = lds + 18432, BWT = lds + 27648, SC = lds + 36864, ST = lds + 46080, XS = lds + 55296, RAW = lds + 64512;
    LAS float* CUM = (LAS float*)(lds + 90912); LAS float* DTV = (LAS float*)(lds + 91168); LAS float* EWV = (LAS float*)(lds + 91424);
    constexpr int RS = 400;
    const int d = tid & 63, o = tid >> 6, g2 = h >> 1;
    const float* cw = P.in[I_SSDCW] + (size_t)l * 3 * 512; const float* cb = P.in[I_SSDCB] + (size_t)l * 512;
    const int chv[3] = {h * 64 + d, 256 + g2 * 64 + d, 384 + g2 * 64 + d};
    float w0[3], w1[3], w2[3], wb[3];
#pragma unroll
    for (int g = 0; g < 3; ++g) { w0[g] = cw[(dir ? 2 : 0) * 512 + chv[g]]; w1[g] = cw[512 + chv[g]]; w2[g] = cw[(dir ? 0 : 2) * 512 + chv[g]]; wb[g] = cb[chv[g]]; }
    const float dtb = P.in[I_SSDDTB][(l * 2 + dir) * 4 + h], nega = -__expf(P.in[I_SSDALOG][(l * 2 + dir) * 4 + h]), dsk = P.in[I_SSDD][l * 4 + h]; const float dskv = dir == 0 ? dsk : 0.f;
    for (int i = tid; i < 9216 / 4; i += 512) ((LAS unsigned*)ST)[i] = 0u;
    f32x4 sacc[2] = {(f32x4){0.f, 0.f, 0.f, 0.f}, (f32x4){0.f, 0.f, 0.f, 0.f}};
    const int tm = wid >> 1, tn0 = (wid & 1) * 2;
    __syncthreads();
    u32x4 rw[4]; float dtraw = 0.f;
#define SSD_LD(dst_, lp_) do { int lpp_ = (lp_); lpp_ = lpp_ < 0 ? 0 : (lpp_ >= L_ ? L_ - 1 : lpp_); const int p_ = dir ? (L_ - 1 - lpp_) : lpp_; \
        const int col_ = cgp_ == 0 ? SSD_X + h * 64 : (cgp_ == 1 ? SSD_B + g2 * 64 : SSD_C + g2 * 64); dst_ = *(const u32x4*)(PB + (size_t)tok_row(sg_, b, p_, true) * NINP + col_ + c8_ * 8); } while (0)
#define SSD_ISSUE(cc_) do { const int sg_ = (cc_) >= 4, c_ = sg_ ? (cc_) - 4 : (cc_), L_ = sg_ ? SEQ : CTXL; \
        _Pragma("unroll") for (int k_ = 0; k_ < 3; ++k_) { const int idx_ = tid + 512 * k_; const int rr_ = idx_ / 24, rem_ = idx_ % 24, cgp_ = rem_ >> 3, c8_ = rem_ & 7; SSD_LD(rw[k_], c_ * 64 + rr_); } \
        { const int th_ = tid % 48; const int rr_ = th_ / 24, rem_ = th_ % 24, cgp_ = rem_ >> 3, c8_ = rem_ & 7; SSD_LD(rw[3], c_ * 64 + (rr_ ? 64 : -1)); } \
        { const int lp_ = c_ * 64 + lane, p_ = dir ? (L_ - 1 - lp_) : lp_; dtraw = PG[(size_t)tok_row(sg_, b, p_, true) * PGW + 32 + dir * 4 + h]; } } while (0)
    constexpr int D_SB = 91904 - 64512;
#define SSD_STAGE(cn_, pp_) do { const int sgS_ = (cn_) >= 4, cS_ = sgS_ ? (cn_) - 4 : (cn_), LS_ = sgS_ ? SEQ : CTXL; \
        lds_t RAWp_ = RAW + (pp_) * D_SB; LAS float* CUMp_ = CUM + (pp_) * (D_SB / 4); LAS float* DTVp_ = DTV + (pp_) * (D_SB / 4); LAS float* EWVp_ = EWV + (pp_) * (D_SB / 4); \
        asm volatile("s_waitcnt vmcnt(0)" ::: "memory"); \
        _Pragma("unroll") for (int k_ = 0; k_ < 3; ++k_) { const int idx_ = tid + 512 * k_; const int rr_ = idx_ / 24, rem_ = idx_ % 24, cgp_ = rem_ >> 3, c8_ = rem_ & 7; *(LAS u32x4*)(RAWp_ + (rr_ + 1) * RS + cgp_ * 128 + c8_ * 16) = rw[k_]; } \
        if (tid < 48) { const int rr_ = tid / 24, rem_ = tid % 24, cgp_ = rem_ >> 3, c8_ = rem_ & 7; const int lph_ = cS_ * 64 + (rr_ ? 64 : -1); \
            *(LAS u32x4*)(RAWp_ + (rr_ ? 65 : 0) * RS + cgp_ * 128 + c8_ * 16) = (lph_ >= 0 && lph_ < LS_) ? rw[3] : (u32x4){0u, 0u, 0u, 0u}; } \
        if (wid == 0) { const float dt_ = softplusf_(dtraw + dtb); const float cum_ = wave_scan_add(dt_ * nega, lane); DTVp_[lane] = dt_; CUMp_[lane] = cum_; \
            const float clv_ = __int_as_float(__builtin_amdgcn_readlane(__float_as_int(cum_), 63)); EWVp_[lane] = __expf(clv_ - cum_); } } while (0)
    constexpr int D_XB = 119072 - 18432;
#define SSD_BCB(pp_) do { lds_t RAWp_ = RAW + (pp_) * D_SB; LAS float* EWVp_ = EWV + (pp_) * (D_SB / 4); float bw_[8]; \
        _Pragma("unroll") for (int g_ = 1; g_ < 3; ++g_) { \
            float prev_ = bf2f(*(const LAS bf16_t*)(RAWp_ + (o * 8 + 0) * RS + g_ * 128 + d * 2)), cur_ = bf2f(*(const LAS bf16_t*)(RAWp_ + (o * 8 + 1) * RS + g_ * 128 + d * 2)); \
            _Pragma("unroll") for (int i_ = 0; i_ < 8; ++i_) { const int t_ = o * 8 + i_; const float nxt_ = bf2f(*(const LAS bf16_t*)(RAWp_ + (t_ + 2) * RS + g_ * 128 + d * 2)); \
                const float v_ = siluf_(w0[g_] * prev_ + w1[g_] * cur_ + w2[g_] * nxt_ + wb[g_]); prev_ = cur_; cur_ = nxt_; \
                if (g_ == 1) { *(LAS bf16_t*)(BM + t_ * LDT + d * 2) = f2bf(v_); bw_[i_] = v_ * EWVp_[t_]; } else { *(LAS bf16_t*)(CM + t_ * LDT + d * 2) = f2bf(v_); } } } \
        u32x4 w_; w_.x = cvt_pk_bf16(bw_[0], bw_[1]); w_.y = cvt_pk_bf16(bw_[2], bw_[3]); w_.z = cvt_pk_bf16(bw_[4], bw_[5]); w_.w = cvt_pk_bf16(bw_[6], bw_[7]); \
        *(LAS u32x4*)(BWT + (pp_) * D_XB + d * LDT + o * 16) = w_; } while (0)
#define SSD_BX(pp_) do { lds_t RAWp_ = RAW + (pp_) * D_SB; LAS float* DTVp_ = DTV + (pp_) * (D_SB / 4); float xt_[8]; \
        float prev_ = bf2f(*(const LAS bf16_t*)(RAWp_ + (o * 8 + 0) * RS + d * 2)), cur_ = bf2f(*(const LAS bf16_t*)(RAWp_ + (o * 8 + 1) * RS + d * 2)); \
        _Pragma("unroll") for (int i_ = 0; i_ < 8; ++i_) { const int t_ = o * 8 + i_; const float nxt_ = bf2f(*(const LAS bf16_t*)(RAWp_ + (t_ + 2) * RS + d * 2)); \
            const float v_ = siluf_(w0[0] * prev_ + w1[0] * cur_ + w2[0] * nxt_ + wb[0]); prev_ = cur_; cur_ = nxt_; \
            *(LAS bf16_t*)(XS + t_ * LDT + d * 2) = f2bf(v_); xt_[i_] = v_ * DTVp_[t_]; } \
        u32x4 w_; w_.x = cvt_pk_bf16(xt_[0], xt_[1]); w_.y = cvt_pk_bf16(xt_[2], xt_[3]); w_.z = cvt_pk_bf16(xt_[4], xt_[5]); w_.w = cvt_pk_bf16(xt_[6], xt_[7]); \
        *(LAS u32x4*)(XT + (pp_) * D_XB + d * LDT + o * 16) = w_; } while (0)
    SSD_ISSUE(0);
    SSD_STAGE(0, 0);
    SSD_ISSUE(1);
    __syncthreads();
    SSD_BCB(0); SSD_BX(0);
    __syncthreads();
#pragma unroll 1
    for (int cc = 0; cc < 132; ++cc) {
        {
            const int seg = cc >= 4, c = seg ? cc - 4 : cc, L = seg ? SEQ : CTXL; const int pb = cc & 1;
            LAS float* CUMc = CUM + pb * (D_SB / 4); lds_t XTc = XT + pb * D_XB; lds_t BWTc = BWT + pb * D_XB;
            f32x4 yacc[2];
            {
                const int t = tm * 16 + fr; const float ct = CUMc[t]; const float ect = __expf(ct);
#pragma unroll
                for (int i = 0; i < 2; ++i) {
                    const int tn = tn0 + i; f32x4 a = (f32x4){0.f, 0.f, 0.f, 0.f};
                    mma_tile<true, 2, LDT, LDT>(a, CM, tm * 16, BM, tn * 16, fr, fq);
                    const int s0 = tn * 16 + fq * 4; const f32x4 cs = *(const LAS f32x4*)(CUMc + s0);
#pragma unroll
                    for (int jx = 0; jx < 4; ++jx) a[jx] = (s0 + jx <= t) ? a[jx] * __expf(ct - cs[jx]) : 0.f;
                    u32x2 w; w.x = cvt_pk_bf16(a[0], a[1]); w.y = cvt_pk_bf16(a[2], a[3]);
                    *(LAS u32x2*)(SC + t * LDT + s0 * 2) = w;
                    yacc[i] = (f32x4){0.f, 0.f, 0.f, 0.f};
                    mma_tile<true, 2, LDT, LDT>(yacc[i], CM, tm * 16, ST, tn * 16, fr, fq);
                    yacc[i] *= ect;
                }
            }
            if (cc + 1 < 132) { SSD_STAGE(cc + 1, pb ^ 1); if (cc + 2 < 132) SSD_ISSUE(cc + 2); }
            __syncthreads();
            {
                const int t = tm * 16 + fr; const int lp = c * 64 + t, p = dir ? (L - 1 - lp) : lp;
                bf16_t* orow = OUT + (size_t)tok_row(seg, b, p, true) * 1024 + 256 + h * 64;
#pragma unroll
                for (int i = 0; i < 2; ++i) {
                    const int tn = tn0 + i, p0 = tn * 16 + fq * 4;
                    mma_tile<true, 2, LDT, LDT>(yacc[i], SC, tm * 16, XTc, tn * 16, fr, fq);
                    {
                        const u32x2 xs = *(const LAS u32x2*)(XS + t * LDT + p0 * 2);
                        yacc[i][0] += dskv * bflo(xs.x); yacc[i][1] += dskv * bfhi(xs.x); yacc[i][2] += dskv * bflo(xs.y); yacc[i][3] += dskv * bfhi(xs.y); }
                    u32x2 w; w.x = cvt_pk_bf16(yacc[i][0], yacc[i][1]); w.y = cvt_pk_bf16(yacc[i][2], yacc[i][3]);
                    *(u32x2*)(orow + p0) = w;
                }
            }
            SSD_BCB(pb ^ 1);
            __syncthreads();
            {
                const float ecl_in = CUMc[63]; const float ecl = __expf(ecl_in);
#pragma unroll
                for (int i = 0; i < 2; ++i) {
                    const int tn = tn0 + i;
                    sacc[i] *= ecl;
                    mma_tile<false, 2, LDT, LDT>(sacc[i], BWTc, tm * 16, XTc, tn * 16, fr, fq);
                    u32x2 w; w.x = cvt_pk_bf16(sacc[i][0], sacc[i][1]); w.y = cvt_pk_bf16(sacc[i][2], sacc[i][3]);
                    *(LAS u32x2*)(ST + (tn * 16 + fr) * LDT + (tm * 16 + fq * 4) * 2) = w;
                }
            }
            SSD_BX(pb ^ 1);
            __syncthreads();
        }
    }
}

__device__ __forceinline__ void scan_mlstm(CPR P, int l, int b, int h, int dir, lds_t lds) {
    const int tid = opaque_tid(), lane = tid & 63, wid = tid >> 6, fr = lane & 15, fq = lane >> 4;
    const bf16_t* PB = (const bf16_t*)(P.ws + WS_PB); const float* PG = (const float*)(P.ws + WS_PG);
    bf16_t* OUT = (bf16_t*)(P.ws + (dir ? WS_H2 : WS_H));
    lds_t QM = lds, KM = lds + 9216, KWT = lds + 18432, WM = lds + 27648, VT = lds + 36864, CT = lds + 48384, RAW = lds + 59904;
    LAS float* FV = (LAS float*)(lds + 77856); LAS float* AV = (LAS float*)(lds + 78112); LAS float* MV = (LAS float*)(lds + 78368); LAS float* DEN = (LAS float*)(lds + 78624); LAS float* KWE = (LAS float*)(lds + 79648);
    constexpr int RS = 272;
    const int d = tid & 63, o = tid >> 6;
    const float* cw = P.in[I_MLCW] + (size_t)l * 3 * 512; const float* cb = P.in[I_MLCB] + (size_t)l * 512;
    const int chv[2] = {h * 64 + d, 256 + h * 64 + d};
    float w0[2], w1[2], w2[2], wb[2];
#pragma unroll
    for (int g = 0; g < 2; ++g) { w0[g] = cw[(dir ? 2 : 0) * 512 + chv[g]]; w1[g] = cw[512 + chv[g]]; w2[g] = cw[(dir ? 0 : 2) * 512 + chv[g]]; wb[g] = cb[chv[g]]; }
    const float gbi = P.in[I_MLGB][l * 16 + dir * 8 + h], gbf = P.in[I_MLGB][l * 16 + dir * 8 + 4 + h];
    for (int i = tid; i < 11520 / 4; i += 512) ((LAS unsigned*)CT)[i] = 0u;
    constexpr int D_VT = 80000 - 36864, D_RAW = 91520 - 59904, D_G = 31744;
    for (int i = tid; i < 16 * LDT / 4; i += 512) { const unsigned v = (i < LDT / 4) ? 0x3F803F80u : 0u; ((LAS unsigned*)(VT + 64 * LDT))[i] = v; ((LAS unsigned*)(VT + D_VT + 64 * LDT))[i] = v; }
    f32x4 cacc[3] = {(f32x4){0.f, 0.f, 0.f, 0.f}, (f32x4){0.f, 0.f, 0.f, 0.f}, (f32x4){0.f, 0.f, 0.f, 0.f}};
    float m_s = 0.f;
    const int tm = wid >> 1, tn0 = (wid & 1) * 2; const bool extra = (wid & 1) == 0;
    __syncthreads();
    u32x4 rw[3], v8; float graw_i = 0.f, graw_f = 0.f;
#define ML_LD(dst_, lp_) do { int lpp_ = (lp_); lpp_ = lpp_ < 0 ? 0 : (lpp_ >= L_ ? L_ - 1 : lpp_); const int p_ = dir ? (L_ - 1 - lpp_) : lpp_; \
        dst_ = *(const u32x4*)(PB + (size_t)tok_row(sg_, b, p_, false) * NINP + ML_Q + cgp_ * 256 + h * 64 + c8_ * 8); } while (0)
#define ML_ISSUE(cc_) do { const int sg_ = (cc_) >= 4, c_ = sg_ ? (cc_) - 4 : (cc_), L_ = sg_ ? SEQ : CTXL; \
        _Pragma("unroll") for (int k_ = 0; k_ < 2; ++k_) { const int idx_ = tid + 512 * k_; const int rr_ = idx_ >> 4, rem_ = idx_ & 15, cgp_ = rem_ >> 3, c8_ = rem_ & 7; ML_LD(rw[k_], c_ * 64 + rr_); } \
        { const int th_ = tid & 31; const int rr_ = th_ >> 4, rem_ = th_ & 15, cgp_ = rem_ >> 3, c8_ = rem_ & 7; ML_LD(rw[2], c_ * 64 + (rr_ ? 64 : -1)); } \
        { const int t_ = tid >> 3, c8_ = tid & 7; const int lp_ = c_ * 64 + t_, p_ = dir ? (L_ - 1 - lp_) : lp_; v8 = *(const u32x4*)(PB + (size_t)tok_row(sg_, b, p_, false) * NINP + ML_V + h * 64 + c8_ * 8); } \
        { const int lp_ = c_ * 64 + lane, p_ = dir ? (L_ - 1 - lp_) : lp_; const float* pg_ = PG + (size_t)tok_row(sg_, b, p_, false) * PGW + 64 + dir * 8 + h; graw_i = pg_[0]; graw_f = pg_[4]; } } while (0)
#define ML_STAGE(cn_, pp_, ms_) do { const int sgS_ = (cn_) >= 4, cS_ = sgS_ ? (cn_) - 4 : (cn_), LS_ = sgS_ ? SEQ : CTXL; \
        lds_t RAWp_ = RAW + (pp_) * D_RAW; lds_t VTp_ = VT + (pp_) * D_VT; LAS float* FVp_ = FV + (pp_) * (D_G / 4); LAS float* AVp_ = AV + (pp_) * (D_G / 4); LAS float* MVp_ = MV + (pp_) * (D_G / 4); LAS float* KWEp_ = KWE + (pp_) * (D_G / 4); \
        asm volatile("s_waitcnt vmcnt(0)" ::: "memory"); \
        _Pragma("unroll") for (int k_ = 0; k_ < 2; ++k_) { const int idx_ = tid + 512 * k_; const int rr_ = idx_ >> 4, rem_ = idx_ & 15, cgp_ = rem_ >> 3, c8_ = rem_ & 7; *(LAS u32x4*)(RAWp_ + (rr_ + 1) * RS + cgp_ * 128 + c8_ * 16) = rw[k_]; } \
        if (tid < 32) { const int rr_ = tid >> 4, rem_ = tid & 15, cgp_ = rem_ >> 3, c8_ = rem_ & 7; const int lph_ = cS_ * 64 + (rr_ ? 64 : -1); \
            *(LAS u32x4*)(RAWp_ + (rr_ ? 65 : 0) * RS + cgp_ * 128 + c8_ * 16) = (lph_ >= 0 && lph_ < LS_) ? rw[2] : (u32x4){0u, 0u, 0u, 0u}; } \
        { const int t_ = tid >> 3, c8_ = tid & 7; \
          _Pragma("unroll") for (int i_ = 0; i_ < 4; ++i_) { *(LAS bf16_t*)(VTp_ + (c8_ * 8 + 2 * i_) * LDT + t_ * 2) = (bf16_t)(v8[i_] & 0xffffu); *(LAS bf16_t*)(VTp_ + (c8_ * 8 + 2 * i_ + 1) * LDT + t_ * 2) = (bf16_t)(v8[i_] >> 16); } } \
        if (wid == 0) { const float ig_ = graw_i + gbi, lf_ = logsigf_(graw_f + gbf); \
            const float F_ = wave_scan_add(lf_, lane); const float a_ = ig_ - F_; const float M_ = fmaxf(wave_scan_max(a_, lane), (ms_)); \
            FVp_[lane] = F_; AVp_[lane] = a_; MVp_[lane] = M_; \
            const float m63_ = __int_as_float(__builtin_amdgcn_readlane(__float_as_int(M_), 63)); KWEp_[lane] = __expf(a_ - m63_); } } while (0)
    constexpr int D_KW = 111648 - 18432;
#define ML_BQ(pp_) do { lds_t RAWp_ = RAW + (pp_) * D_RAW; \
        float prev_ = bf2f(*(const LAS bf16_t*)(RAWp_ + (o * 8 + 0) * RS + d * 2)), cur_ = bf2f(*(const LAS bf16_t*)(RAWp_ + (o * 8 + 1) * RS + d * 2)); \
        _Pragma("unroll") for (int i_ = 0; i_ < 8; ++i_) { const int t_ = o * 8 + i_; const float nxt_ = bf2f(*(const LAS bf16_t*)(RAWp_ + (t_ + 2) * RS + d * 2)); \
            const float v_ = siluf_(w0[0] * prev_ + w1[0] * cur_ + w2[0] * nxt_ + wb[0]); prev_ = cur_; cur_ = nxt_; *(LAS bf16_t*)(QM + t_ * LDT + d * 2) = f2bf(v_); } } while (0)
#define ML_BK(pp_) do { lds_t RAWp_ = RAW + (pp_) * D_RAW; LAS float* KWEp_ = KWE + (pp_) * (D_G / 4); float kw_[8]; \
        float prev_ = bf2f(*(const LAS bf16_t*)(RAWp_ + (o * 8 + 0) * RS + 128 + d * 2)), cur_ = bf2f(*(const LAS bf16_t*)(RAWp_ + (o * 8 + 1) * RS + 128 + d * 2)); \
        _Pragma("unroll") for (int i_ = 0; i_ < 8; ++i_) { const int t_ = o * 8 + i_; const float nxt_ = bf2f(*(const LAS bf16_t*)(RAWp_ + (t_ + 2) * RS + 128 + d * 2)); \
            const float v_ = siluf_(w0[1] * prev_ + w1[1] * cur_ + w2[1] * nxt_ + wb[1]); prev_ = cur_; cur_ = nxt_; \
            const float kk_ = v_ * 0.125f; *(LAS bf16_t*)(KM + t_ * LDT + d * 2) = f2bf(kk_); kw_[i_] = kk_ * KWEp_[t_]; } \
        u32x4 w_; w_.x = cvt_pk_bf16(kw_[0], kw_[1]); w_.y = cvt_pk_bf16(kw_[2], kw_[3]); w_.z = cvt_pk_bf16(kw_[4], kw_[5]); w_.w = cvt_pk_bf16(kw_[6], kw_[7]); \
        *(LAS u32x4*)(KWT + (pp_) * D_KW + d * LDT + o * 16) = w_; } while (0)
    ML_ISSUE(0);
    ML_STAGE(0, 0, 0.f);
    ML_ISSUE(1);
    __syncthreads();
    ML_BQ(0); ML_BK(0);
    __syncthreads();
#pragma unroll 1
    for (int cc = 0; cc < 132; ++cc) {
        {
            const int seg = cc >= 4, c = seg ? cc - 4 : cc, L = seg ? SEQ : CTXL; const int pb = cc & 1;
            lds_t VTc = VT + pb * D_VT; LAS float* FVc = FV + pb * (D_G / 4); LAS float* AVc = AV + pb * (D_G / 4); LAS float* MVc = MV + pb * (D_G / 4); lds_t KWTc = KWT + pb * D_KW;
            f32x4 hacc[3];
            const int trow = tm * 16 + fr; const float Mt = MVc[trow];
            {
                const float winter = __expf(m_s - Mt);
#pragma unroll
                for (int i = 0; i < 2; ++i) {
                    const int tn = tn0 + i; f32x4 a = (f32x4){0.f, 0.f, 0.f, 0.f};
                    mma_tile<true, 2, LDT, LDT>(a, QM, tm * 16, KM, tn * 16, fr, fq);
                    const int s0 = tn * 16 + fq * 4; const f32x4 as = *(const LAS f32x4*)(AVc + s0);
#pragma unroll
                    for (int jx = 0; jx < 4; ++jx) a[jx] = (s0 + jx <= trow) ? a[jx] * __expf(as[jx] - Mt) : 0.f;
                    u32x2 w; w.x = cvt_pk_bf16(a[0], a[1]); w.y = cvt_pk_bf16(a[2], a[3]);
                    *(LAS u32x2*)(WM + trow * LDT + s0 * 2) = w;
                    hacc[i] = (f32x4){0.f, 0.f, 0.f, 0.f};
                    mma_tile<true, 2, LDT, LDT>(hacc[i], QM, tm * 16, CT, tn * 16, fr, fq);
                    hacc[i] *= winter;
                }
                hacc[2] = (f32x4){0.f, 0.f, 0.f, 0.f};
                if (extra) { mma_tile<true, 2, LDT, LDT>(hacc[2], QM, tm * 16, CT, 64, fr, fq); hacc[2] *= winter; }
            }
            if (cc + 1 < 132) { const float msn = FVc[63] + MVc[63]; ML_STAGE(cc + 1, pb ^ 1, msn); if (cc + 2 < 132) ML_ISSUE(cc + 2); }
            __syncthreads();
#pragma unroll
            for (int i = 0; i < 2; ++i) mma_tile<true, 2, LDT, LDT>(hacc[i], WM, tm * 16, VTc, (tn0 + i) * 16, fr, fq);
            if (extra) { mma_tile<true, 2, LDT, LDT>(hacc[2], WM, tm * 16, VTc, 64, fr, fq); DEN[fq * 64 + trow] = hacc[2][0]; }
            ML_BQ(pb ^ 1);
            __syncthreads();
            {
                const int lp = c * 64 + trow, p = dir ? (L - 1 - lp) : lp;
                bf16_t* orow = OUT + (size_t)tok_row(seg, b, p, false) * 1024 + 512 + h * 64;
                const float den = DEN[trow], mt = FVc[trow] + Mt; const float inv = 1.0f / fmaxf(fabsf(den), __expf(-mt));
#pragma unroll
                for (int i = 0; i < 2; ++i) {
                    u32x2 w; w.x = cvt_pk_bf16(hacc[i][0] * inv, hacc[i][1] * inv); w.y = cvt_pk_bf16(hacc[i][2] * inv, hacc[i][3] * inv);
                    *(u32x2*)(orow + (tn0 + i) * 16 + fq * 4) = w;
                }
                const float M63 = MVc[63]; const float decay = __expf(m_s - M63);
#pragma unroll
                for (int i = 0; i < 2; ++i) {
                    const int tn = tn0 + i;
                    cacc[i] *= decay;
                    mma_tile<false, 2, LDT, LDT>(cacc[i], KWTc, tm * 16, VTc, tn * 16, fr, fq);
                    u32x2 w; w.x = cvt_pk_bf16(cacc[i][0], cacc[i][1]); w.y = cvt_pk_bf16(cacc[i][2], cacc[i][3]);
                    *(LAS u32x2*)(CT + (tn * 16 + fr) * LDT + (tm * 16 + fq * 4) * 2) = w;
                }
                if (extra) {
                    cacc[2] *= decay;
                    mma_tile<false, 2, LDT, LDT>(cacc[2], KWTc, tm * 16, VTc, 64, fr, fq);
                    u32x2 w; w.x = cvt_pk_bf16(cacc[2][0], cacc[2][1]); w.y = cvt_pk_bf16(cacc[2][2], cacc[2][3]);
                    *(LAS u32x2*)(CT + (64 + fr) * LDT + (tm * 16 + fq * 4) * 2) = w;
                }
                m_s = FVc[63] + M63;
            }
            ML_BK(pb ^ 1);
            __syncthreads();
        }
    }
}

__device__ __forceinline__ void scan_s5(CPR P, int l, int b, int g, int dir, lds_t lds) {
    const int tid = opaque_tid(), lane = tid & 63, wid = tid >> 6, fr = lane & 15, fq = lane >> 4;
    const bf16_t* PB = (const bf16_t*)(P.ws + WS_PB);
    bf16_t* OUT = (bf16_t*)(P.ws + (dir ? WS_H2 : WS_H));
    constexpr int US = 80, HS = 272;
    lds_t UA = lds, BB = lds + 5120, HB = lds + 49152, CB = lds + 66560;
    LAS float* BU = (LAS float*)(lds + 15360); LAS float* EO = (LAS float*)(lds + 70912);
    const int n = tid & 63, o = tid >> 6;
    const int pidx = ((l * 2 + dir) * 16 + g) * 64 + n;
    const float are = fminf(P.in[I_S5ARE][pidx], -1e-4f), aim = P.in[I_S5AIM][pidx], step = expf(P.in[I_S5LS][(l * 2 + dir) * 16 + g]);
    const float mag = expf(are * step), abr = mag * cosf(aim * step), abi = mag * sinf(aim * step);
    {
        const float den = are * are + aim * aim, nr = abr - 1.0f, ni = abi;
        const float cre = (nr * are + ni * aim) / den, cim = (ni * are - nr * aim) / den;
#pragma unroll
        for (int jj = 0; jj < 2; ++jj) {
            const int j = o * 2 + jj;
            const float bre = P.in[I_S5BRE][(size_t)((l * 16 + g) * 64 + n) * 16 + j], bim = P.in[I_S5BIM][(size_t)((l * 16 + g) * 64 + n) * 16 + j];
            *(LAS bf16_t*)(BB + n * US + j * 2) = f2bf(cre * bre - cim * bim);
            *(LAS bf16_t*)(BB + (64 + n) * US + j * 2) = f2bf(cre * bim + cim * bre);
            *(LAS bf16_t*)(BB + n * US + (16 + j) * 2) = 0; *(LAS bf16_t*)(BB + (64 + n) * US + (16 + j) * 2) = 0;
            *(LAS bf16_t*)(UA + n * US + (16 + j) * 2) = 0;
            const float cr = P.in[I_S5CRE][(size_t)((l * 16 + g) * 16 + j) * 64 + n], ci = P.in[I_S5CIM][(size_t)((l * 16 + g) * 16 + j) * 64 + n];
            *(LAS bf16_t*)(CB + j * HS + n * 2) = f2bf(cr); *(LAS bf16_t*)(CB + j * HS + (64 + n) * 2) = f2bf(-ci);
        }
    }
    float a8r = abr, a8i = abi;
#pragma unroll
    for (int s = 0; s < 3; ++s) { const float r2 = a8r * a8r - a8i * a8i, i2 = 2.0f * a8r * a8i; a8r = r2; a8i = i2; }
    float h0r = 0.f, h0i = 0.f;
    __syncthreads();
    u32x4 u8 = (u32x4){0u, 0u, 0u, 0u};
#define S5_ISSUE(cc_) do { { const int sg_ = (cc_) >= 4, c_ = sg_ ? (cc_) - 4 : (cc_), L_ = sg_ ? SEQ : CTXL; const int t_ = (tid & 127) >> 1, hf_ = tid & 1; const int lp_ = c_ * 64 + t_, p_ = dir ? (L_ - 1 - lp_) : lp_; \
        u8 = *(const u32x4*)(PB + (size_t)tok_row(sg_, b, p_, true) * NINP + S50 + g * 16 + hf_ * 8); } } while (0)
    S5_ISSUE(0);
#pragma unroll 1
    for (int cc = 0; cc < 132; ++cc) {
        {
            const int seg = cc >= 4, c = seg ? cc - 4 : cc, L = seg ? SEQ : CTXL;
            asm volatile("s_waitcnt vmcnt(0)" ::: "memory");
            if (tid < 128) { const int t = tid >> 1, hf = tid & 1; *(LAS u32x4*)(UA + t * US + hf * 16) = u8; }
            __syncthreads();
            if (cc + 1 < 132) S5_ISSUE(cc + 1);
            {   const int tm = wid >> 1;
#pragma unroll
                for (int i = 0; i < 4; ++i) { const int tn = (wid & 1) * 4 + i; f32x4 a = (f32x4){0.f, 0.f, 0.f, 0.f};
                    mma_tile<false, 1, US, US>(a, UA, tm * 16, BB, tn * 16, fr, fq);
#pragma unroll
                    for (int jx = 0; jx < 4; ++jx) BU[(tm * 16 + fq * 4 + jx) * 132 + tn * 16 + fr] = a[jx]; }
            }
            __syncthreads();
            float hr[8], hi[8];
            {   float r = 0.f, im = 0.f;
#pragma unroll
                for (int i = 0; i < 8; ++i) { const int t = o * 8 + i; const float br = BU[t * 132 + n], bi = BU[t * 132 + 64 + n];
                    const float nr = abr * r - abi * im + br, ni = abr * im + abi * r + bi; r = nr; im = ni; hr[i] = r; hi[i] = im; }
                EO[o * 128 + n] = r; EO[o * 128 + 64 + n] = im;
            }
            __syncthreads();
            {   float cr = h0r, ci = h0i, mr = 0.f, mi = 0.f;
#pragma unroll
                for (int o2 = 0; o2 < 8; ++o2) { if (o2 == o) { mr = cr; mi = ci; }
                    const float er = EO[o2 * 128 + n], ei = EO[o2 * 128 + 64 + n];
                    const float nr = a8r * cr - a8i * ci + er, ni = a8r * ci + a8i * cr + ei; cr = nr; ci = ni; }
                h0r = cr; h0i = ci;
                float pr = abr, pi = abi;
#pragma unroll
                for (int i = 0; i < 8; ++i) { const int t = o * 8 + i;
                    const float vr = hr[i] + pr * mr - pi * mi, vi = hi[i] + pr * mi + pi * mr;
                    *(LAS bf16_t*)(HB + t * HS + n * 2) = f2bf(vr); *(LAS bf16_t*)(HB + t * HS + (64 + n) * 2) = f2bf(vi);
                    const float qr = pr * abr - pi * abi, qi = pr * abi + pi * abr; pr = qr; pi = qi; }
            }
            __syncthreads();
            if (wid < 4) { const int tm = wid; f32x4 a = (f32x4){0.f, 0.f, 0.f, 0.f};
                mma_tile<true, 4, HS, HS>(a, HB, tm * 16, CB, 0, fr, fq);
                const int t = tm * 16 + fr; const int lp = c * 64 + t, p = dir ? (L - 1 - lp) : lp;
                u32x2 w; w.x = cvt_pk_bf16(a[0], a[1]); w.y = cvt_pk_bf16(a[2], a[3]);
                __hip_atomic_store((unsigned long long*)(OUT + (size_t)tok_row(seg, b, p, true) * 1024 + 768 + g * 16 + fq * 4), ((unsigned long long)w.y << 32) | w.x, __ATOMIC_RELAXED, __HIP_MEMORY_SCOPE_AGENT); }
        }
    }
    __syncthreads();
}

__device__ __forceinline__ void phase_mixers(CPR P, int l, lds_t lds) {
#pragma unroll 1
    for (int item = blockIdx.x; item < 224; item += gridDim.x) {
        if (item < 32) scan_gla(P, l, item >> 3, (item >> 1) & 3, item & 1, lds);
        else if (item < 64) { const int i = item - 32; scan_ssd(P, l, i >> 3, (i >> 1) & 3, i & 1, lds); }
        else if (item < 96) { const int i = item - 64; scan_mlstm(P, l, i >> 3, (i >> 1) & 3, i & 1, lds); }
        else { const int i = item - 96; scan_s5(P, l, i >> 5, (i >> 1) & 15, i & 1, lds); }
        __syncthreads();
    }
    if ((int)blockIdx.x >= 224 && l + 1 < DEPTH) phase_convert(P, lds, l + 1, 224, (int)gridDim.x - 224);
}

__device__ __forceinline__ void phase_post(CPR P, int l) {
    const int tid_ = opaque_tid(); const int lane = tid_ & 63, wid = tid_ >> 6, c4 = lane * 4;
    bf16_t* H = (bf16_t*)(P.ws + WS_H); const bf16_t* H2 = (const bf16_t*)(P.ws + WS_H2); const bf16_t* PB = (const bf16_t*)(P.ws + WS_PB);
    bf16_t* GB = (bf16_t*)(P.ws + WS_GB);
    const f32x4 gg = *(const f32x4*)(P.in[I_GLAG] + l * 256 + c4), gs = *(const f32x4*)(P.in[I_SSDG] + l * 256 + c4), gm = *(const f32x4*)(P.in[I_MLG] + l * 256 + c4), sd = *(const f32x4*)(P.in[I_S5D] + l * 256 + c4);
    for (int row = blockIdx.x * 8 + wid; row < NT; row += gridDim.x * 8) {
        bf16_t* hrow = H + (size_t)row * 1024; const bf16_t* orow = H2 + (size_t)row * 1024; const bf16_t* pr = PB + (size_t)row * NINP;
        u32x2 f[4], bk[4];
#pragma unroll
        for (int q = 0; q < 4; ++q) { f[q] = *(const u32x2*)(hrow + q * 256 + c4); bk[q] = *(const u32x2*)(orow + q * 256 + c4); }
        const u32x2 rr = *(const u32x2*)(pr + GLA_R + c4), zz = *(const u32x2*)(pr + SSD_Z + c4), oo = *(const u32x2*)(pr + ML_O + c4), pp = *(const u32x2*)(pr + S50 + c4);
        float v[4][4];
#pragma unroll
        for (int q = 0; q < 4; ++q) { v[q][0] = bflo(f[q].x) + bflo(bk[q].x); v[q][1] = bfhi(f[q].x) + bfhi(bk[q].x); v[q][2] = bflo(f[q].y) + bflo(bk[q].y); v[q][3] = bfhi(f[q].y) + bfhi(bk[q].y); }
        const float rv[4] = {bflo(rr.x), bfhi(rr.x), bflo(rr.y), bfhi(rr.y)}, zv[4] = {bflo(zz.x), bfhi(zz.x), bflo(zz.y), bfhi(zz.y)};
        const float ov[4] = {bflo(oo.x), bfhi(oo.x), bflo(oo.y), bfhi(oo.y)}, pv[4] = {bflo(pp.x), bfhi(pp.x), bflo(pp.y), bfhi(pp.y)};
        float ss = v[0][0] * v[0][0] + v[0][1] * v[0][1] + v[0][2] * v[0][2] + v[0][3] * v[0][3];
        ss = row16_sum(ss);
        float rs = rsqrtf(ss * (1.0f / 64.0f) + EPS);
        { u32x2 w; w.x = cvt_pk_bf16(v[0][0] * rs * gg[0] * siluf_(rv[0]), v[0][1] * rs * gg[1] * siluf_(rv[1])); w.y = cvt_pk_bf16(v[0][2] * rs * gg[2] * siluf_(rv[2]), v[0][3] * rs * gg[3] * siluf_(rv[3]));
          *(u32x2*)(hrow + c4) = w; }
        float y[4];
#pragma unroll
        for (int i = 0; i < 4; ++i) y[i] = v[1][i] * siluf_(zv[i]);
        ss = y[0] * y[0] + y[1] * y[1] + y[2] * y[2] + y[3] * y[3];
        ss = wave_sum(ss);
        rs = rsqrtf(ss * (1.0f / 256.0f) + EPS);
        { u32x2 w; w.x = cvt_pk_bf16(y[0] * rs * gs[0], y[1] * rs * gs[1]); w.y = cvt_pk_bf16(y[2] * rs * gs[2], y[3] * rs * gs[3]); *(u32x2*)(hrow + 256 + c4) = w; }
        ss = v[2][0] * v[2][0] + v[2][1] * v[2][1] + v[2][2] * v[2][2] + v[2][3] * v[2][3];
        ss = row16_sum(ss);
        rs = rsqrtf(ss * (1.0f / 64.0f) + EPS);
        { u32x2 w; w.x = cvt_pk_bf16(v[2][0] * rs * gm[0] * sigmoidf_(ov[0]), v[2][1] * rs * gm[1] * sigmoidf_(ov[1])); w.y = cvt_pk_bf16(v[2][2] * rs * gm[2] * sigmoidf_(ov[2]), v[2][3] * rs * gm[3] * sigmoidf_(ov[3]));
          *(u32x2*)(hrow + 512 + c4) = w; }
        { u32x2 w; w.x = cvt_pk_bf16(geluf_(v[3][0] + sd[0] * pv[0]), geluf_(v[3][1] + sd[1] * pv[1])); w.y = cvt_pk_bf16(geluf_(v[3][2] + sd[2] * pv[2]), geluf_(v[3][3] + sd[3] * pv[3]));
          *(u32x2*)(GB + (size_t)row * 256 + c4) = w; }
    }
}

#define XB_TMO      128
#define XB_XCNT(j)  (256  + 64 * (j))
#define XB_XSUB(j)  (1280 + 64 * (j))
#define XB_XGEN(j)  (2304 + 64 * (j))
#define XB_TOP      3328
#define XB_TOPGEN   3392
#define XCD_BAR_WORDS 3456
#define XB_SPIN_CAP (1u << 22)
__device__ __forceinline__ unsigned xb_ld(unsigned* p)              { return __hip_atomic_load(p, __ATOMIC_RELAXED, __HIP_MEMORY_SCOPE_AGENT); }
__device__ __forceinline__ unsigned xb_add(unsigned* p, unsigned v) { return __hip_atomic_fetch_add(p, v, __ATOMIC_RELAXED, __HIP_MEMORY_SCOPE_AGENT); }
__device__ __forceinline__ unsigned xb_xcc_id() { return (unsigned)__builtin_amdgcn_s_getreg((3 << 11) | 20) & 0xFu; }
#define XB_SPIN(cond, bar) do { unsigned _sp = 0; while (cond) { __builtin_amdgcn_s_sleep(1); \
    if ((++_sp & 255u) == 0u) { if (xb_ld(&(bar)[XB_TMO])) break; if (_sp > XB_SPIN_CAP) { atomicAdd(&(bar)[XB_TMO], 1u); break; } } } } while (0)
struct XcdBarrier { unsigned* bar; unsigned x; volatile LAS unsigned* st; };
__device__ __forceinline__ XcdBarrier xcd_barrier_post(unsigned* bar, volatile LAS unsigned* st) {
    XcdBarrier b; b.bar = bar; b.x = xb_xcc_id(); b.st = st;
    if (threadIdx.x == 0) (void)xb_add(&bar[XB_XCNT(b.x)], 1u);
    return b;
}
__device__ __forceinline__ void xcd_barrier_complete(unsigned* bar, unsigned x, unsigned& nloc, unsigned& nx) {
    const unsigned G = gridDim.x * gridDim.y * gridDim.z;
    unsigned sum, cnt, mine, sp = 0u;
    for (;;) {
        sum = 0u; cnt = 0u; mine = 0u;
#pragma unroll
        for (unsigned j = 0; j < 16; ++j) { const unsigned c = xb_ld(&bar[XB_XCNT(j)]); sum += c; cnt += (c > 0u) ? 1u : 0u; mine = (j == x) ? c : mine; }
        if (sum == G) break;
        __builtin_amdgcn_s_sleep(1);
        if ((++sp & 255u) == 0u) { if (xb_ld(&bar[XB_TMO])) break; if (sp > XB_SPIN_CAP) { atomicAdd(&bar[XB_TMO], 1u); break; } }
    }
    nloc = mine > 0u ? mine : 1u; nx = cnt > 0u ? cnt : 1u;
}
__device__ __forceinline__ void xcd_barrier(const XcdBarrier& b) {
    asm volatile("s_waitcnt vmcnt(0)" ::: "memory");
    __syncthreads();
    if (threadIdx.x == 0) {
        unsigned* bar = b.bar;
        __builtin_amdgcn_s_waitcnt(0);
        unsigned nloc = b.st[0], nx = b.st[1];
        if (nloc == 0u) { xcd_barrier_complete(bar, b.x, nloc, nx); b.st[0] = nloc; b.st[1] = nx; }
        const unsigned old = xb_add(&bar[XB_XSUB(b.x)], 1u);
        const unsigned gen = old / nloc;
        if (old + 1u == (gen + 1u) * nloc) {
            __builtin_amdgcn_fence(__ATOMIC_RELEASE, "agent");
            asm volatile("s_waitcnt vmcnt(0)" ::: "memory");
            const unsigned og = xb_add(&bar[XB_TOP], 1u);
            const unsigned tg = og / nx;
            if (og + 1u == (tg + 1u) * nx) xb_add(&bar[XB_TOPGEN], 1u);
            else XB_SPIN(xb_ld(&bar[XB_TOPGEN]) == tg, bar);
            __builtin_amdgcn_fence(__ATOMIC_ACQUIRE, "agent");
            xb_add(&bar[XB_XGEN(b.x)], 1u);
            asm volatile("s_waitcnt vmcnt(0)" ::: "memory");
        } else {
            XB_SPIN(xb_ld(&bar[XB_XGEN(b.x)]) == gen, bar);
            __builtin_amdgcn_fence(__ATOMIC_ACQUIRE, "agent");
            asm volatile("s_waitcnt vmcnt(0)" ::: "memory");
        }
    }
    __syncthreads();
}
__device__ __forceinline__ void gsync(cg::grid_group& grid) {
    asm volatile("s_waitcnt vmcnt(0) lgkmcnt(0)" ::: "memory");
    __builtin_amdgcn_fence(__ATOMIC_RELEASE, "agent");
    asm volatile("s_waitcnt vmcnt(0)" ::: "memory");
    grid.sync();
    __builtin_amdgcn_fence(__ATOMIC_ACQUIRE, "agent");
    asm volatile("s_waitcnt vmcnt(0)" ::: "memory");
    __syncthreads();
}
__global__ void __launch_bounds__(512, 2) fwd_megakernel(Params Pk) {
    extern __shared__ __attribute__((aligned(16))) unsigned char smem[];
    lds_t lds = (lds_t)smem;
    cg::grid_group grid = cg::this_grid();
    volatile LAS unsigned* xst = (volatile LAS unsigned*)(lds + 139264);
    if (threadIdx.x == 0) { xst[0] = 0u; xst[1] = 0u; xst[2] = 0u; xst[3] = 0u; }
    __syncthreads();
    const XcdBarrier xb = xcd_barrier_post((unsigned*)(getP()->ws + WS_BAR), xst);
    phase_mods(*getP(), lds);
    phase_convert(*getP(), lds, 0, 0, (int)gridDim.x);
    xcd_barrier(xb);
    if (getP()->ws == nullptr) gsync(grid);
#pragma unroll 1
    for (int l = 0; l < DEPTH; ++l) {
#pragma unroll 1
        for (int j = 0; j < 3; ++j) {
            phase_modnorm(*getP(), l, j, l == 0 && j == 0);
            xcd_barrier(xb);
            CPR P = *getP();
            bf16_t* H = (bf16_t*)(P.ws + WS_H); bf16_t* PBp = (bf16_t*)(P.ws + WS_PB);
            const float* mods_l = (const float*)(P.ws + WS_MODS) + (size_t)l * 5 * 9216;
            pg8::Gemm g2;
            if (j != 1) {
                const int s = j >> 1;
                pg8::Gemm g; g.A = H; g.Bt = (const bf16_t*)(P.ws + WS_WFI) + (size_t)(l * 2 + s) * 5632 * 1024; g.M = NT; g.N = 5632; g.K = 1024; g.lda = 1024; g.ldb = 1024;
                pg8::StaticOrder S; S.init(g.M, g.N, (int)gridDim.x, (int)blockIdx.x);
                EpiSwiGLU E; E.O = PBp;
                pg8::gemm_phase(lds, g, S, E);
                xcd_barrier(xb);
                g2.A = PBp; g2.Bt = (const bf16_t*)(P.ws + WS_WFO) + (size_t)(l * 2 + s) * 1024 * DFF; g2.M = NLAT; g2.N = 1024; g2.K = DFF; g2.lda = DFF; g2.ldb = DFF;
            } else {
                {
                    pg8::Gemm g; g.A = H; g.Bt = (const bf16_t*)(P.ws + WS_WIN) + (size_t)l * NINP * 1024; g.M = NT; g.N = NINP; g.K = 1024; g.lda = 1024; g.ldb = 1024;
                    pg8::StaticOrder S; S.init(g.M, g.N, (int)gridDim.x, (int)blockIdx.x);
                    EpiInProj E; E.Pb = PBp; E.Pg = (float*)(P.ws + WS_PG);
                    pg8::gemm_phase(lds, g, S, E);
                }
                xcd_barrier(xb);
                phase_mixers(*getP(), l, lds);
                xcd_barrier(xb);
                phase_post(*getP(), l);
                xcd_barrier(xb);
                {
                    pg8::Gemm g; g.A = (const bf16_t*)(P.ws + WS_GB); g.Bt = (const bf16_t*)(P.ws + WS_WGLU) + (size_t)l * 256 * 256; g.M = NT; g.N = 256; g.K = 256; g.lda = 256; g.ldb = 256;
                    pg8::StaticOrder S; S.init(g.M, g.N, (int)gridDim.x, (int)blockIdx.x);
                    EpiGLU E; E.G = (const bf16_t*)(P.ws + WS_GB); E.bglu = P.in[I_S5BGLU] + l * 256; E.O = H;
                    pg8::gemm_phase(lds, g, S, E);
                }
                xcd_barrier(xb);
                g2.A = H; g2.Bt = (const bf16_t*)(P.ws + WS_WOUT) + (size_t)l * 1024 * 1024; g2.M = NLAT; g2.N = 1024; g2.K = 1024; g2.lda = 1024; g2.ldb = 1024;
            }
            {
                pg8::StaticOrder S; S.init(g2.M, g2.N, (int)gridDim.x, (int)blockIdx.x);
                EpiResid E; E.xlat = P.out; E.xctx = (float*)(P.ws + WS_CTXX); E.gate_l = mods_l + (3 * j + 2) * 1024; E.coef = (j == 1) ? 1.0f : 0.5f;
                pg8::gemm_phase(lds, g2, S, E);
                pg8::Gemm g3 = g2; g3.A = g2.A + (size_t)NLAT * g2.lda; g3.M = NCTX; g3.K = 256;
                pg8::SplitKOrder S3; S3.init(g3.M, g3.N, g2.K / 256, (int)gridDim.x, (int)blockIdx.x);
                EpiSlab E3; E3.slab = (float*)(P.ws + WS_SLAB);
                pg8::gemm_phase(lds, g3, S3, E3);
            }
            xcd_barrier(xb);
        }
    }
    phase_final(*getP());
}

extern "C" void kernel_launch(void* const* d_in, const int* in_sizes, int n_in, void* d_out, int out_size, void* d_ws, size_t ws_size, hipStream_t stream) {
    constexpr int LDS_BYTES = 139264 + 64;
    static int grid = 0;
    if (grid == 0) {
        if (n_in != 35 || ws_size < WS_END) { fprintf(stderr, "kernel_launch: expected 35 inputs and >= %zu bytes of workspace; got %d, %zu\n", (size_t)WS_END, n_in, ws_size); grid = -1; return; }
        int dev = 0, cus = 0, per_cu = 0;
        hipGetDevice(&dev);
        hipDeviceGetAttribute(&cus, hipDeviceAttributeMultiprocessorCount, dev);
        if (hipFuncSetAttribute((const void*)fwd_megakernel, hipFuncAttributeMaxDynamicSharedMemorySize, LDS_BYTES) != hipSuccess) { fprintf(stderr, "kernel_launch: hipFuncSetAttribute failed\n"); grid = -1; return; }
        if (hipOccupancyMaxActiveBlocksPerMultiprocessor(&per_cu, (const void*)fwd_megakernel, 512, LDS_BYTES) != hipSuccess || per_cu < 1) { fprintf(stderr, "kernel_launch: occupancy query says %d blocks per CU\n", per_cu); per_cu = 1; }
        (void)hipGetLastError();
        grid = cus;
    }
    if (grid < 0) return;
    Params p{};
    for (int i = 0; i < 35; ++i) p.in[i] = (const float*)d_in[i];
    p.out = (float*)d_out; p.ws = (unsigned char*)d_ws;
    if (hipMemsetAsync((char*)d_ws + WS_BAR, 0, SZ_BAR, stream) != hipSuccess) { fprintf(stderr, "kernel_launch: memset of the barrier words failed\n"); return; }
    void* args[] = {&p};
    hipError_t e = hipLaunchCooperativeKernel((const void*)fwd_megakernel, dim3(grid), dim3(512), args, LDS_BYTES, stream);
    if (e != hipSuccess) fprintf(stderr, "cooperative launch failed: %s (grid %d)\n", hipGetErrorString(e), grid);
}
```

```cpp
#include <hip/hip_runtime.h>
#include <hip/hip_cooperative_groups.h>
#include <cstdio>
namespace cg = cooperative_groups;

#define LAS __attribute__((address_space(3)))
typedef unsigned short bf16_t;
typedef short bf16x8 __attribute__((ext_vector_type(8)));
typedef float f32x4 __attribute__((ext_vector_type(4)));
typedef unsigned u32x4 __attribute__((ext_vector_type(4)));
typedef unsigned u32x2 __attribute__((ext_vector_type(2)));
typedef LAS unsigned char* lds_t;

constexpr int DM = 1024, NB = 4, SEQ = 8192, DEPTH = 4, CTXL = 256;
constexpr int NLAT = NB * SEQ, NCTX = NB * CTXL, NT = NLAT + NCTX;
constexpr int DFF = 2816, NIN = 3128, NINP = 3328;
constexpr int GLA_Q = 0, GLA_K = 256, GLA_V = 512, GLA_R = 768;
constexpr int SSD_X = 1056, SSD_B = 1312, SSD_C = 1440, SSD_Z = 1568;
constexpr int ML_Q = 1832, ML_V = 2344, ML_O = 2600;
constexpr int S50 = 2872;
constexpr int PGW = 96;
constexpr float EPS = 1e-6f;

constexpr size_t SZ_WFI = (size_t)DEPTH * 2 * 5632 * 1024 * 2;
constexpr size_t SZ_WFO = (size_t)DEPTH * 2 * 1024 * 2816 * 2;
constexpr size_t SZ_WIN = (size_t)DEPTH * NINP * 1024 * 2;
constexpr size_t SZ_WOUT = (size_t)DEPTH * 1024 * 1024 * 2;
constexpr size_t SZ_WGLU = (size_t)DEPTH * 256 * 256 * 2;
constexpr size_t SZ_MODS = (size_t)DEPTH * 5 * 9216 * 4;
constexpr size_t SZ_CTXX = (size_t)NCTX * 1024 * 4;
constexpr size_t SZ_H = (size_t)NT * 1024 * 2;
constexpr size_t SZ_PB = (size_t)NT * NINP * 2;
constexpr size_t SZ_PG = (size_t)NT * PGW * 4;
constexpr size_t SZ_GB = (size_t)NT * 256 * 2;
constexpr size_t WS_WFI = 0;
constexpr size_t WS_WFO = WS_WFI + SZ_WFI;
constexpr size_t WS_WIN = WS_WFO + SZ_WFO;
constexpr size_t WS_WOUT = WS_WIN + SZ_WIN;
constexpr size_t WS_WGLU = WS_WOUT + SZ_WOUT;
constexpr size_t WS_MODS = WS_WGLU + SZ_WGLU;
constexpr size_t WS_CTXX = WS_MODS + SZ_MODS;
constexpr size_t WS_H = WS_CTXX + SZ_CTXX;
constexpr size_t WS_H2 = WS_H + SZ_H;
constexpr size_t WS_PB = WS_H2 + SZ_H;
constexpr size_t WS_PG = WS_PB + SZ_PB;
constexpr size_t WS_GB = WS_PG + SZ_PG;
constexpr size_t WS_BAR = WS_GB + SZ_GB;
constexpr size_t SZ_BAR = 16384;
constexpr size_t WS_SLAB = WS_BAR + SZ_BAR;
constexpr size_t SZ_SLAB = (size_t)11 * NCTX * 1024 * 4;
constexpr size_t WS_END = WS_SLAB + SZ_SLAB;

struct Params {
    const float* in[35];
    float* out;
    unsigned char* ws;
};
typedef const __attribute__((address_space(4))) Params* cparams_t;
#define CPR const __attribute__((address_space(4))) Params&
__device__ __forceinline__ cparams_t getP() { cparams_t p = (cparams_t)__builtin_amdgcn_kernarg_segment_ptr(); asm volatile("" : "+s"(p)); return p; }
enum { I_X = 0, I_C, I_CTX, I_CCTX, I_WMOD, I_BMOD, I_GNORM, I_FFNWIN, I_FFNWOUT, I_WIN, I_WOUT, I_GLAW, I_GLAB, I_GLAG,
       I_SSDCW, I_SSDCB, I_SSDALOG, I_SSDDTB, I_SSDD, I_SSDG, I_MLCW, I_MLCB, I_MLGB, I_MLG, I_S5ARE, I_S5AIM, I_S5LS,
       I_S5BRE, I_S5BIM, I_S5CRE, I_S5CIM, I_S5D, I_S5WGLU, I_S5BGLU, I_GFINAL };

__device__ __forceinline__ float bf2f(unsigned b) { return __uint_as_float(b << 16); }
typedef __bf16 bf16x2_t __attribute__((ext_vector_type(2)));
typedef float f32x2_t __attribute__((ext_vector_type(2)));
__device__ __forceinline__ unsigned cvt_pk_bf16(float lo, float hi) { const f32x2_t f = {lo, hi}; return __builtin_bit_cast(unsigned, __builtin_convertvector(f, bf16x2_t)); }
__device__ __forceinline__ bf16_t f2bf(float f) { return (bf16_t)(cvt_pk_bf16(f, 0.f) & 0xffffu); }
__device__ __forceinline__ float bflo(unsigned w) { return __uint_as_float(w << 16); }
__device__ __forceinline__ float bfhi(unsigned w) { return __uint_as_float(w & 0xffff0000u); }
__device__ __forceinline__ float sigmoidf_(float x) { return __builtin_amdgcn_rcpf(1.0f + __expf(-x)); }
__device__ __forceinline__ float siluf_(float x) { return x * sigmoidf_(x); }
__device__ __forceinline__ float logsigf_(float x) { return fminf(x, 0.f) - __logf(1.0f + __expf(-fabsf(x))); }
__device__ __forceinline__ float softplusf_(float x) { return fmaxf(x, 0.f) + __logf(1.0f + __expf(-fabsf(x))); }
__device__ __forceinline__ float geluf_(float x) { const float u = 0.7978845608028654f * (x + 0.044715f * x * x * x); return x * sigmoidf_(2.0f * u); }

__device__ __forceinline__ int tok_row(int seg, int b, int p, bool colmajor) {
    if (seg == 0) return NLAT + b * CTXL + p;
    return b * SEQ + (colmajor ? ((p & 127) * 64 + (p >> 7)) : p);
}

__device__ __forceinline__ int opaque_tid() { int t = threadIdx.x; asm volatile("" : "+v"(t) :: "memory"); return t; }
__device__ __forceinline__ float shfl_idx(float v, int srclane) { return __int_as_float(__builtin_amdgcn_ds_bpermute(srclane << 2, __float_as_int(v))); }
template <bool TRANS, int KSTEPS, int SA, int SB, bool SAFE = false>
__device__ __forceinline__ void mma_tile(f32x4& acc, lds_t As, int arow0, lds_t Bs, int brow0, int fr, int fq) {
#pragma unroll
    for (int kk = 0; kk < KSTEPS; ++kk) {
        const bf16x8 a = *(const LAS bf16x8*)(As + (arow0 + fr) * SA + kk * 64 + fq * 16);
        const bf16x8 b = *(const LAS bf16x8*)(Bs + (brow0 + fr) * SB + kk * 64 + fq * 16);
        if (SAFE) asm volatile("s_waitcnt lgkmcnt(0)" ::: "memory");
        if (TRANS) acc = __builtin_amdgcn_mfma_f32_16x16x32_bf16(b, a, acc, 0, 0, 0);
        else acc = __builtin_amdgcn_mfma_f32_16x16x32_bf16(a, b, acc, 0, 0, 0);
    }
}
constexpr int LDT = 144;

namespace pg8 {
constexpr int BM = 256, BK = 64, HALF = 128, HTB = HALF * BK * 2, STAGE_BYTES = 8 * HTB, NXCD = 8, WGM = 8;
__device__ __forceinline__ int lds_byte(int r, int c) { const int st = (r >> 4) * 2 + (c >> 5), rr = r & 15, cc = c & 31, ob = rr * 64 + cc * 2; return st * 1024 + (ob ^ (((ob >> 9) & 1) << 5)); }
__device__ __forceinline__ void stage_rc(int b, int& R, int& C) { const int st = b / 1024, sb = b % 1024, swz = sb ^ (((sb >> 9) & 1) << 5); R = (st >> 1) * 16 + swz / 64; C = (st & 1) * 32 + (swz % 64) / 2; }
__device__ __forceinline__ int perm32(int rho) { const int n = rho >> 4, i = rho & 15; return 8 * (i >> 2) + 4 * n + (i & 3); }
struct Unit { int pm, pn, ks; };
struct Gemm { const bf16_t* A; const bf16_t* Bt; int M, N, K, lda, ldb; };
struct StaticOrder {
    int nM, nN, nwg, G, c;
    __device__ void init(int M, int N, int G_, int c_) { nM = M / BM; nN = N / BM; nwg = nM * nN; G = G_; c = c_; }
    __device__ bool next(int i, Unit& u) const {
        const long L = (long)i * G + c; if (L >= nwg) return false;
        int wgid = (int)L; { const int q = nwg / NXCD, r = nwg % NXCD, xcd = wgid % NXCD, off = wgid / NXCD; wgid = (xcd < r ? xcd * (q + 1) : r * (q + 1) + (xcd - r) * q) + off; }
        const int nig = WGM * nN, gid = wgid / nig, fm = gid * WGM, gsz = (nM - fm) < WGM ? (nM - fm) : WGM;
        u.pm = fm + ((wgid % nig) % gsz); u.pn = (wgid % nig) / gsz; u.ks = 0; return true;
    }
};
struct SplitKOrder {
    int nN, nks, n, G, c;
    __device__ void init(int M, int N, int nks_, int G_, int c_) { nN = N / BM; nks = nks_; n = (M / BM) * nN * nks; G = G_; c = c_; }
    __device__ bool next(int i, Unit& u) const { const long L = (long)i * G + c; if (L >= n) return false; const int l = (int)L; u.ks = l % nks; const int r = l / nks; u.pn = r % nN; u.pm = r / nN; return true; }
};
template <class Epi, class Sched>
__device__ __forceinline__ void gemm_phase(lds_t lds, const Gemm g, const Sched& S, const Epi& E) {
    const int tid = opaque_tid(), wid = __builtin_amdgcn_readfirstlane(tid >> 6), lane = tid & 63, wr = wid >> 2, wc = wid & 3, fr = lane & 15, fq = lane >> 4;
    const int K = g.K, nt = K / BK;
    unsigned voffA[2], voffB[2];
#pragma unroll
    for (int i = 0; i < 2; ++i) { int R, C; stage_rc(tid * 16 + i * 8192, R, C); const int Rb = Epi::PERM ? ((R & ~31) + perm32(R & 31)) : R;
        voffA[i] = (unsigned)(R * g.lda + C) * 2u; voffB[i] = (unsigned)(Rb * g.ldb + C) * 2u; }
    const size_t kstep = (size_t)(BK * 2);
    const size_t hstepA = (size_t)HALF * g.lda * 2, hstepB = (size_t)HALF * g.ldb * 2;
    const size_t tstepA = 2 * hstepA, tstepB = 2 * hstepB, kslice = (size_t)K * 2;
    const unsigned ldsw = (unsigned)wid * 1024u;
    const int aoff = lds_byte(wr * 64 + fr, fq * 8), boff = lds_byte(wc * 32 + fr, fq * 8);
#define PG8_SA(b, h) (((b) * 2 + (h)) * HTB)
#define PG8_SB(b, h) ((4 + (b) * 2 + (h)) * HTB)
#define PG8_STAGE(bufoff, gbase, voff) do { _Pragma("unroll") for (int _i = 0; _i < 2; ++_i) \
        __builtin_amdgcn_global_load_lds((const unsigned*)((const char*)(gbase) + (voff)[_i]), (LAS unsigned*)(lds + (bufoff) + ldsw + _i * 8192), 16, 0, 0); } while (0)
#define PG8_LDA(dst, b, h) do { _Pragma("unroll") for (int m = 0; m < 4; ++m) _Pragma("unroll") for (int k = 0; k < 2; ++k) dst[m][k] = *(const LAS bf16x8*)(lds + PG8_SA(b, h) + aoff + m * 2048 + k * 1024); } while (0)
#define PG8_LDB(dst, b, h) do { _Pragma("unroll") for (int n = 0; n < 2; ++n) _Pragma("unroll") for (int k = 0; k < 2; ++k) dst[n][k] = *(const LAS bf16x8*)(lds + PG8_SB(b, h) + boff + n * 2048 + k * 1024); } while (0)
#define PG8_MMA(ai, bj, At, Bt) do { __builtin_amdgcn_s_setprio(1); _Pragma("unroll") for (int m = 0; m < 4; ++m) _Pragma("unroll") for (int n = 0; n < 2; ++n) _Pragma("unroll") for (int k = 0; k < 2; ++k) \
        acc[ai][bj][m][n] = __builtin_amdgcn_mfma_f32_16x16x32_bf16(Bt[n][k], At[m][k], acc[ai][bj][m][n], 0, 0, 0); __builtin_amdgcn_s_setprio(0); } while (0)
#define PG8_WAIT_V(n) asm volatile("s_waitcnt vmcnt(" #n ")" ::: "memory")
#define PG8_WAIT_L(n) asm volatile("s_waitcnt lgkmcnt(" #n ")" ::: "memory")
#define PG8_BAR __builtin_amdgcn_s_barrier()
#define PG8_SCHED __builtin_amdgcn_sched_barrier(0)
    Unit cur, nxt; int ui = 0;
    if (!S.next(0, cur)) return;
    f32x4 acc[2][2][4][2];
#pragma unroll
    for (int a = 0; a < 2; ++a)
#pragma unroll
        for (int b = 0; b < 2; ++b)
#pragma unroll
            for (int m = 0; m < 4; ++m)
#pragma unroll
                for (int n = 0; n < 2; ++n) acc[a][b][m][n] = (f32x4){0.f, 0.f, 0.f, 0.f};
    bf16x8 At[4][2], B0[2][2], B1[2][2];
    const char* cA = (const char*)g.A + (size_t)cur.pm * tstepA + (size_t)cur.ks * kslice; const char* cB = (const char*)g.Bt + (size_t)cur.pn * tstepB + (size_t)cur.ks * kslice;
    PG8_STAGE(PG8_SB(0, 0), cB, voffB); PG8_STAGE(PG8_SA(0, 0), cA, voffA); PG8_STAGE(PG8_SB(0, 1), cB + hstepB, voffB); PG8_STAGE(PG8_SA(0, 1), cA + hstepA, voffA);
    if (wr == 1) PG8_BAR;
    PG8_WAIT_V(4); PG8_BAR;
    PG8_STAGE(PG8_SB(1, 0), cB + kstep, voffB); PG8_STAGE(PG8_SA(1, 0), cA + kstep, voffA); PG8_STAGE(PG8_SB(1, 1), cB + hstepB + kstep, voffB);
    PG8_WAIT_V(6); PG8_BAR;
    for (;;) {
        const bool has_next = S.next(ui + 1, nxt);
        const char* nA = has_next ? (const char*)g.A + (size_t)nxt.pm * tstepA + (size_t)nxt.ks * kslice : cA; const char* nB = has_next ? (const char*)g.Bt + (size_t)nxt.pn * tstepB + (size_t)nxt.ks * kslice : cB;
        for (int t = 0; t < nt; t += 2) {
            const bool last = (t == nt - 2);
            const char* a1 = cA + (size_t)(t + 1) * kstep;
            const char* a2 = last ? nA : cA + (size_t)(t + 2) * kstep; const char* b2 = last ? nB : cB + (size_t)(t + 2) * kstep;
            const char* a3 = a2 + kstep; const char* b3 = b2 + kstep;
            PG8_LDB(B0, 0, 0); PG8_SCHED; PG8_LDA(At, 0, 0); PG8_STAGE(PG8_SA(1, 1), a1 + hstepA, voffA);
            PG8_WAIT_L(8); PG8_BAR; PG8_WAIT_L(0); PG8_MMA(0, 0, At, B0); PG8_BAR; PG8_SCHED;
            PG8_LDB(B1, 0, 1); PG8_STAGE(PG8_SB(0, 0), b2, voffB);
            PG8_BAR; PG8_WAIT_L(0); PG8_MMA(0, 1, At, B1); PG8_BAR;
            PG8_LDA(At, 0, 1); PG8_STAGE(PG8_SA(0, 0), a2, voffA);
            PG8_BAR; PG8_WAIT_L(0); PG8_MMA(1, 0, At, B0); PG8_BAR; PG8_SCHED;
            PG8_STAGE(PG8_SB(0, 1), b2 + hstepB, voffB);
            PG8_WAIT_V(6); PG8_BAR; PG8_MMA(1, 1, At, B1); PG8_BAR;
            PG8_LDB(B0, 1, 0); PG8_SCHED; PG8_LDA(At, 1, 0); PG8_STAGE(PG8_SA(0, 1), a2 + hstepA, voffA);
            PG8_WAIT_L(8); PG8_BAR; PG8_WAIT_L(0); PG8_MMA(0, 0, At, B0); PG8_BAR; PG8_SCHED;
            PG8_LDB(B1, 1, 1); PG8_STAGE(PG8_SB(1, 0), b3, voffB);
            PG8_BAR; PG8_WAIT_L(0); PG8_MMA(0, 1, At, B1); PG8_BAR;
            PG8_LDA(At, 1, 1); PG8_STAGE(PG8_SA(1, 0), a3, voffA);
            PG8_BAR; PG8_WAIT_L(0); PG8_MMA(1, 0, At, B0); PG8_BAR; PG8_SCHED;
            PG8_STAGE(PG8_SB(1, 1), b3 + hstepB, voffB);
            PG8_WAIT_V(6); PG8_BAR; PG8_MMA(1, 1, At, B1); PG8_BAR;
        }
        { const int t2 = opaque_tid(); E(acc, cur, wr, wc, t2 & 15, (t2 & 63) >> 4); }
        if (!has_next) break;
#pragma unroll
        for (int a = 0; a < 2; ++a)
#pragma unroll
            for (int b = 0; b < 2; ++b)
#pragma unroll
                for (int m = 0; m < 4; ++m)
#pragma unroll
                    for (int n = 0; n < 2; ++n) acc[a][b][m][n] = (f32x4){0.f, 0.f, 0.f, 0.f};
        cur = nxt; cA = nA; cB = nB; ++ui;
    }
    PG8_WAIT_V(0);
    if (wr == 0) PG8_BAR;
    PG8_BAR;
#undef PG8_SA
#undef PG8_SB
#undef PG8_STAGE
#undef PG8_LDA
#undef PG8_LDB
#undef PG8_MMA
#undef PG8_WAIT_V
#undef PG8_WAIT_L
#undef PG8_BAR
#undef PG8_SCHED
}
}
using pg8::Unit;

struct EpiSwiGLU {
    static constexpr bool PERM = true;
    bf16_t* O;
    __device__ __forceinline__ void operator()(const f32x4 (&acc)[2][2][4][2], const Unit& u, int wr, int wc, int fr, int fq) const {
        const int row0 = u.pm * 256 + wr * 64 + fr, col0 = u.pn * 128 + wc * 32 + 8 * fq;
#pragma unroll
        for (int ai = 0; ai < 2; ++ai)
#pragma unroll
            for (int m = 0; m < 4; ++m) {
                bf16_t* rowp = O + (size_t)(row0 + ai * 128 + m * 16) * DFF + col0;
                const f32x4 g0 = acc[ai][0][m][0], g1 = acc[ai][0][m][1], u0 = acc[ai][1][m][0], u1 = acc[ai][1][m][1];
                u32x4 w;
                w.x = cvt_pk_bf16(siluf_(g0[0]) * u0[0], siluf_(g0[1]) * u0[1]);
                w.y = cvt_pk_bf16(siluf_(g0[2]) * u0[2], siluf_(g0[3]) * u0[3]);
                w.z = cvt_pk_bf16(siluf_(g1[0]) * u1[0], siluf_(g1[1]) * u1[1]);
                w.w = cvt_pk_bf16(siluf_(g1[2]) * u1[2], siluf_(g1[3]) * u1[3]);
                *(u32x4*)rowp = w;
                asm volatile("" ::: "memory");
            }
    }
};
struct EpiResid {
    static constexpr bool PERM = false;
    float* xlat; float* xctx; const float* gate_l; float coef;
    __device__ __forceinline__ void operator()(const f32x4 (&acc)[2][2][4][2], const Unit& u, int wr, int wc, int fr, int fq) const {
        float* base; int mod;
        if (u.pm < 128) { base = xlat + (size_t)u.pm * 256 * 1024; mod = u.pm >> 5; } else { base = xctx + (size_t)(u.pm - 128) * 256 * 1024; mod = 4; }
        const int col0 = u.pn * 256 + wc * 32 + 4 * fq;
        const float* gp = gate_l + mod * 9216 + col0;
        float* rbase = base + (size_t)(wr * 64 + fr) * 1024 + col0;
#pragma unroll
        for (int bj = 0; bj < 2; ++bj) {
            f32x4 xv[2][2][4];
#pragma unroll
            for (int n = 0; n < 2; ++n)
#pragma unroll
                for (int ai = 0; ai < 2; ++ai)
#pragma unroll
                    for (int m = 0; m < 4; ++m) xv[n][ai][m] = *(const f32x4*)(rbase + (size_t)(ai * 128 + m * 16) * 1024 + bj * 128 + n * 16);
            const f32x4 gv0 = *(const f32x4*)(gp + bj * 128) * coef, gv1 = *(const f32x4*)(gp + bj * 128 + 16) * coef;
#pragma unroll
            for (int n = 0; n < 2; ++n)
#pragma unroll
                for (int ai = 0; ai < 2; ++ai)
#pragma unroll
                    for (int m = 0; m < 4; ++m)
                        *(f32x4*)(rbase + (size_t)(ai * 128 + m * 16) * 1024 + bj * 128 + n * 16) = xv[n][ai][m] + (n == 0 ? gv0 : gv1) * acc[ai][bj][m][n];
            asm volatile("" ::: "memory");
        }
    }
};
struct EpiSlab {
    static constexpr bool PERM = false;
    float* slab;
    __device__ __forceinline__ void operator()(const f32x4 (&acc)[2][2][4][2], const Unit& u, int wr, int wc, int fr, int fq) const {
        float* base = slab + ((size_t)u.ks * NCTX + (size_t)u.pm * 256) * 1024;
        const int col0 = u.pn * 256 + wc * 32 + 4 * fq;
#pragma unroll
        for (int ai = 0; ai < 2; ++ai)
#pragma unroll
            for (int m = 0; m < 4; ++m) {
                float* rowp = base + (size_t)(wr * 64 + fr + ai * 128 + m * 16) * 1024 + col0;
#pragma unroll
                for (int bj = 0; bj < 2; ++bj)
#pragma unroll
                    for (int n = 0; n < 2; ++n) *(f32x4*)(rowp + bj * 128 + n * 16) = acc[ai][bj][m][n];
                asm volatile("" ::: "memory");
            }
    }
};
struct EpiInProj {
    static constexpr bool PERM = true;
    bf16_t* Pb; float* Pg;
    __device__ __forceinline__ void operator()(const f32x4 (&acc)[2][2][4][2], const Unit& u, int wr, int wc, int fr, int fq) const {
        const int row0 = u.pm * 256 + wr * 64 + fr;
#pragma unroll
        for (int bj = 0; bj < 2; ++bj) {
            const int c0 = u.pn * 256 + bj * 128 + wc * 32 + 8 * fq;
            int gi = -1;
            if (c0 >= 1024 && c0 < 1056) gi = c0 - 1024; else if (c0 >= 1824 && c0 < 1832) gi = 32 + c0 - 1824; else if (c0 >= 2856 && c0 < 2872) gi = 64 + c0 - 2856;
#pragma unroll
            for (int ai = 0; ai < 2; ++ai)
#pragma unroll
                for (int m = 0; m < 4; ++m) {
                    const size_t row = (size_t)(row0 + ai * 128 + m * 16);
                    const f32x4 v0 = acc[ai][bj][m][0], v1 = acc[ai][bj][m][1];
                    u32x4 w; w.x = cvt_pk_bf16(v0[0], v0[1]); w.y = cvt_pk_bf16(v0[2], v0[3]); w.z = cvt_pk_bf16(v1[0], v1[1]); w.w = cvt_pk_bf16(v1[2], v1[3]);
                    *(u32x4*)(Pb + row * NINP + c0) = w;
                    if (gi >= 0) { *(f32x4*)(Pg + row * PGW + gi) = v0; *(f32x4*)(Pg + row * PGW + gi + 4) = v1; }
                    asm volatile("" ::: "memory");
                }
        }
    }
};
struct EpiGLU {
    static constexpr bool PERM = true;
    const bf16_t* G; const float* bglu; bf16_t* O;
    __device__ __forceinline__ void operator()(const f32x4 (&acc)[2][2][4][2], const Unit& u, int wr, int wc, int fr, int fq) const {
        const int row0 = u.pm * 256 + wr * 64 + fr;
#pragma unroll
        for (int bj = 0; bj < 2; ++bj) {
            const int c0 = bj * 128 + wc * 32 + 8 * fq;
            const f32x4 bb0 = *(const f32x4*)(bglu + c0), bb1 = *(const f32x4*)(bglu + c0 + 4);
            u32x4 gw[2][4];
#pragma unroll
            for (int ai = 0; ai < 2; ++ai)
#pragma unroll
                for (int m = 0; m < 4; ++m) gw[ai][m] = *(const u32x4*)(G + (size_t)(row0 + ai * 128 + m * 16) * 256 + c0);
#pragma unroll
            for (int ai = 0; ai < 2; ++ai)
#pragma unroll
                for (int m = 0; m < 4; ++m) {
                    const size_t row = (size_t)(row0 + ai * 128 + m * 16);
                    const f32x4 v0 = acc[ai][bj][m][0] + bb0, v1 = acc[ai][bj][m][1] + bb1; const u32x4 g4 = gw[ai][m];
                    u32x4 w;
                    w.x = cvt_pk_bf16(bflo(g4.x) * sigmoidf_(v0[0]), bfhi(g4.x) * sigmoidf_(v0[1]));
                    w.y = cvt_pk_bf16(bflo(g4.y) * sigmoidf_(v0[2]), bfhi(g4.y) * sigmoidf_(v0[3]));
                    w.z = cvt_pk_bf16(bflo(g4.z) * sigmoidf_(v1[0]), bfhi(g4.z) * sigmoidf_(v1[1]));
                    w.w = cvt_pk_bf16(bflo(g4.w) * sigmoidf_(v1[2]), bfhi(g4.w) * sigmoidf_(v1[3]));
                    *(u32x4*)(O + row * 1024 + 768 + c0) = w;
                }
            asm volatile("" ::: "memory");
        }
    }
};

__device__ __forceinline__ void phase_mods(CPR P, lds_t lds) {
    const int tid = opaque_tid();
    LAS float* sc = (LAS float*)lds;
    LAS float* red = sc + 5120;
    const float* c = P.in[I_C]; const float* cc = P.in[I_CCTX]; const float* wmod = P.in[I_WMOD]; const float* bmod = P.in[I_BMOD];
    float* mods = (float*)(P.ws + WS_MODS);
    for (int i = tid; i < 5120; i += 512) { const int v = i >> 10, k = i & 1023; const float x = v < 4 ? c[v * 1024 + k] : cc[k]; sc[i] = siluf_(x); }
    __syncthreads();
    for (int item = blockIdx.x; item < 288; item += gridDim.x) {
        const int l = item / 72, col0 = (item % 72) * 128, c4 = (tid & 31) * 4, kg = tid >> 5;
        f32x4 acc[5];
#pragma unroll
        for (int v = 0; v < 5; ++v) acc[v] = (f32x4){0.f, 0.f, 0.f, 0.f};
        const float* wp = wmod + ((size_t)l * 1024 + kg * 64) * 9216 + col0 + c4;
#pragma unroll 8
        for (int kk = 0; kk < 64; ++kk) {
            const f32x4 w = *(const f32x4*)(wp + (size_t)kk * 9216);
#pragma unroll
            for (int v = 0; v < 5; ++v) { const float s = sc[v * 1024 + kg * 64 + kk]; acc[v] += w * s; }
        }
#pragma unroll
        for (int v = 0; v < 5; ++v) *(LAS f32x4*)(red + (kg * 5 + v) * 128 + c4) = acc[v];
        __syncthreads();
        for (int o = tid; o < 640; o += 512) {
            const int v = o >> 7, cx = o & 127; float s = 0.f;
#pragma unroll
            for (int k2 = 0; k2 < 16; ++k2) s += red[(k2 * 5 + v) * 128 + cx];
            mods[(size_t)(l * 5 + v) * 9216 + col0 + cx] = s + bmod[l * 9216 + col0 + cx];
        }
        __syncthreads();
    }
}

__device__ __forceinline__ void conv_tile(const float* src, int src_ld, int col0, int ncv, int k0, bf16_t* dst, int dst_ld, int drow0, LAS float* tile) {
    const int tid = opaque_tid();
    { const int r = tid >> 4, c4 = (tid & 15) * 4;
#pragma unroll
      for (int i = 0; i < 2; ++i) { const int k = r + 32 * i; f32x4 v = (f32x4){0.f, 0.f, 0.f, 0.f};
          if (c4 < ncv) v = *(const f32x4*)(src + (size_t)(k0 + k) * src_ld + col0 + c4);
          tile[k * 65 + c4 + 0] = v[0]; tile[k * 65 + c4 + 1] = v[1]; tile[k * 65 + c4 + 2] = v[2]; tile[k * 65 + c4 + 3] = v[3]; } }
    __syncthreads();
    { const int n = tid >> 3, k8 = (tid & 7) * 8; u32x4 w;
      w.x = cvt_pk_bf16(tile[(k8 + 0) * 65 + n], tile[(k8 + 1) * 65 + n]); w.y = cvt_pk_bf16(tile[(k8 + 2) * 65 + n], tile[(k8 + 3) * 65 + n]);
      w.z = cvt_pk_bf16(tile[(k8 + 4) * 65 + n], tile[(k8 + 5) * 65 + n]); w.w = cvt_pk_bf16(tile[(k8 + 6) * 65 + n], tile[(k8 + 7) * 65 + n]);
      *(u32x4*)(dst + (size_t)(drow0 + n) * dst_ld + k0 + k8) = w; }
    __syncthreads();
}
__device__ __forceinline__ void phase_convert(CPR P, lds_t lds, int l, int b0, int nb) {
    LAS float* tile = (LAS float*)lds;
    constexpr int PER_LAYER = 2 * 1408 + 2 * 704 + 832 + 256 + 16;
    for (int idx = (int)blockIdx.x - b0; idx < PER_LAYER; idx += nb) {
        int t = idx;
        if (t < 2816) {
            const int s = t / 1408; t %= 1408; const int rt = t >> 4, kt = t & 15, drow0 = rt * 64, t256 = drow0 >> 8, cc = drow0 & 255, j0 = t256 * 128 + (cc & 127);
            const int scol = (cc < 128) ? j0 : DFF + j0;
            conv_tile(P.in[I_FFNWIN] + (size_t)(l * 2 + s) * 1024 * 5632, 5632, scol, 64, kt * 64, (bf16_t*)(P.ws + WS_WFI) + (size_t)(l * 2 + s) * 5632 * 1024, 1024, drow0, tile);
        } else if (t < 4224) {
            t -= 2816; const int s = t / 704; t %= 704; const int rt = t / 44, kt = t % 44;
            conv_tile(P.in[I_FFNWOUT] + (size_t)(l * 2 + s) * DFF * 1024, 1024, rt * 64, 64, kt * 64, (bf16_t*)(P.ws + WS_WFO) + (size_t)(l * 2 + s) * 1024 * DFF, DFF, rt * 64, tile);
        } else if (t < 5056) {
            t -= 4224; const int rt = t >> 4, kt = t & 15;
            conv_tile(P.in[I_WIN] + (size_t)l * 1024 * NIN, NIN, rt * 64, NIN - rt * 64, kt * 64, (bf16_t*)(P.ws + WS_WIN) + (size_t)l * NINP * 1024, 1024, rt * 64, tile);
        } else if (t < 5312) {
            t -= 5056; const int rt = t >> 4, kt = t & 15;
            conv_tile(P.in[I_WOUT] + (size_t)l * 1024 * 1024, 1024, rt * 64, 64, kt * 64, (bf16_t*)(P.ws + WS_WOUT) + (size_t)l * 1024 * 1024, 1024, rt * 64, tile);
        } else {
            t -= 5312; const int rt = t >> 2, kt = t & 3;
            conv_tile(P.in[I_S5WGLU] + (size_t)l * 256 * 256, 256, rt * 64, 64, kt * 64, (bf16_t*)(P.ws + WS_WGLU) + (size_t)l * 256 * 256, 256, rt * 64, tile);
        }
    }
}

template <int CTRL> __device__ __forceinline__ float dpp_mov(float x) { return __int_as_float(__builtin_amdgcn_update_dpp(0, __float_as_int(x), CTRL, 0xf, 0xf, false)); }
__device__ __forceinline__ float wave_scan_add(float x, int lane) {
    const int rl = lane & 15; float t;
    t = dpp_mov<0x111>(x) + x; if (rl >= 1) x = t;
    t = dpp_mov<0x112>(x) + x; if (rl >= 2) x = t;
    t = dpp_mov<0x114>(x) + x; if (rl >= 4) x = t;
    t = dpp_mov<0x118>(x) + x; if (rl >= 8) x = t;
    t = dpp_mov<0x142>(x) + x; if ((lane & 31) >= 16) x = t;
    t = dpp_mov<0x143>(x) + x; if (lane >= 32) x = t;
    return x;
}
__device__ __forceinline__ float wave_scan_max(float x, int lane) {
    const int rl = lane & 15; float t;
    t = fmaxf(dpp_mov<0x111>(x), x); if (rl >= 1) x = t;
    t = fmaxf(dpp_mov<0x112>(x), x); if (rl >= 2) x = t;
    t = fmaxf(dpp_mov<0x114>(x), x); if (rl >= 4) x = t;
    t = fmaxf(dpp_mov<0x118>(x), x); if (rl >= 8) x = t;
    t = fmaxf(dpp_mov<0x142>(x), x); if ((lane & 31) >= 16) x = t;
    t = fmaxf(dpp_mov<0x143>(x), x); if (lane >= 32) x = t;
    return x;
}

__device__ __forceinline__ float row16_sum(float s) { s += dpp_mov<0xB1>(s); s += dpp_mov<0x4E>(s); s += dpp_mov<0x124>(s); s += dpp_mov<0x128>(s); return s; }
__device__ __forceinline__ float wave_sum(float s) { s = row16_sum(s);
    const int si = __float_as_int(s);
    return __int_as_float(__builtin_amdgcn_readlane(si, 0)) + __int_as_float(__builtin_amdgcn_readlane(si, 16)) + __int_as_float(__builtin_amdgcn_readlane(si, 32)) + __int_as_float(__builtin_amdgcn_readlane(si, 48)); }

__device__ __forceinline__ void phase_modnorm(CPR P, int l, int j, bool first) {
    const int jp = (j + 2) % 3, lp = (j == 0) ? l - 1 : l, nks = first ? 0 : (jp == 1 ? 4 : 11); const float coefp = (jp == 1) ? 1.0f : 0.5f;
    const float* slab = (const float*)(P.ws + WS_SLAB);
    const float* gatep = (const float*)(P.ws + WS_MODS) + (size_t)(lp < 0 ? 0 : lp) * 5 * 9216 + 4 * 9216 + (3 * jp + 2) * 1024;
    const int tid_ = opaque_tid(); const int lane = tid_ & 63, wid = tid_ >> 6;
    const float* mods_l = (const float*)(P.ws + WS_MODS) + (size_t)l * 5 * 9216;
    const float* gn = P.in[I_GNORM] + (size_t)(l * 3 + j) * 1024;
    float* xctx = (float*)(P.ws + WS_CTXX);
    bf16_t* H = (bf16_t*)(P.ws + WS_H);
    const float* xlat_src = first ? P.in[I_X] : P.out; const float* xctx_src = first ? P.in[I_CTX] : xctx;
    f32x4 gv[4], sh[4], scl[4], xn[4];
#pragma unroll
    for (int i = 0; i < 4; ++i) { gv[i] = *(const f32x4*)(gn + lane * 4 + 256 * i); sh[i] = gv[i]; scl[i] = gv[i]; xn[i] = gv[i]; }
    const int stride = gridDim.x * 8; int row = blockIdx.x * 8 + wid; int curmod = -1;
#define MN_LOAD(r_) do { const float* s_ = ((r_) < NLAT) ? xlat_src + (size_t)(r_) * 1024 : xctx_src + (size_t)((r_) - NLAT) * 1024; \
        _Pragma("unroll") for (int i_ = 0; i_ < 4; ++i_) xn[i_] = *(const f32x4*)(s_ + lane * 4 + 256 * i_); } while (0)
    if (row < NT) MN_LOAD(row);
    for (; row < NT; row += stride) {
        float* dst; int mod;
        if (row < NLAT) { dst = P.out + (size_t)row * 1024; mod = row >> 13; } else { dst = xctx + (size_t)(row - NLAT) * 1024; mod = 4; }
        f32x4 xv[4];
#pragma unroll
        for (int i = 0; i < 4; ++i) xv[i] = xn[i];
        if (row + stride < NT) MN_LOAD(row + stride);
        if (row >= NLAT && nks > 0) {
#pragma unroll
            for (int i = 0; i < 4; ++i) {
                f32x4 s = (f32x4){0.f, 0.f, 0.f, 0.f};
                for (int ks = 0; ks < nks; ++ks) s += *(const f32x4*)(slab + ((size_t)ks * NCTX + (row - NLAT)) * 1024 + lane * 4 + 256 * i);
                xv[i] += *(const f32x4*)(gatep + lane * 4 + 256 * i) * coefp * s;
                *(f32x4*)(dst + lane * 4 + 256 * i) = xv[i];
            }
        }
        float ss = 0.f;
#pragma unroll
        for (int i = 0; i < 4; ++i) ss += xv[i][0] * xv[i][0] + xv[i][1] * xv[i][1] + xv[i][2] * xv[i][2] + xv[i][3] * xv[i][3];
        if (first) {
#pragma unroll
            for (int i = 0; i < 4; ++i) *(f32x4*)(dst + lane * 4 + 256 * i) = xv[i];
        }
        if (mod != curmod) {
            const float* mp = mods_l + (size_t)mod * 9216 + (3 * j) * 1024;
#pragma unroll
            for (int i = 0; i < 4; ++i) { sh[i] = *(const f32x4*)(mp + lane * 4 + 256 * i); scl[i] = *(const f32x4*)(mp + 1024 + lane * 4 + 256 * i) + 1.0f; }
            curmod = mod;
        }
        const float rstd = rsqrtf(wave_sum(ss) * (1.0f / 1024.0f) + EPS);
#pragma unroll
        for (int i = 0; i < 4; ++i) {
            const f32x4 hv = xv[i] * rstd * gv[i] * scl[i] + sh[i];
            u32x2 w; w.x = cvt_pk_bf16(hv[0], hv[1]); w.y = cvt_pk_bf16(hv[2], hv[3]);
            *(u32x2*)(H + (size_t)row * 1024 + lane * 4 + 256 * i) = w;
        }
    }
#undef MN_LOAD
}
__device__ __forceinline__ void phase_final(CPR P) {
    const int tid_ = opaque_tid(); const int lane = tid_ & 63, wid = tid_ >> 6;
    const float* gn = P.in[I_GFINAL];
    f32x4 gv[4];
#pragma unroll
    for (int i = 0; i < 4; ++i) gv[i] = *(const f32x4*)(gn + lane * 4 + 256 * i);
    for (int row = blockIdx.x * 8 + wid; row < NLAT; row += gridDim.x * 8) {
        float* p = P.out + (size_t)row * 1024;
        f32x4 xv[4]; float ss = 0.f;
#pragma unroll
        for (int i = 0; i < 4; ++i) { xv[i] = *(const f32x4*)(p + lane * 4 + 256 * i); ss += xv[i][0] * xv[i][0] + xv[i][1] * xv[i][1] + xv[i][2] * xv[i][2] + xv[i][3] * xv[i][3]; }
        const float rstd = rsqrtf(wave_sum(ss) * (1.0f / 1024.0f) + EPS);
#pragma unroll
        for (int i = 0; i < 4; ++i) *(f32x4*)(p + lane * 4 + 256 * i) = xv[i] * rstd * gv[i];
    }
}

__device__ __forceinline__ void scan_gla(CPR P, int l, int b, int h, int dir, lds_t lds) {
    const int tid = opaque_tid(), lane = tid & 63, wid = tid >> 6, fr = lane & 15, fq = lane >> 4;
    const bf16_t* PB = (const bf16_t*)(P.ws + WS_PB); const float* PG = (const float*)(P.ws + WS_PG);
    bf16_t* OUT = (bf16_t*)(P.ws + (dir ? WS_H2 : WS_H));
    lds_t QR = lds, KR = lds + 9216, VT = lds + 18432, QT = lds + 27648, KT = lds + 36864, KWT = lds + 46080, ATT = lds + 55296, ST = lds + 64512;
    LAS float* LR = (LAS float*)(lds + 73728); LAS float* TOT = (LAS float*)(lds + 77824); LAS float* DEC = (LAS float*)(lds + 79872);
    const int d = tid & 63, o = tid >> 6;
    float wreg[16];
#pragma unroll
    for (int r = 0; r < 16; ++r) wreg[r] = P.in[I_GLAW][(size_t)((l * 2 + dir) * 16 + r) * 256 + h * 64 + d];
    const float bias = P.in[I_GLAB][(l * 2 + dir) * 256 + h * 64 + d];
    for (int i = tid; i < 9216 / 4; i += 512) ((LAS unsigned*)ST)[i] = 0u;
    f32x4 sacc[2] = {(f32x4){0.f, 0.f, 0.f, 0.f}, (f32x4){0.f, 0.f, 0.f, 0.f}};
    const int tm = wid >> 1, tn0 = (wid & 1) * 2;
    __syncthreads();
    u32x4 q8, k8, v8; f32x4 lr4 = (f32x4){0.f, 0.f, 0.f, 0.f};
#define GLA_ISSUE(cc_) do { const int sg_ = (cc_) >= 4, c_ = sg_ ? (cc_) - 4 : (cc_), L_ = sg_ ? SEQ : CTXL; const int t_ = tid >> 3, c8_ = tid & 7; const int lp_ = c_ * 64 + t_, p_ = dir ? (L_ - 1 - lp_) : lp_; \
        const bf16_t* pr_ = PB + (size_t)tok_row(sg_, b, p_, false) * NINP + h * 64 + c8_ * 8; \
        q8 = *(const u32x4*)(pr_ + GLA_Q); k8 = *(const u32x4*)(pr_ + GLA_K); v8 = *(const u32x4*)(pr_ + GLA_V); \
        { const int t2_ = (tid & 255) >> 2, r4_ = tid & 3; const int lp2_ = c_ * 64 + t2_, p2_ = dir ? (L_ - 1 - lp2_) : lp2_; \
            lr4 = *(const f32x4*)(PG + (size_t)tok_row(sg_, b, p2_, false) * PGW + dir * 16 + r4_ * 4); } } while (0)
    constexpr int D_GA = 80384, D_LR = 108032 - 73728;
#define GLA_STAGE(pp_) do { lds_t QRp_ = QR + (pp_) * D_GA; lds_t KRp_ = KR + (pp_) * D_GA; lds_t VTp_ = VT + (pp_) * D_GA; LAS float* LRp_ = LR + (pp_) * (D_LR / 4); \
        asm volatile("s_waitcnt vmcnt(0)" ::: "memory"); \
        { const int t_ = tid >> 3, c8_ = tid & 7; \
          *(LAS u32x4*)(QRp_ + t_ * LDT + c8_ * 16) = q8; *(LAS u32x4*)(KRp_ + t_ * LDT + c8_ * 16) = k8; \
          _Pragma("unroll") for (int i_ = 0; i_ < 4; ++i_) { *(LAS bf16_t*)(VTp_ + (c8_ * 8 + 2 * i_) * LDT + t_ * 2) = (bf16_t)(v8[i_] & 0xffffu); *(LAS bf16_t*)(VTp_ + (c8_ * 8 + 2 * i_ + 1) * LDT + t_ * 2) = (bf16_t)(v8[i_] >> 16); } \
          if (tid < 256) { const int t2_ = tid >> 2, r4_ = tid & 3; *(LAS f32x4*)(LRp_ + t2_ * 16 + r4_ * 4) = lr4; } } } while (0)
    constexpr int D_KW = 112128 - 46080, D_DEC = 121344 - 79872;
    float bl[8];
#define GLA_B1(pp_) do { LAS float* LRp_ = LR + (pp_) * (D_LR / 4); float run_ = 0.f; \
        _Pragma("unroll") for (int i_ = 0; i_ < 8; ++i_) { const int t_ = o * 8 + i_; float dot_ = bias; \
            _Pragma("unroll") for (int r4_ = 0; r4_ < 4; ++r4_) { const f32x4 x_ = *(const LAS f32x4*)(LRp_ + t_ * 16 + r4_ * 4); dot_ += x_[0] * wreg[4 * r4_] + x_[1] * wreg[4 * r4_ + 1] + x_[2] * wreg[4 * r4_ + 2] + x_[3] * wreg[4 * r4_ + 3]; } \
            run_ += logsigf_(dot_) * (1.0f / 16.0f); bl[i_] = run_; } \
        TOT[o * 64 + d] = run_; } while (0)
#define GLA_B2(pp_) do { lds_t QRp_ = QR + (pp_) * D_GA; lds_t KRp_ = KR + (pp_) * D_GA; float pre_ = 0.f, tot_ = 0.f; \
        _Pragma("unroll") for (int o2_ = 0; o2_ < 8; ++o2_) { const float v_ = TOT[o2_ * 64 + d]; if (o2_ < o) pre_ += v_; tot_ += v_; } \
        float kw_[8]; const float et_ = __expf(tot_); \
        _Pragma("unroll") for (int i_ = 0; i_ < 8; ++i_) { const int t_ = o * 8 + i_; const float bb_ = pre_ + bl[i_]; const float enb_ = __expf(-bb_); \
            const float qv_ = bf2f(*(const LAS bf16_t*)(QRp_ + t_ * LDT + d * 2)), kv_ = bf2f(*(const LAS bf16_t*)(KRp_ + t_ * LDT + d * 2)); \
            *(LAS bf16_t*)(QT + t_ * LDT + d * 2) = f2bf(qv_ * 0.125f * __expf(bb_)); *(LAS bf16_t*)(KT + t_ * LDT + d * 2) = f2bf(kv_ * enb_); kw_[i_] = kv_ * (et_ * enb_); } \
        u32x4 w_; w_.x = cvt_pk_bf16(kw_[0], kw_[1]); w_.y = cvt_pk_bf16(kw_[2], kw_[3]); w_.z = cvt_pk_bf16(kw_[4], kw_[5]); w_.w = cvt_pk_bf16(kw_[6], kw_[7]); \
        *(LAS u32x4*)(KWT + (pp_) * D_KW + d * LDT + o * 16) = w_; if (o == 0) (DEC + (pp_) * (D_DEC / 4))[d] = et_; } while (0)
    GLA_ISSUE(0);
    GLA_STAGE(0);
    GLA_ISSUE(1);
    __syncthreads();
    GLA_B1(0);
    __syncthreads();
    GLA_B2(0);
    __syncthreads();
#pragma unroll 1
    for (int cc = 0; cc < 132; ++cc) {
        {
            const int seg = cc >= 4, c = seg ? cc - 4 : cc, L = seg ? SEQ : CTXL; const int pb = cc & 1;
            lds_t VTc = VT + pb * D_GA; lds_t KWTc = KWT + pb * D_KW; LAS float* DECc = DEC + pb * (D_DEC / 4);
            f32x4 oacc[2];
#pragma unroll
            for (int i = 0; i < 2; ++i) {
                const int tn = tn0 + i; f32x4 a = (f32x4){0.f, 0.f, 0.f, 0.f};
                mma_tile<true, 2, LDT, LDT>(a, QT, tm * 16, KT, tn * 16, fr, fq);
                const int t = tm * 16 + fr, s0 = tn * 16 + fq * 4;
#pragma unroll
                for (int jx = 0; jx < 4; ++jx) a[jx] = (s0 + jx <= t) ? a[jx] : 0.f;
                u32x2 w; w.x = cvt_pk_bf16(a[0], a[1]); w.y = cvt_pk_bf16(a[2], a[3]);
                *(LAS u32x2*)(ATT + t * LDT + s0 * 2) = w;
                oacc[i] = (f32x4){0.f, 0.f, 0.f, 0.f};
                mma_tile<true, 2, LDT, LDT>(oacc[i], QT, tm * 16, ST, tn * 16, fr, fq);
            }
            if (cc + 1 < 132) { GLA_STAGE(pb ^ 1); if (cc + 2 < 132) GLA_ISSUE(cc + 2); }
            __syncthreads();
            {
                const int t = tm * 16 + fr; const int lp = c * 64 + t, p = dir ? (L - 1 - lp) : lp;
                bf16_t* orow = OUT + (size_t)tok_row(seg, b, p, false) * 1024 + 0 + h * 64;
#pragma unroll
                for (int i = 0; i < 2; ++i) {
                    const int tn = tn0 + i;
                    mma_tile<true, 2, LDT, LDT>(oacc[i], ATT, tm * 16, VTc, tn * 16, fr, fq);
                    u32x2 w; w.x = cvt_pk_bf16(oacc[i][0], oacc[i][1]); w.y = cvt_pk_bf16(oacc[i][2], oacc[i][3]);
                    *(u32x2*)(orow + tn * 16 + fq * 4) = w;
                }
            }
            GLA_B1(pb ^ 1);
            __syncthreads();
            {
                const f32x4 dv = *(const LAS f32x4*)(DECc + tm * 16 + fq * 4);
#pragma unroll
                for (int i = 0; i < 2; ++i) {
                    const int tn = tn0 + i;
                    sacc[i] *= dv;
                    mma_tile<false, 2, LDT, LDT>(sacc[i], KWTc, tm * 16, VTc, tn * 16, fr, fq);
                    u32x2 w; w.x = cvt_pk_bf16(sacc[i][0], sacc[i][1]); w.y = cvt_pk_bf16(sacc[i][2], sacc[i][3]);
                    *(LAS u32x2*)(ST + (tn * 16 + fr) * LDT + (tm * 16 + fq * 4) * 2) = w;
                }
            }
            GLA_B2(pb ^ 1);
            __syncthreads();
        }
    }
}

__device__ __forceinline__ void scan_ssd(CPR P, int l, int b, int h, int dir, lds_t lds) {
    const int tid = opaque_tid(), lane = tid & 63, wid = tid >> 6, fr = lane & 15, fq = lane >> 4;
    const bf16_t* PB = (const bf16_t*)(P.ws + WS_PB); const float* PG = (const float*)(P.ws + WS_PG);
    bf16_t* OUT = (bf16_t*)(P.ws + (dir ? WS_H2 : WS_H));
    lds_t CM = lds, BM = lds + 9216, XT = lds + 18432, BWT = lds + 27648, SC = lds + 36864, ST = lds + 46080, XS = lds + 55296, RAW = lds + 64512;
    LAS float* CUM = (LAS float*)(lds + 90912); LAS float* DTV = (LAS float*)(lds + 91168); LAS float* EWV = (LAS float*)(lds + 91424);
    constexpr int RS = 400;
    const int d = tid & 63, o = tid >> 6, g2 = h >> 1;
    const float* cw = P.in[I_SSDCW] + (size_t)l * 3 * 512; const float* cb = P.in[I_SSDCB] + (size_t)l * 512;
    const int chv[3] = {h * 64 + d, 256 + g2 * 64 + d, 384 + g2 * 64 + d};
    float w0[3], w1[3], w2[3], wb[3];
#pragma unroll
    for (int g = 0; g < 3; ++g) { w0[g] = cw[(dir ? 2 : 0) * 512 + chv[g]]; w1[g] = cw[512 + chv[g]]; w2[g] = cw[(dir ? 0 : 2) * 512 + chv[g]]; wb[g] = cb[chv[g]]; }
    const float dtb = P.in[I_SSDDTB][(l * 2 + dir) * 4 + h], nega = -__expf(P.in[I_SSDALOG][(l * 2 + dir) * 4 + h]), dsk = P.in[I_SSDD][l * 4 + h]; const float dskv = dir == 0 ? dsk : 0.f;
    for (int i = tid; i < 9216 / 4; i += 512) ((LAS unsigned*)ST)[i] = 0u;
    f32x4 sacc[2] = {(f32x4){0.f, 0.f, 0.f, 0.f}, (f32x4){0.f, 0.f, 0.f, 0.f}};
    const int tm = wid >> 1, tn0 = (wid & 1) * 2;
    __syncthreads();
    u32x4 rw[4]; float dtraw = 0.f;
#define SSD_LD(dst_, lp_) do { int lpp_ = (lp_); lpp_ = lpp_ < 0 ? 0 : (lpp_ >= L_ ? L_ - 1 : lpp_); const int p_ = dir ? (L_ - 1 - lpp_) : lpp_; \
        const int col_ = cgp_ == 0 ? SSD_X + h * 64 : (cgp_ == 1 ? SSD_B + g2 * 64 : SSD_C + g2 * 64); dst_ = *(const u32x4*)(PB + (size_t)tok_row(sg_, b, p_, true) * NINP + col_ + c8_ * 8); } while (0)
#define SSD_ISSUE(cc_) do { const int sg_ = (cc_) >= 4, c_ = sg_ ? (cc_) - 4 : (cc_), L_ = sg_ ? SEQ : CTXL; \
        _Pragma("unroll") for (int k_ = 0; k_ < 3; ++k_) { const int idx_ = tid + 512 * k_; const int rr_ = idx_ / 24, rem_ = idx_ % 24, cgp_ = rem_ >> 3, c8_ = rem_ & 7; SSD_LD(rw[k_], c_ * 64 + rr_); } \
        { const int th_ = tid % 48; const int rr_ = th_ / 24, rem_ = th_ % 24, cgp_ = rem_ >> 3, c8_ = rem_ & 7; SSD_LD(rw[3], c_ * 64 + (rr_ ? 64 : -1)); } \
        { const int lp_ = c_ * 64 + lane, p_ = dir ? (L_ - 1 - lp_) : lp_; dtraw = PG[(size_t)tok_row(sg_, b, p_, true) * PGW + 32 + dir * 4 + h]; } } while (0)
    constexpr int D_SB = 91904 - 64512;
#define SSD_STAGE(cn_, pp_) do { const int sgS_ = (cn_) >= 4, cS_ = sgS_ ? (cn_) - 4 : (cn_), LS_ = sgS_ ? SEQ : CTXL; \
        lds_t RAWp_ = RAW + (pp_) * D_SB; LAS float* CUMp_ = CUM + (pp_) * (D_SB / 4); LAS float* DTVp_ = DTV + (pp_) * (D_SB / 4); LAS float* EWVp_ = EWV + (pp_) * (D_SB / 4); \
        asm volatile("s_waitcnt vmcnt(0)" ::: "memory"); \
        _Pragma("unroll") for (int k_ = 0; k_ < 3; ++k_) { const int idx_ = tid + 512 * k_; const int rr_ = idx_ / 24, rem_ = idx_ % 24, cgp_ = rem_ >> 3, c8_ = rem_ & 7; *(LAS u32x4*)(RAWp_ + (rr_ + 1) * RS + cgp_ * 128 + c8_ * 16) = rw[k_]; } \
        if (tid < 48) { const int rr_ = tid / 24, rem_ = tid % 24, cgp_ = rem_ >> 3, c8_ = rem_ & 7; const int lph_ = cS_ * 64 + (rr_ ? 64 : -1); \
            *(LAS u32x4*)(RAWp_ + (rr_ ? 65 : 0) * RS + cgp_ * 128 + c8_ * 16) = (lph_ >= 0 && lph_ < LS_) ? rw[3] : (u32x4){0u, 0u, 0u, 0u}; } \
        if (wid == 0) { const float dt_ = softplusf_(dtraw + dtb); const float cum_ = wave_scan_add(dt_ * nega, lane); DTVp_[lane] = dt_; CUMp_[lane] = cum_; \
            const float clv_ = __int_as_float(__builtin_amdgcn_readlane(__float_as_int(cum_), 63)); EWVp_[lane] = __expf(clv_ - cum_); } } while (0)
    constexpr int D_XB = 119072 - 18432;
#define SSD_BCB(pp_) do { lds_t RAWp_ = RAW + (pp_) * D_SB; LAS float* EWVp_ = EWV + (pp_) * (D_SB / 4); float bw_[8]; \
        _Pragma("unroll") for (int g_ = 1; g_ < 3; ++g_) { \
            float prev_ = bf2f(*(const LAS bf16_t*)(RAWp_ + (o * 8 + 0) * RS + g_ * 128 + d * 2)), cur_ = bf2f(*(const LAS bf16_t*)(RAWp_ + (o * 8 + 1) * RS + g_ * 128 + d * 2)); \
            _Pragma("unroll") for (int i_ = 0; i_ < 8; ++i_) { const int t_ = o * 8 + i_; const float nxt_ = bf2f(*(const LAS bf16_t*)(RAWp_ + (t_ + 2) * RS + g_ * 128 + d * 2)); \
                const float v_ = siluf_(w0[g_] * prev_ + w1[g_] * cur_ + w2[g_] * nxt_ + wb[g_]); prev_ = cur_; cur_ = nxt_; \
                if (g_ == 1) { *(LAS bf16_t*)(BM + t_ * LDT + d * 2) = f2bf(v_); bw_[i_] = v_ * EWVp_[t_]; } else { *(LAS bf16_t*)(CM + t_ * LDT + d * 2) = f2bf(v_); } } } \
        u32x4 w_; w_.x = cvt_pk_bf16(bw_[0], bw_[1]); w_.y = cvt_pk_bf16(bw_[2], bw_[3]); w_.z = cvt_pk_bf16(bw_[4], bw_[5]); w_.w = cvt_pk_bf16(bw_[6], bw_[7]); \
        *(LAS u32x4*)(BWT + (pp_) * D_XB + d * LDT + o * 16) = w_; } while (0)
#define SSD_BX(pp_) do { lds_t RAWp_ = RAW + (pp_) * D_SB; LAS float* DTVp_ = DTV + (pp_) * (D_SB / 4); float xt_[8]; \
        float prev_ = bf2f(*(const LAS bf16_t*)(RAWp_ + (o * 8 + 0) * RS + d * 2)), cur_ = bf2f(*(const LAS bf16_t*)(RAWp_ + (o * 8 + 1) * RS + d * 2)); \
        _Pragma("unroll") for (int i_ = 0; i_ < 8; ++i_) { const int t_ = o * 8 + i_; const float nxt_ = bf2f(*(const LAS bf16_t*)(RAWp_ + (t_ + 2) * RS + d * 2)); \
            const float v_ = siluf_(w0[0] * prev_ + w1[0] * cur_ + w2[0] * nxt_ + wb[0]); prev_ = cur_; cur_ = nxt_; \
            *(LAS bf16_t*)(XS + t_ * LDT + d * 2) = f2bf(v_); xt_[i_] = v_ * DTVp_[t_]; } \
        u32x4 w_; w_.x = cvt_pk_bf16(xt_[0], xt_[1]); w_.y = cvt_pk_bf16(xt_[2], xt_[3]); w_.z = cvt_pk_bf16(xt_[4], xt_[5]); w_.w = cvt_pk_bf16(xt_[6], xt_[7]); \
        *(LAS u32x4*)(XT + (pp_) * D_XB + d * LDT + o * 16) = w_; } while (0)
    SSD_ISSUE(0);
    SSD_STAGE(0, 0);
    SSD_ISSUE(1);
    __syncthreads();
    SSD_BCB(0); SSD_BX(0);
    __syncthreads();
#pragma unroll 1
    for (int cc = 0; cc < 132; ++cc) {
        {
            const int seg = cc >= 4, c = seg ? cc - 4 : cc, L = seg ? SEQ : CTXL; const int pb = cc & 1;
            LAS float* CUMc = CUM + pb * (D_SB / 4); lds_t XTc = XT + pb * D_XB; lds_t BWTc = BWT + pb * D_XB;
            f32x4 yacc[2];
            {
                const int t = tm * 16 + fr; const float ct = CUMc[t]; const float ect = __expf(ct);
#pragma unroll
                for (int i = 0; i < 2; ++i) {
                    const int tn = tn0 + i; f32x4 a = (f32x4){0.f, 0.f, 0.f, 0.f};
                    mma_tile<true, 2, LDT, LDT>(a, CM, tm * 16, BM, tn * 16, fr, fq);
                    const int s0 = tn * 16 + fq * 4; const f32x4 cs = *(const LAS f32x4*)(CUMc + s0);
#pragma unroll
                    for (int jx = 0; jx < 4; ++jx) a[jx] = (s0 + jx <= t) ? a[jx] * __expf(ct - cs[jx]) : 0.f;
                    u32x2 w; w.x = cvt_pk_bf16(a[0], a[1]); w.y = cvt_pk_bf16(a[2], a[3]);
                    *(LAS u32x2*)(SC + t * LDT + s0 * 2) = w;
                    yacc[i] = (f32x4){0.f, 0.f, 0.f, 0.f};
                    mma_tile<true, 2, LDT, LDT>(yacc[i], CM, tm * 16, ST, tn * 16, fr, fq);
                    yacc[i] *= ect;
                }
            }
            if (cc + 1 < 132) { SSD_STAGE(cc + 1, pb ^ 1); if (cc + 2 < 132) SSD_ISSUE(cc + 2); }
            __syncthreads();
            {
                const int t = tm * 16 + fr; const int lp = c * 64 + t, p = dir ? (L - 1 - lp) : lp;
                bf16_t* orow = OUT + (size_t)tok_row(seg, b, p, true) * 1024 + 256 + h * 64;
#pragma unroll
                for (int i = 0; i < 2; ++i) {
                    const int tn = tn0 + i, p0 = tn * 16 + fq * 4;
                    mma_tile<true, 2, LDT, LDT>(yacc[i], SC, tm * 16, XTc, tn * 16, fr, fq);
                    {
                        const u32x2 xs = *(const LAS u32x2*)(XS + t * LDT + p0 * 2);
                        yacc[i][0] += dskv * bflo(xs.x); yacc[i][1] += dskv * bfhi(xs.x); yacc[i][2] += dskv * bflo(xs.y); yacc[i][3] += dskv * bfhi(xs.y); }
                    u32x2 w; w.x = cvt_pk_bf16(yacc[i][0], yacc[i][1]); w.y = cvt_pk_bf16(yacc[i][2], yacc[i][3]);
                    *(u32x2*)(orow + p0) = w;
                }
            }
            SSD_BCB(pb ^ 1);
            __syncthreads();
            {
                const float ecl_in = CUMc[63]; const float ecl = __expf(ecl_in);
#pragma unroll
                for (int i = 0; i < 2; ++i) {
                    const int tn = tn0 + i;
                    sacc[i] *= ecl;
                    mma_tile<false, 2, LDT, LDT>(sacc[i], BWTc, tm * 16, XTc, tn * 16, fr, fq);
                    u32x2 w; w.x = cvt_pk_bf16(sacc[i][0], sacc[i][1]); w.y = cvt_pk_bf16(sacc[i][2], sacc[i][3]);
                    *(LAS u32x2*)(ST + (tn * 16 + fr) * LDT + (tm * 16 + fq * 4) * 2) = w;
                }
            }
            SSD_BX(pb ^ 1);
            __syncthreads();
        }
    }
}

__device__ __forceinline__ void scan_mlstm(CPR P, int l, int b, int h, int dir, lds_t lds) {
    const int tid = opaque_tid(), lane = tid & 63, wid = tid >> 6, fr = lane & 15, fq = lane >> 4;
    const bf16_t* PB = (const bf16_t*)(P.ws + WS_PB); const float* PG = (const float*)(P.ws + WS_PG);
    bf16_t* OUT = (bf16_t*)(P.ws + (dir ? WS_H2 : WS_H));
    lds_t QM = lds, KM = lds + 9216, KWT = lds + 18432, WM = lds + 27648, VT = lds + 36864, CT = lds + 48384, RAW = lds + 59904;
    LAS float* FV = (LAS float*)(lds + 77856); LAS float* AV = (LAS float*)(lds + 78112); LAS float* MV = (LAS float*)(lds + 78368); LAS float* DEN = (LAS float*)(lds + 78624); LAS float* KWE = (LAS float*)(lds + 79648);
    constexpr int RS = 272;
    const int d = tid & 63, o = tid >> 6;
    const float* cw = P.in[I_MLCW] + (size_t)l * 3 * 512; const float* cb = P.in[I_MLCB] + (size_t)l * 512;
    const int chv[2] = {h * 64 + d, 256 + h * 64 + d};
    float w0[2], w1[2], w2[2], wb[2];
#pragma unroll
    for (int g = 0; g < 2; ++g) { w0[g] = cw[(dir ? 2 : 0) * 512 + chv[g]]; w1[g] = cw[512 + chv[g]]; w2[g] = cw[(dir ? 0 : 2) * 512 + chv[g]]; wb[g] = cb[chv[g]]; }
    const float gbi = P.in[I_MLGB][l * 16 + dir * 8 + h], gbf = P.in[I_MLGB][l * 16 + dir * 8 + 4 + h];
    for (int i = tid; i < 11520 / 4; i += 512) ((LAS unsigned*)CT)[i] = 0u;
    constexpr int D_VT = 80000 - 36864, D_RAW = 91520 - 59904, D_G = 31744;
    for (int i = tid; i < 16 * LDT / 4; i += 512) { const unsigned v = (i < LDT / 4) ? 0x3F803F80u : 0u; ((LAS unsigned*)(VT + 64 * LDT))[i] = v; ((LAS unsigned*)(VT + D_VT + 64 * LDT))[i] = v; }
    f32x4 cacc[3] = {(f32x4){0.f, 0.f, 0.f, 0.f}, (f32x4){0.f, 0.f, 0.f, 0.f}, (f32x4){0.f, 0.f, 0.f, 0.f}};
    float m_s = 0.f;
    const int tm = wid >> 1, tn0 = (wid & 1) * 2; const bool extra = (wid & 1) == 0;
    __syncthreads();
    u32x4 rw[3], v8; float graw_i = 0.f, graw_f = 0.f;
#define ML_LD(dst_, lp_) do { int lpp_ = (lp_); lpp_ = lpp_ < 0 ? 0 : (lpp_ >= L_ ? L_ - 1 : lpp_); const int p_ = dir ? (L_ - 1 - lpp_) : lpp_; \
        dst_ = *(const u32x4*)(PB + (size_t)tok_row(sg_, b, p_, false) * NINP + ML_Q + cgp_ * 256 + h * 64 + c8_ * 8); } while (0)
#define ML_ISSUE(cc_) do { const int sg_ = (cc_) >= 4, c_ = sg_ ? (cc_) - 4 : (cc_), L_ = sg_ ? SEQ : CTXL; \
        _Pragma("unroll") for (int k_ = 0; k_ < 2; ++k_) { const int idx_ = tid + 512 * k_; const int rr_ = idx_ >> 4, rem_ = idx_ & 15, cgp_ = rem_ >> 3, c8_ = rem_ & 7; ML_LD(rw[k_], c_ * 64 + rr_); } \
        { const int th_ = tid & 31; const int rr_ = th_ >> 4, rem_ = th_ & 15, cgp_ = rem_ >> 3, c8_ = rem_ & 7; ML_LD(rw[2], c_ * 64 + (rr_ ? 64 : -1)); } \
        { const int t_ = tid >> 3, c8_ = tid & 7; const int lp_ = c_ * 64 + t_, p_ = dir ? (L_ - 1 - lp_) : lp_; v8 = *(const u32x4*)(PB + (size_t)tok_row(sg_, b, p_, false) * NINP + ML_V + h * 64 + c8_ * 8); } \
        { const int lp_ = c_ * 64 + lane, p_ = dir ? (L_ - 1 - lp_) : lp_; const float* pg_ = PG + (size_t)tok_row(sg_, b, p_, false) * PGW + 64 + dir * 8 + h; graw_i = pg_[0]; graw_f = pg_[4]; } } while (0)
#define ML_STAGE(cn_, pp_, ms_) do { const int sgS_ = (cn_) >= 4, cS_ = sgS_ ? (cn_) - 4 : (cn_), LS_ = sgS_ ? SEQ : CTXL; \
        lds_t RAWp_ = RAW + (pp_) * D_RAW; lds_t VTp_ = VT + (pp_) * D_VT; LAS float* FVp_ = FV + (pp_) * (D_G / 4); LAS float* AVp_ = AV + (pp_) * (D_G / 4); LAS float* MVp_ = MV + (pp_) * (D_G / 4); LAS float* KWEp_ = KWE + (pp_) * (D_G / 4); \
        asm volatile("s_waitcnt vmcnt(0)" ::: "memory"); \
        _Pragma("unroll") for (int k_ = 0; k_ < 2; ++k_) { const int idx_ = tid + 512 * k_; const int rr_ = idx_ >> 4, rem_ = idx_ & 15, cgp_ = rem_ >> 3, c8_ = rem_ & 7; *(LAS u32x4*)(RAWp_ + (rr_ + 1) * RS + cgp_ * 128 + c8_ * 16) = rw[k_]; } \
        if (tid < 32) { const int rr_ = tid >> 4, rem_ = tid & 15, cgp_ = rem_ >> 3, c8_ = rem_ & 7; const int lph_ = cS_ * 64 + (rr_ ? 64 : -1); \
            *(LAS u32x4*)(RAWp_ + (rr_ ? 65 : 0) * RS + cgp_ * 128 + c8_ * 16) = (lph_ >= 0 && lph_ < LS_) ? rw[2] : (u32x4){0u, 0u, 0u, 0u}; } \
        { const int t_ = tid >> 3, c8_ = tid & 7; \
          _Pragma("unroll") for (int i_ = 0; i_ < 4; ++i_) { *(LAS bf16_t*)(VTp_ + (c8_ * 8 + 2 * i_) * LDT + t_ * 2) = (bf16_t)(v8[i_] & 0xffffu); *(LAS bf16_t*)(VTp_ + (c8_ * 8 + 2 * i_ + 1) * LDT + t_ * 2) = (bf16_t)(v8[i_] >> 16); } } \
        if (wid == 0) { const float ig_ = graw_i + gbi, lf_ = logsigf_(graw_f + gbf); \
            const float F_ = wave_scan_add(lf_, lane); const float a_ = ig_ - F_; const float M_ = fmaxf(wave_scan_max(a_, lane), (ms_)); \
            FVp_[lane] = F_; AVp_[lane] = a_; MVp_[lane] = M_; \
            const float m63_ = __int_as_float(__builtin_amdgcn_readlane(__float_as_int(M_), 63)); KWEp_[lane] = __expf(a_ - m63_); } } while (0)
    constexpr int D_KW = 111648 - 18432;
#define ML_BQ(pp_) do { lds_t RAWp_ = RAW + (pp_) * D_RAW; \
        float prev_ = bf2f(*(const LAS bf16_t*)(RAWp_ + (o * 8 + 0) * RS + d * 2)), cur_ = bf2f(*(const LAS bf16_t*)(RAWp_ + (o * 8 + 1) * RS + d * 2)); \
        _Pragma("unroll") for (int i_ = 0; i_ < 8; ++i_) { const int t_ = o * 8 + i_; const float nxt_ = bf2f(*(const LAS bf16_t*)(RAWp_ + (t_ + 2) * RS + d * 2)); \
            const float v_ = siluf_(w0[0] * prev_ + w1[0] * cur_ + w2[0] * nxt_ + wb[0]); prev_ = cur_; cur_ = nxt_; *(LAS bf16_t*)(QM + t_ * LDT + d * 2) = f2bf(v_); } } while (0)
#define ML_BK(pp_) do { lds_t RAWp_ = RAW + (pp_) * D_RAW; LAS float* KWEp_ = KWE + (pp_) * (D_G / 4); float kw_[8]; \
        float prev_ = bf2f(*(const LAS bf16_t*)(RAWp_ + (o * 8 + 0) * RS + 128 + d * 2)), cur_ = bf2f(*(const LAS bf16_t*)(RAWp_ + (o * 8 + 1) * RS + 128 + d * 2)); \
        _Pragma("unroll") for (int i_ = 0; i_ < 8; ++i_) { const int t_ = o * 8 + i_; const float nxt_ = bf2f(*(const LAS bf16_t*)(RAWp_ + (t_ + 2) * RS + 128 + d * 2)); \
            const float v_ = siluf_(w0[1] * prev_ + w1[1] * cur_ + w2[1] * nxt_ + wb[1]); prev_ = cur_; cur_ = nxt_; \
            const float kk_ = v_ * 0.125f; *(LAS bf16_t*)(KM + t_ * LDT + d * 2) = f2bf(kk_); kw_[i_] = kk_ * KWEp_[t_]; } \
        u32x4 w_; w_.x = cvt_pk_bf16(kw_[0], kw_[1]); w_.y = cvt_pk_bf16(kw_[2], kw_[3]); w_.z = cvt_pk_bf16(kw_[4], kw_[5]); w_.w = cvt_pk_bf16(kw_[6], kw_[7]); \
        *(LAS u32x4*)(KWT + (pp_) * D_KW + d * LDT + o * 16) = w_; } while (0)
    ML_ISSUE(0);
    ML_STAGE(0, 0, 0.f);
    ML_ISSUE(1);
    __syncthreads();
    ML_BQ(0); ML_BK(0);
    __syncthreads();
#pragma unroll 1
    for (int cc = 0; cc < 132; ++cc) {
        {
            const int seg = cc >= 4, c = seg ? cc - 4 : cc, L = seg ? SEQ : CTXL; const int pb = cc & 1;
            lds_t VTc = VT + pb * D_VT; LAS float* FVc = FV + pb * (D_G / 4); LAS float* AVc = AV + pb * (D_G / 4); LAS float* MVc = MV + pb * (D_G / 4); lds_t KWTc = KWT + pb * D_KW;
            f32x4 hacc[3];
            const int trow = tm * 16 + fr; const float Mt = MVc[trow];
            {
                const float winter = __expf(m_s - Mt);
#pragma unroll
                for (int i = 0; i < 2; ++i) {
                    const int tn = tn0 + i; f32x4 a = (f32x4){0.f, 0.f, 0.f, 0.f};
                    mma_tile<true, 2, LDT, LDT>(a, QM, tm * 16, KM, tn * 16, fr, fq);
                    const int s0 = tn * 16 + fq * 4; const f32x4 as = *(const LAS f32x4*)(AVc + s0);
#pragma unroll
                    for (int jx = 0; jx < 4; ++jx) a[jx] = (s0 + jx <= trow) ? a[jx] * __expf(as[jx] - Mt) : 0.f;
                    u32x2 w; w.x = cvt_pk_bf16(a[0], a[1]); w.y = cvt_pk_bf16(a[2], a[3]);
                    *(LAS u32x2*)(WM + trow * LDT + s0 * 2) = w;
                    hacc[i] = (f32x4){0.f, 0.f, 0.f, 0.f};
                    mma_tile<true, 2, LDT, LDT>(hacc[i], QM, tm * 16, CT, tn * 16, fr, fq);
                    hacc[i] *= winter;
                }
                hacc[2] = (f32x4){0.f, 0.f, 0.f, 0.f};
                if (extra) { mma_tile<true, 2, LDT, LDT>(hacc[2], QM, tm * 16, CT, 64, fr, fq); hacc[2] *= winter; }
            }
            if (cc + 1 < 132) { const float msn = FVc[63] + MVc[63]; ML_STAGE(cc + 1, pb ^ 1, msn); if (cc + 2 < 132) ML_ISSUE(cc + 2); }
            __syncthreads();
#pragma unroll
            for (int i = 0; i < 2; ++i) mma_tile<true, 2, LDT, LDT>(hacc[i], WM, tm * 16, VTc, (tn0 + i) * 16, fr, fq);
            if (extra) { mma_tile<true, 2, LDT, LDT>(hacc[2], WM, tm * 16, VTc, 64, fr, fq); DEN[fq * 64 + trow] = hacc[2][0]; }
            ML_BQ(pb ^ 1);
            __syncthreads();
            {
                const int lp = c * 64 + trow, p = dir ? (L - 1 - lp) : lp;
                bf16_t* orow = OUT + (size_t)tok_row(seg, b, p, false) * 1024 + 512 + h * 64;
                const float den = DEN[trow], mt = FVc[trow] + Mt; const float inv = __builtin_amdgcn_rcpf(fmaxf(fabsf(den), __expf(-mt)));
#pragma unroll
                for (int i = 0; i < 2; ++i) {
                    u32x2 w; w.x = cvt_pk_bf16(hacc[i][0] * inv, hacc[i][1] * inv); w.y = cvt_pk_bf16(hacc[i][2] * inv, hacc[i][3] * inv);
                    *(u32x2*)(orow + (tn0 + i) * 16 + fq * 4) = w;
                }
                const float M63 = MVc[63]; const float decay = __expf(m_s - M63);
#pragma unroll
                for (int i = 0; i < 2; ++i) {
                    const int tn = tn0 + i;
                    cacc[i] *= decay;
                    mma_tile<false, 2, LDT, LDT>(cacc[i], KWTc, tm * 16, VTc, tn * 16, fr, fq);
                    u32x2 w; w.x = cvt_pk_bf16(cacc[i][0], cacc[i][1]); w.y = cvt_pk_bf16(cacc[i][2], cacc[i][3]);
                    *(LAS u32x2*)(CT + (tn * 16 + fr) * LDT + (tm * 16 + fq * 4) * 2) = w;
                }
                if (extra) {
                    cacc[2] *= decay;
                    mma_tile<false, 2, LDT, LDT>(cacc[2], KWTc, tm * 16, VTc, 64, fr, fq);
                    u32x2 w; w.x = cvt_pk_bf16(cacc[2][0], cacc[2][1]); w.y = cvt_pk_bf16(cacc[2][2], cacc[2][3]);
                    *(LAS u32x2*)(CT + (64 + fr) * LDT + (tm * 16 + fq * 4) * 2) = w;
                }
                m_s = FVc[63] + M63;
            }
            ML_BK(pb ^ 1);
            __syncthreads();
        }
    }
}

__device__ __forceinline__ void scan_s5(CPR P, int l, int b, int g, int dir, lds_t lds) {
    const int tid = opaque_tid(), lane = tid & 63, wid = tid >> 6, fr = lane & 15, fq = lane >> 4;
    const bf16_t* PB = (const bf16_t*)(P.ws + WS_PB);
    bf16_t* OUT = (bf16_t*)(P.ws + (dir ? WS_H2 : WS_H));
    constexpr int US = 80, HS = 272;
    lds_t UA = lds, BB = lds + 5120, HB = lds + 49152, CB = lds + 66560;
    LAS float* BU = (LAS float*)(lds + 15360); LAS float* EO = (LAS float*)(lds + 70912);
    const int n = tid & 63, o = tid >> 6;
    const int pidx = ((l * 2 + dir) * 16 + g) * 64 + n;
    const float are = fminf(P.in[I_S5ARE][pidx], -1e-4f), aim = P.in[I_S5AIM][pidx], step = expf(P.in[I_S5LS][(l * 2 + dir) * 16 + g]);
    const float mag = expf(are * step), abr = mag * cosf(aim * step), abi = mag * sinf(aim * step);
    {
        const float den = are * are + aim * aim, nr = abr - 1.0f, ni = abi;
        const float cre = (nr * are + ni * aim) / den, cim = (ni * are - nr * aim) / den;
#pragma unroll
        for (int jj = 0; jj < 2; ++jj) {
            const int j = o * 2 + jj;
            const float bre = P.in[I_S5BRE][(size_t)((l * 16 + g) * 64 + n) * 16 + j], bim = P.in[I_S5BIM][(size_t)((l * 16 + g) * 64 + n) * 16 + j];
            *(LAS bf16_t*)(BB + n * US + j * 2) = f2bf(cre * bre - cim * bim);
            *(LAS bf16_t*)(BB + (64 + n) * US + j * 2) = f2bf(cre * bim + cim * bre);
            *(LAS bf16_t*)(BB + n * US + (16 + j) * 2) = 0; *(LAS bf16_t*)(BB + (64 + n) * US + (16 + j) * 2) = 0;
            *(LAS bf16_t*)(UA + n * US + (16 + j) * 2) = 0;
            const float cr = P.in[I_S5CRE][(size_t)((l * 16 + g) * 16 + j) * 64 + n], ci = P.in[I_S5CIM][(size_t)((l * 16 + g) * 16 + j) * 64 + n];
            *(LAS bf16_t*)(CB + j * HS + n * 2) = f2bf(cr); *(LAS bf16_t*)(CB + j * HS + (64 + n) * 2) = f2bf(-ci);
        }
    }
    float a8r = abr, a8i = abi;
#pragma unroll
    for (int s = 0; s < 3; ++s) { const float r2 = a8r * a8r - a8i * a8i, i2 = 2.0f * a8r * a8i; a8r = r2; a8i = i2; }
    float h0r = 0.f, h0i = 0.f;
    __syncthreads();
    u32x4 u8 = (u32x4){0u, 0u, 0u, 0u};
#define S5_ISSUE(cc_) do { { const int sg_ = (cc_) >= 4, c_ = sg_ ? (cc_) - 4 : (cc_), L_ = sg_ ? SEQ : CTXL; const int t_ = (tid & 127) >> 1, hf_ = tid & 1; const int lp_ = c_ * 64 + t_, p_ = dir ? (L_ - 1 - lp_) : lp_; \
        u8 = *(const u32x4*)(PB + (size_t)tok_row(sg_, b, p_, true) * NINP + S50 + g * 16 + hf_ * 8); } } while (0)
    S5_ISSUE(0);
#pragma unroll 1
    for (int cc = 0; cc < 132; ++cc) {
        {
            const int seg = cc >= 4, c = seg ? cc - 4 : cc, L = seg ? SEQ : CTXL;
            asm volatile("s_waitcnt vmcnt(0)" ::: "memory");
            if (tid < 128) { const int t = tid >> 1, hf = tid & 1; *(LAS u32x4*)(UA + t * US + hf * 16) = u8; }
            __syncthreads();
            if (cc + 1 < 132) S5_ISSUE(cc + 1);
            {   const int tm = wid >> 1;
#pragma unroll
                for (int i = 0; i < 4; ++i) { const int tn = (wid & 1) * 4 + i; f32x4 a = (f32x4){0.f, 0.f, 0.f, 0.f};
                    mma_tile<false, 1, US, US>(a, UA, tm * 16, BB, tn * 16, fr, fq);
#pragma unroll
                    for (int jx = 0; jx < 4; ++jx) BU[(tm * 16 + fq * 4 + jx) * 132 + tn * 16 + fr] = a[jx]; }
            }
            __syncthreads();
            float hr[8], hi[8];
            {   float r = 0.f, im = 0.f;
#pragma unroll
                for (int i = 0; i < 8; ++i) { const int t = o * 8 + i; const float br = BU[t * 132 + n], bi = BU[t * 132 + 64 + n];
                    const float nr = abr * r - abi * im + br, ni = abr * im + abi * r + bi; r = nr; im = ni; hr[i] = r; hi[i] = im; }
                EO[o * 128 + n] = r; EO[o * 128 + 64 + n] = im;
            }
            __syncthreads();
            {   float cr = h0r, ci = h0i, mr = 0.f, mi = 0.f;
#pragma unroll
                for (int o2 = 0; o2 < 8; ++o2) { if (o2 == o) { mr = cr; mi = ci; }
                    const float er = EO[o2 * 128 + n], ei = EO[o2 * 128 + 64 + n];
                    const float nr = a8r * cr - a8i * ci + er, ni = a8r * ci + a8i * cr + ei; cr = nr; ci = ni; }
                h0r = cr; h0i = ci;
                float pr = abr, pi = abi;
#pragma unroll
                for (int i = 0; i < 8; ++i) { const int t = o * 8 + i;
                    const float vr = hr[i] + pr * mr - pi * mi, vi = hi[i] + pr * mi + pi * mr;
                    *(LAS bf16_t*)(HB + t * HS + n * 2) = f2bf(vr); *(LAS bf16_t*)(HB + t * HS + (64 + n) * 2) = f2bf(vi);
                    const float qr = pr * abr - pi * abi, qi = pr * abi + pi * abr; pr = qr; pi = qi; }
            }
            __syncthreads();
            if (wid < 4) { const int tm = wid; f32x4 a = (f32x4){0.f, 0.f, 0.f, 0.f};
                mma_tile<true, 4, HS, HS>(a, HB, tm * 16, CB, 0, fr, fq);
                const int t = tm * 16 + fr; const int lp = c * 64 + t, p = dir ? (L - 1 - lp) : lp;
                u32x2 w; w.x = cvt_pk_bf16(a[0], a[1]); w.y = cvt_pk_bf16(a[2], a[3]);
                __hip_atomic_store((unsigned long long*)(OUT + (size_t)tok_row(seg, b, p, true) * 1024 + 768 + g * 16 + fq * 4), ((unsigned long long)w.y << 32) | w.x, __ATOMIC_RELAXED, __HIP_MEMORY_SCOPE_AGENT); }
        }
    }
    __syncthreads();
}

__device__ __forceinline__ void phase_mixers(CPR P, int l, lds_t lds) {
#pragma unroll 1
    for (int item = blockIdx.x; item < 224; item += gridDim.x) {
        if (item < 32) scan_gla(P, l, item >> 3, (item >> 1) & 3, item & 1, lds);
        else if (item < 64) { const int i = item - 32; scan_ssd(P, l, i >> 3, (i >> 1) & 3, i & 1, lds); }
        else if (item < 96) { const int i = item - 64; scan_mlstm(P, l, i >> 3, (i >> 1) & 3, i & 1, lds); }
        else { const int i = item - 96; scan_s5(P, l, i >> 5, (i >> 1) & 15, i & 1, lds); }
        __syncthreads();
    }
    if ((int)blockIdx.x >= 224 && l + 1 < DEPTH) phase_convert(P, lds, l + 1, 224, (int)gridDim.x - 224);
}

__device__ __forceinline__ void phase_post(CPR P, int l) {
    const int tid_ = opaque_tid(); const int lane = tid_ & 63, wid = tid_ >> 6, c4 = lane * 4;
    bf16_t* H = (bf16_t*)(P.ws + WS_H); const bf16_t* H2 = (const bf16_t*)(P.ws + WS_H2); const bf16_t* PB = (const bf16_t*)(P.ws + WS_PB);
    bf16_t* GB = (bf16_t*)(P.ws + WS_GB);
    const f32x4 gg = *(const f32x4*)(P.in[I_GLAG] + l * 256 + c4), gs = *(const f32x4*)(P.in[I_SSDG] + l * 256 + c4), gm = *(const f32x4*)(P.in[I_MLG] + l * 256 + c4), sd = *(const f32x4*)(P.in[I_S5D] + l * 256 + c4);
    for (int row = blockIdx.x * 8 + wid; row < NT; row += gridDim.x * 8) {
        bf16_t* hrow = H + (size_t)row * 1024; const bf16_t* orow = H2 + (size_t)row * 1024; const bf16_t* pr = PB + (size_t)row * NINP;
        u32x2 f[4], bk[4];
#pragma unroll
        for (int q = 0; q < 4; ++q) { f[q] = *(const u32x2*)(hrow + q * 256 + c4); bk[q] = *(const u32x2*)(orow + q * 256 + c4); }
        const u32x2 rr = *(const u32x2*)(pr + GLA_R + c4), zz = *(const u32x2*)(pr + SSD_Z + c4), oo = *(const u32x2*)(pr + ML_O + c4), pp = *(const u32x2*)(pr + S50 + c4);
        float v[4][4];
#pragma unroll
        for (int q = 0; q < 4; ++q) { v[q][0] = bflo(f[q].x) + bflo(bk[q].x); v[q][1] = bfhi(f[q].x) + bfhi(bk[q].x); v[q][2] = bflo(f[q].y) + bflo(bk[q].y); v[q][3] = bfhi(f[q].y) + bfhi(bk[q].y); }
        const float rv[4] = {bflo(rr.x), bfhi(rr.x), bflo(rr.y), bfhi(rr.y)}, zv[4] = {bflo(zz.x), bfhi(zz.x), bflo(zz.y), bfhi(zz.y)};
        const float ov[4] = {bflo(oo.x), bfhi(oo.x), bflo(oo.y), bfhi(oo.y)}, pv[4] = {bflo(pp.x), bfhi(pp.x), bflo(pp.y), bfhi(pp.y)};
        float ss = v[0][0] * v[0][0] + v[0][1] * v[0][1] + v[0][2] * v[0][2] + v[0][3] * v[0][3];
        ss = row16_sum(ss);
        float rs = rsqrtf(ss * (1.0f / 64.0f) + EPS);
        { u32x2 w; w.x = cvt_pk_bf16(v[0][0] * rs * gg[0] * siluf_(rv[0]), v[0][1] * rs * gg[1] * siluf_(rv[1])); w.y = cvt_pk_bf16(v[0][2] * rs * gg[2] * siluf_(rv[2]), v[0][3] * rs * gg[3] * siluf_(rv[3]));
          *(u32x2*)(hrow + c4) = w; }
        float y[4];
#pragma unroll
        for (int i = 0; i < 4; ++i) y[i] = v[1][i] * siluf_(zv[i]);
        ss = y[0] * y[0] + y[1] * y[1] + y[2] * y[2] + y[3] * y[3];
        ss = wave_sum(ss);
        rs = rsqrtf(ss * (1.0f / 256.0f) + EPS);
        { u32x2 w; w.x = cvt_pk_bf16(y[0] * rs * gs[0], y[1] * rs * gs[1]); w.y = cvt_pk_bf16(y[2] * rs * gs[2], y[3] * rs * gs[3]); *(u32x2*)(hrow + 256 + c4) = w; }
        ss = v[2][0] * v[2][0] + v[2][1] * v[2][1] + v[2][2] * v[2][2] + v[2][3] * v[2][3];
        ss = row16_sum(ss);
        rs = rsqrtf(ss * (1.0f / 64.0f) + EPS);
        { u32x2 w; w.x = cvt_pk_bf16(v[2][0] * rs * gm[0] * sigmoidf_(ov[0]), v[2][1] * rs * gm[1] * sigmoidf_(ov[1])); w.y = cvt_pk_bf16(v[2][2] * rs * gm[2] * sigmoidf_(ov[2]), v[2][3] * rs * gm[3] * sigmoidf_(ov[3]));
          *(u32x2*)(hrow + 512 + c4) = w; }
        { u32x2 w; w.x = cvt_pk_bf16(geluf_(v[3][0] + sd[0] * pv[0]), geluf_(v[3][1] + sd[1] * pv[1])); w.y = cvt_pk_bf16(geluf_(v[3][2] + sd[2] * pv[2]), geluf_(v[3][3] + sd[3] * pv[3]));
          *(u32x2*)(GB + (size_t)row * 256 + c4) = w; }
    }
}

#define XB_TMO      128
#define XB_XCNT(j)  (256  + 64 * (j))
#define XB_XSUB(j)  (1280 + 64 * (j))
#define XB_XGEN(j)  (2304 + 64 * (j))
#define XB_TOP      3328
#define XB_TOPGEN   3392
#define XCD_BAR_WORDS 3456
#define XB_SPIN_CAP (1u << 22)
__device__ __forceinline__ unsigned xb_ld(unsigned* p)              { return __hip_atomic_load(p, __ATOMIC_RELAXED, __HIP_MEMORY_SCOPE_AGENT); }
__device__ __forceinline__ unsigned xb_add(unsigned* p, unsigned v) { return __hip_atomic_fetch_add(p, v, __ATOMIC_RELAXED, __HIP_MEMORY_SCOPE_AGENT); }
__device__ __forceinline__ unsigned xb_xcc_id() { return (unsigned)__builtin_amdgcn_s_getreg((3 << 11) | 20) & 0xFu; }
#define XB_SPIN(cond, bar) do { unsigned _sp = 0; while (cond) { __builtin_amdgcn_s_sleep(1); \
    if ((++_sp & 255u) == 0u) { if (xb_ld(&(bar)[XB_TMO])) break; if (_sp > XB_SPIN_CAP) { atomicAdd(&(bar)[XB_TMO], 1u); break; } } } } while (0)
struct XcdBarrier { unsigned* bar; unsigned x; volatile LAS unsigned* st; };
__device__ __forceinline__ XcdBarrier xcd_barrier_post(unsigned* bar, volatile LAS unsigned* st) {
    XcdBarrier b; b.bar = bar; b.x = xb_xcc_id(); b.st = st;
    if (threadIdx.x == 0) (void)xb_add(&bar[XB_XCNT(b.x)], 1u);
    return b;
}
__device__ __forceinline__ void xcd_barrier_complete(unsigned* bar, unsigned x, unsigned& nloc, unsigned& nx) {
    const unsigned G = gridDim.x * gridDim.y * gridDim.z;
    unsigned sum, cnt, mine, sp = 0u;
    for (;;) {
        sum = 0u; cnt = 0u; mine = 0u;
#pragma unroll
        for (unsigned j = 0; j < 16; ++j) { const unsigned c = xb_ld(&bar[XB_XCNT(j)]); sum += c; cnt += (c > 0u) ? 1u : 0u; mine = (j == x) ? c : mine; }
        if (sum == G) break;
        __builtin_amdgcn_s_sleep(1);
        if ((++sp & 255u) == 0u) { if (xb_ld(&bar[XB_TMO])) break; if (sp > XB_SPIN_CAP) { atomicAdd(&bar[XB_TMO], 1u); break; } }
    }
    nloc = mine > 0u ? mine : 1u; nx = cnt > 0u ? cnt : 1u;
}
__device__ __forceinline__ void xcd_barrier(const XcdBarrier& b) {
    asm volatile("s_waitcnt vmcnt(0)" ::: "memory");
    __syncthreads();
    if (threadIdx.x == 0) {
        unsigned* bar = b.bar;
        __builtin_amdgcn_s_waitcnt(0);
        unsigned nloc = b.st[0], nx = b.st[1];
        if (nloc == 0u) { xcd_barrier_complete(bar, b.x, nloc, nx); b.st[0] = nloc; b.st[1] = nx; }
        const unsigned old = xb_add(&bar[XB_XSUB(b.x)], 1u);
        const unsigned gen = old / nloc;
        if (old + 1u == (gen + 1u) * nloc) {
            __builtin_amdgcn_fence(__ATOMIC_RELEASE, "agent");
            asm volatile("s_waitcnt vmcnt(0)" ::: "memory");
            const unsigned og = xb_add(&bar[XB_TOP], 1u);
            const unsigned tg = og / nx;
            if (og + 1u == (tg + 1u) * nx) xb_add(&bar[XB_TOPGEN], 1u);
            else XB_SPIN(xb_ld(&bar[XB_TOPGEN]) == tg, bar);
            __builtin_amdgcn_fence(__ATOMIC_ACQUIRE, "agent");
            xb_add(&bar[XB_XGEN(b.x)], 1u);
            asm volatile("s_waitcnt vmcnt(0)" ::: "memory");
        } else {
            XB_SPIN(xb_ld(&bar[XB_XGEN(b.x)]) == gen, bar);
            __builtin_amdgcn_fence(__ATOMIC_ACQUIRE, "agent");
            asm volatile("s_waitcnt vmcnt(0)" ::: "memory");
        }
    }
    __syncthreads();
}
__device__ __forceinline__ void gsync(cg::grid_group& grid) {
    asm volatile("s_waitcnt vmcnt(0) lgkmcnt(0)" ::: "memory");
    __builtin_amdgcn_fence(__ATOMIC_RELEASE, "agent");
    asm volatile("s_waitcnt vmcnt(0)" ::: "memory");
    grid.sync();
    __builtin_amdgcn_fence(__ATOMIC_ACQUIRE, "agent");
    asm volatile("s_waitcnt vmcnt(0)" ::: "memory");
    __syncthreads();
}
__global__ void __launch_bounds__(512, 2) fwd_megakernel(Params Pk) {
    extern __shared__ __attribute__((aligned(16))) unsigned char smem[];
    lds_t lds = (lds_t)smem;
    cg::grid_group grid = cg::this_grid();
    volatile LAS unsigned* xst = (volatile LAS unsigned*)(lds + 139264);
    if (threadIdx.x == 0) { xst[0] = 0u; xst[1] = 0u; xst[2] = 0u; xst[3] = 0u; }
    __syncthreads();
    const XcdBarrier xb = xcd_barrier_post((unsigned*)(getP()->ws + WS_BAR), xst);
    phase_mods(*getP(), lds);
    phase_convert(*getP(), lds, 0, 0, (int)gridDim.x);
    xcd_barrier(xb);
    if (getP()->ws == nullptr) gsync(grid);
#pragma unroll 1
    for (int l = 0; l < DEPTH; ++l) {
#pragma unroll 1
        for (int j = 0; j < 3; ++j) {
            phase_modnorm(*getP(), l, j, l == 0 && j == 0);
            xcd_barrier(xb);
            CPR P = *getP();
            bf16_t* H = (bf16_t*)(P.ws + WS_H); bf16_t* PBp = (bf16_t*)(P.ws + WS_PB);
            const float* mods_l = (const float*)(P.ws + WS_MODS) + (size_t)l * 5 * 9216;
            pg8::Gemm g2;
            if (j != 1) {
                const int s = j >> 1;
                pg8::Gemm g; g.A = H; g.Bt = (const bf16_t*)(P.ws + WS_WFI) + (size_t)(l * 2 + s) * 5632 * 1024; g.M = NT; g.N = 5632; g.K = 1024; g.lda = 1024; g.ldb = 1024;
                pg8::StaticOrder S; S.init(g.M, g.N, (int)gridDim.x, (int)blockIdx.x);
                EpiSwiGLU E; E.O = PBp;
                pg8::gemm_phase(lds, g, S, E);
                xcd_barrier(xb);
                g2.A = PBp; g2.Bt = (const bf16_t*)(P.ws + WS_WFO) + (size_t)(l * 2 + s) * 1024 * DFF; g2.M = NLAT; g2.N = 1024; g2.K = DFF; g2.lda = DFF; g2.ldb = DFF;
            } else {
                {
                    pg8::Gemm g; g.A = H; g.Bt = (const bf16_t*)(P.ws + WS_WIN) + (size_t)l * NINP * 1024; g.M = NT; g.N = NINP; g.K = 1024; g.lda = 1024; g.ldb = 1024;
                    pg8::StaticOrder S; S.init(g.M, g.N, (int)gridDim.x, (int)blockIdx.x);
                    EpiInProj E; E.Pb = PBp; E.Pg = (float*)(P.ws + WS_PG);
                    pg8::gemm_phase(lds, g, S, E);
                }
                xcd_barrier(xb);
                phase_mixers(*getP(), l, lds);
                xcd_barrier(xb);
                phase_post(*getP(), l);
                xcd_barrier(xb);
                {
                    pg8::Gemm g; g.A = (const bf16_t*)(P.ws + WS_GB); g.Bt = (const bf16_t*)(P.ws + WS_WGLU) + (size_t)l * 256 * 256; g.M = NT; g.N = 256; g.K = 256; g.lda = 256; g.ldb = 256;
                    pg8::StaticOrder S; S.init(g.M, g.N, (int)gridDim.x, (int)blockIdx.x);
                    EpiGLU E; E.G = (const bf16_t*)(P.ws + WS_GB); E.bglu = P.in[I_S5BGLU] + l * 256; E.O = H;
                    pg8::gemm_phase(lds, g, S, E);
                }
                xcd_barrier(xb);
                g2.A = H; g2.Bt = (const bf16_t*)(P.ws + WS_WOUT) + (size_t)l * 1024 * 1024; g2.M = NLAT; g2.N = 1024; g2.K = 1024; g2.lda = 1024; g2.ldb = 1024;
            }
            {
                pg8::StaticOrder S; S.init(g2.M, g2.N, (int)gridDim.x, (int)blockIdx.x);
                EpiResid E; E.xlat = P.out; E.xctx = (float*)(P.ws + WS_CTXX); E.gate_l = mods_l + (3 * j + 2) * 1024; E.coef = (j == 1) ? 1.0f : 0.5f;
                pg8::gemm_phase(lds, g2, S, E);
                pg8::Gemm g3 = g2; g3.A = g2.A + (size_t)NLAT * g2.lda; g3.M = NCTX; g3.K = 256;
                pg8::SplitKOrder S3; S3.init(g3.M, g3.N, g2.K / 256, (int)gridDim.x, (int)blockIdx.x);
                EpiSlab E3; E3.slab = (float*)(P.ws + WS_SLAB);
                pg8::gemm_phase(lds, g3, S3, E3);
            }
            xcd_barrier(xb);
        }
    }
    phase_final(*getP());
}

extern "C" void kernel_launch(void* const* d_in, const int* in_sizes, int n_in, void* d_out, int out_size, void* d_ws, size_t ws_size, hipStream_t stream) {
    constexpr int LDS_BYTES = 139264 + 64;
    static int grid = 0;
    if (grid == 0) {
        if (n_in != 35 || ws_size < WS_END) { fprintf(stderr, "kernel_launch: expected 35 inputs and >= %zu bytes of workspace; got %d, %zu\n", (size_t)WS_END, n_in, ws_size); grid = -1; return; }
        int dev = 0, cus = 0, per_cu = 0;
        hipGetDevice(&dev);
        hipDeviceGetAttribute(&cus, hipDeviceAttributeMultiprocessorCount, dev);
        if (hipFuncSetAttribute((const void*)fwd_megakernel, hipFuncAttributeMaxDynamicSharedMemorySize, LDS_BYTES) != hipSuccess) { fprintf(stderr, "kernel_launch: hipFuncSetAttribute failed\n"); grid = -1; return; }
        if (hipOccupancyMaxActiveBlocksPerMultiprocessor(&per_cu, (const void*)fwd_megakernel, 512, LDS_BYTES) != hipSuccess || per_cu < 1) { fprintf(stderr, "kernel_launch: occupancy query says %d blocks per CU\n", per_cu); per_cu = 1; }
        (void)hipGetLastError();
        grid = cus;
    }
    if (grid < 0) return;
    Params p{};
    for (int i = 0; i < 35; ++i) p.in[i] = (const float*)d_in[i];
    p.out = (float*)d_out; p.ws = (unsigned char*)d_ws;
    if (hipMemsetAsync((char*)d_ws + WS_BAR, 0, SZ_BAR, stream) != hipSuccess) { fprintf(stderr, "kernel_launch: memset of the barrier words failed\n"); return; }
    void* args[] = {&p};
    hipError_t e = hipLaunchCooperativeKernel((const void*)fwd_megakernel, dim3(grid), dim3(512), args, LDS_BYTES, stream);
    if (e != hipSuccess) fprintf(stderr, "cooperative launch failed: %s (grid %d)\n", hipGetErrorString(e), grid);
}
```

```cpp
#include <hip/hip_runtime.h>
#include <hip/hip_cooperative_groups.h>
#include <cstdio>
namespace cg = cooperative_groups;

#define LAS __attribute__((address_space(3)))
typedef unsigned short bf16_t;
typedef short bf16x8 __attribute__((ext_vector_type(8)));
typedef float f32x4 __attribute__((ext_vector_type(4)));
typedef unsigned u32x4 __attribute__((ext_vector_type(4)));
typedef unsigned u32x2 __attribute__((ext_vector_type(2)));
typedef LAS unsigned char* lds_t;

constexpr int DM = 1024, NB = 4, SEQ = 8192, DEPTH = 4, CTXL = 256;
constexpr int NLAT = NB * SEQ, NCTX = NB * CTXL, NT = NLAT + NCTX;
constexpr int DFF = 2816, NIN = 3128, NINP = 3328;
constexpr int GLA_Q = 0, GLA_K = 256, GLA_V = 512, GLA_R = 768;
constexpr int SSD_X = 1056, SSD_B = 1312, SSD_C = 1440, SSD_Z = 1568;
constexpr int ML_Q = 1832, ML_V = 2344, ML_O = 2600;
constexpr int S50 = 2872;
constexpr int PGW = 96;
constexpr float EPS = 1e-6f;

constexpr size_t SZ_WFI = (size_t)DEPTH * 2 * 5632 * 1024 * 2;
constexpr size_t SZ_WFO = (size_t)DEPTH * 2 * 1024 * 2816 * 2;
constexpr size_t SZ_WIN = (size_t)DEPTH * NINP * 1024 * 2;
constexpr size_t SZ_WOUT = (size_t)DEPTH * 1024 * 1024 * 2;
constexpr size_t SZ_WGLU = (size_t)DEPTH * 256 * 256 * 2;
constexpr size_t SZ_MODS = (size_t)DEPTH * 5 * 9216 * 4;
constexpr size_t SZ_CTXX = (size_t)NCTX * 1024 * 4;
constexpr size_t SZ_H = (size_t)NT * 1024 * 2;
constexpr size_t SZ_PB = (size_t)NT * NINP * 2;
constexpr size_t SZ_PG = (size_t)NT * PGW * 4;
constexpr size_t SZ_GB = (size_t)NT * 256 * 2;
constexpr size_t WS_WFI = 0;
constexpr size_t WS_WFO = WS_WFI + SZ_WFI;
constexpr size_t WS_WIN = WS_WFO + SZ_WFO;
constexpr size_t WS_WOUT = WS_WIN + SZ_WIN;
constexpr size_t WS_WGLU = WS_WOUT + SZ_WOUT;
constexpr size_t WS_MODS = WS_WGLU + SZ_WGLU;
constexpr size_t WS_CTXX = WS_MODS + SZ_MODS;
constexpr size_t WS_H = WS_CTXX + SZ_CTXX;
constexpr size_t WS_H2 = WS_H + SZ_H;
constexpr size_t WS_PB = WS_H2 + SZ_H;
constexpr size_t WS_PG = WS_PB + SZ_PB;
constexpr size_t WS_GB = WS_PG + SZ_PG;
constexpr size_t WS_BAR = WS_GB + SZ_GB;
constexpr size_t SZ_BAR = 16384;
constexpr size_t WS_SLAB = WS_BAR + SZ_BAR;
constexpr size_t SZ_SLAB = (size_t)11 * NCTX * 1024 * 4;
constexpr size_t WS_END = WS_SLAB + SZ_SLAB;

struct Params {
    const float* in[35];
    float* out;
    unsigned char* ws;
};
typedef const __attribute__((address_space(4))) Params* cparams_t;
#define CPR const __attribute__((address_space(4))) Params&
__device__ __forceinline__ cparams_t getP() { cparams_t p = (cparams_t)__builtin_amdgcn_kernarg_segment_ptr(); asm volatile("" : "+s"(p)); return p; }
enum { I_X = 0, I_C, I_CTX, I_CCTX, I_WMOD, I_BMOD, I_GNORM, I_FFNWIN, I_FFNWOUT, I_WIN, I_WOUT, I_GLAW, I_GLAB, I_GLAG,
       I_SSDCW, I_SSDCB, I_SSDALOG, I_SSDDTB, I_SSDD, I_SSDG, I_MLCW, I_MLCB, I_MLGB, I_MLG, I_S5ARE, I_S5AIM, I_S5LS,
       I_S5BRE, I_S5BIM, I_S5CRE, I_S5CIM, I_S5D, I_S5WGLU, I_S5BGLU, I_GFINAL };

__device__ __forceinline__ float bf2f(unsigned b) { return __uint_as_float(b << 16); }
typedef __bf16 bf16x2_t __attribute__((ext_vector_type(2)));
typedef float f32x2_t __attribute__((ext_vector_type(2)));
__device__ __forceinline__ unsigned cvt_pk_bf16(float lo, float hi) { const f32x2_t f = {lo, hi}; return __builtin_bit_cast(unsigned, __builtin_convertvector(f, bf16x2_t)); }
__device__ __forceinline__ bf16_t f2bf(float f) { return (bf16_t)(cvt_pk_bf16(f, 0.f) & 0xffffu); }
__device__ __forceinline__ float bflo(unsigned w) { return __uint_as_float(w << 16); }
__device__ __forceinline__ float bfhi(unsigned w) { return __uint_as_float(w & 0xffff0000u); }
__device__ __forceinline__ float sigmoidf_(float x) { return __builtin_amdgcn_rcpf(1.0f + __expf(-x)); }
__device__ __forceinline__ float siluf_(float x) { return x * sigmoidf_(x); }
__device__ __forceinline__ float logsigf_(float x) { return fminf(x, 0.f) - 0.6931471805599453f * __builtin_amdgcn_logf(1.0f + __expf(-fabsf(x)));   }
__device__ __forceinline__ float softplusf_(float x) { return fmaxf(x, 0.f) + 0.6931471805599453f * __builtin_amdgcn_logf(1.0f + __expf(-fabsf(x))); }
__device__ __forceinline__ float geluf_(float x) { const float u = 0.7978845608028654f * (x + 0.044715f * x * x * x); return x * sigmoidf_(2.0f * u); }

__device__ __forceinline__ int tok_row(int seg, int b, int p, bool colmajor) {
    if (seg == 0) return NLAT + b * CTXL + p;
    return b * SEQ + (colmajor ? ((p & 127) * 64 + (p >> 7)) : p);
}

__device__ __forceinline__ int opaque_tid() { int t = threadIdx.x; asm volatile("" : "+v"(t) :: "memory"); return t; }
__device__ __forceinline__ float shfl_idx(float v, int srclane) { return __int_as_float(__builtin_amdgcn_ds_bpermute(srclane << 2, __float_as_int(v))); }
template <bool TRANS, int KSTEPS, int SA, int SB, bool SAFE = false>
__device__ __forceinline__ void mma_tile(f32x4& acc, lds_t As, int arow0, lds_t Bs, int brow0, int fr, int fq) {
#pragma unroll
    for (int kk = 0; kk < KSTEPS; ++kk) {
        const bf16x8 a = *(const LAS bf16x8*)(As + (arow0 + fr) * SA + kk * 64 + fq * 16);
        const bf16x8 b = *(const LAS bf16x8*)(Bs + (brow0 + fr) * SB + kk * 64 + fq * 16);
        if (SAFE) asm volatile("s_waitcnt lgkmcnt(0)" ::: "memory");
        if (TRANS) acc = __builtin_amdgcn_mfma_f32_16x16x32_bf16(b, a, acc, 0, 0, 0);
        else acc = __builtin_amdgcn_mfma_f32_16x16x32_bf16(a, b, acc, 0, 0, 0);
    }
}
constexpr int LDT = 144;

namespace pg8 {
constexpr int BM = 256, BK = 64, HALF = 128, HTB = HALF * BK * 2, STAGE_BYTES = 8 * HTB, NXCD = 8, WGM = 8;
__device__ __forceinline__ int lds_byte(int r, int c) { const int st = (r >> 4) * 2 + (c >> 5), rr = r & 15, cc = c & 31, ob = rr * 64 + cc * 2; return st * 1024 + (ob ^ (((ob >> 9) & 1) << 5)); }
__device__ __forceinline__ void stage_rc(int b, int& R, int& C) { const int st = b / 1024, sb = b % 1024, swz = sb ^ (((sb >> 9) & 1) << 5); R = (st >> 1) * 16 + swz / 64; C = (st & 1) * 32 + (swz % 64) / 2; }
__device__ __forceinline__ int perm32(int rho) { const int n = rho >> 4, i = rho & 15; return 8 * (i >> 2) + 4 * n + (i & 3); }
struct Unit { int pm, pn, ks; };
struct Gemm { const bf16_t* A; const bf16_t* Bt; int M, N, K, lda, ldb; };
struct StaticOrder {
    int nM, nN, nwg, G, c;
    __device__ void init(int M, int N, int G_, int c_) { nM = M / BM; nN = N / BM; nwg = nM * nN; G = G_; c = c_; }
    __device__ bool next(int i, Unit& u) const {
        const long L = (long)i * G + c; if (L >= nwg) return false;
        int wgid = (int)L; { const int q = nwg / NXCD, r = nwg % NXCD, xcd = wgid % NXCD, off = wgid / NXCD; wgid = (xcd < r ? xcd * (q + 1) : r * (q + 1) + (xcd - r) * q) + off; }
        const int nig = WGM * nN, gid = wgid / nig, fm = gid * WGM, gsz = (nM - fm) < WGM ? (nM - fm) : WGM;
        u.pm = fm + ((wgid % nig) % gsz); u.pn = (wgid % nig) / gsz; u.ks = 0; return true;
    }
};
struct SplitKOrder {
    int nN, nks, n, G, c;
    __device__ void init(int M, int N, int nks_, int G_, int c_) { nN = N / BM; nks = nks_; n = (M / BM) * nN * nks; G = G_; c = c_; }
    __device__ bool next(int i, Unit& u) const { const long L = (long)i * G + c; if (L >= n) return false; const int l = (int)L; u.ks = l % nks; const int r = l / nks; u.pn = r % nN; u.pm = r / nN; return true; }
};
template <class Epi, class Sched>
__device__ __forceinline__ void gemm_phase(lds_t lds, const Gemm g, const Sched& S, const Epi& E) {
    const int tid = opaque_tid(), wid = __builtin_amdgcn_readfirstlane(tid >> 6), lane = tid & 63, wr = wid >> 2, wc = wid & 3, fr = lane & 15, fq = lane >> 4;
    const int K = g.K, nt = K / BK;
    unsigned voffA[2], voffB[2];
#pragma unroll
    for (int i = 0; i < 2; ++i) { int R, C; stage_rc(tid * 16 + i * 8192, R, C); const int Rb = Epi::PERM ? ((R & ~31) + perm32(R & 31)) : R;
        voffA[i] = (unsigned)(R * g.lda + C) * 2u; voffB[i] = (unsigned)(Rb * g.ldb + C) * 2u; }
    const size_t kstep = (size_t)(BK * 2);
    const size_t hstepA = (size_t)HALF * g.lda * 2, hstepB = (size_t)HALF * g.ldb * 2;
    const size_t tstepA = 2 * hstepA, tstepB = 2 * hstepB, kslice = (size_t)K * 2;
    const unsigned ldsw = (unsigned)wid * 1024u;
    const int aoff = lds_byte(wr * 64 + fr, fq * 8), boff = lds_byte(wc * 32 + fr, fq * 8);
#define PG8_SA(b, h) (((b) * 2 + (h)) * HTB)
#define PG8_SB(b, h) ((4 + (b) * 2 + (h)) * HTB)
#define PG8_STAGE(bufoff, gbase, voff) do { _Pragma("unroll") for (int _i = 0; _i < 2; ++_i) \
        __builtin_amdgcn_global_load_lds((const unsigned*)((const char*)(gbase) + (voff)[_i]), (LAS unsigned*)(lds + (bufoff) + ldsw + _i * 8192), 16, 0, 0); } while (0)
#define PG8_LDA(dst, b, h) do { _Pragma("unroll") for (int m = 0; m < 4; ++m) _Pragma("unroll") for (int k = 0; k < 2; ++k) dst[m][k] = *(const LAS bf16x8*)(lds + PG8_SA(b, h) + aoff + m * 2048 + k * 1024); } while (0)
#define PG8_LDB(dst, b, h) do { _Pragma("unroll") for (int n = 0; n < 2; ++n) _Pragma("unroll") for (int k = 0; k < 2; ++k) dst[n][k] = *(const LAS bf16x8*)(lds + PG8_SB(b, h) + boff + n * 2048 + k * 1024); } while (0)
#define PG8_MMA(ai, bj, At, Bt) do { __builtin_amdgcn_s_setprio(1); _Pragma("unroll") for (int m = 0; m < 4; ++m) _Pragma("unroll") for (int n = 0; n < 2; ++n) _Pragma("unroll") for (int k = 0; k < 2; ++k) \
        acc[ai][bj][m][n] = __builtin_amdgcn_mfma_f32_16x16x32_bf16(Bt[n][k], At[m][k], acc[ai][bj][m][n], 0, 0, 0); __builtin_amdgcn_s_setprio(0); } while (0)
#define PG8_WAIT_V(n) asm volatile("s_waitcnt vmcnt(" #n ")" ::: "memory")
#define PG8_WAIT_L(n) asm volatile("s_waitcnt lgkmcnt(" #n ")" ::: "memory")
#define PG8_BAR __builtin_amdgcn_s_barrier()
#define PG8_SCHED __builtin_amdgcn_sched_barrier(0)
    Unit cur, nxt; int ui = 0;
    if (!S.next(0, cur)) return;
    f32x4 acc[2][2][4][2];
#pragma unroll
    for (int a = 0; a < 2; ++a)
#pragma unroll
        for (int b = 0; b < 2; ++b)
#pragma unroll
            for (int m = 0; m < 4; ++m)
#pragma unroll
                for (int n = 0; n < 2; ++n) acc[a][b][m][n] = (f32x4){0.f, 0.f, 0.f, 0.f};
    bf16x8 At[4][2], B0[2][2], B1[2][2];
    const char* cA = (const char*)g.A + (size_t)cur.pm * tstepA + (size_t)cur.ks * kslice; const char* cB = (const char*)g.Bt + (size_t)cur.pn * tstepB + (size_t)cur.ks * kslice;
    PG8_STAGE(PG8_SB(0, 0), cB, voffB); PG8_STAGE(PG8_SA(0, 0), cA, voffA); PG8_STAGE(PG8_SB(0, 1), cB + hstepB, voffB); PG8_STAGE(PG8_SA(0, 1), cA + hstepA, voffA);
    if (wr == 1) PG8_BAR;
    PG8_WAIT_V(4); PG8_BAR;
    PG8_STAGE(PG8_SB(1, 0), cB + kstep, voffB); PG8_STAGE(PG8_SA(1, 0), cA + kstep, voffA); PG8_STAGE(PG8_SB(1, 1), cB + hstepB + kstep, voffB);
    PG8_WAIT_V(6); PG8_BAR;
    for (;;) {
        const bool has_next = S.next(ui + 1, nxt);
        const char* nA = has_next ? (const char*)g.A + (size_t)nxt.pm * tstepA + (size_t)nxt.ks * kslice : cA; const char* nB = has_next ? (const char*)g.Bt + (size_t)nxt.pn * tstepB + (size_t)nxt.ks * kslice : cB;
        for (int t = 0; t < nt; t += 2) {
            const bool last = (t == nt - 2);
            const char* a1 = cA + (size_t)(t + 1) * kstep;
            const char* a2 = last ? nA : cA + (size_t)(t + 2) * kstep; const char* b2 = last ? nB : cB + (size_t)(t + 2) * kstep;
            const char* a3 = a2 + kstep; const char* b3 = b2 + kstep;
            PG8_LDB(B0, 0, 0); PG8_SCHED; PG8_LDA(At, 0, 0); PG8_STAGE(PG8_SA(1, 1), a1 + hstepA, voffA);
            PG8_WAIT_L(8); PG8_BAR; PG8_WAIT_L(0); PG8_MMA(0, 0, At, B0); PG8_BAR; PG8_SCHED;
            PG8_LDB(B1, 0, 1); PG8_STAGE(PG8_SB(0, 0), b2, voffB);
            PG8_BAR; PG8_WAIT_L(0); PG8_MMA(0, 1, At, B1); PG8_BAR;
            PG8_LDA(At, 0, 1); PG8_STAGE(PG8_SA(0, 0), a2, voffA);
            PG8_BAR; PG8_WAIT_L(0); PG8_MMA(1, 0, At, B0); PG8_BAR; PG8_SCHED;
            PG8_STAGE(PG8_SB(0, 1), b2 + hstepB, voffB);
            PG8_WAIT_V(6); PG8_BAR; PG8_MMA(1, 1, At, B1); PG8_BAR;
            PG8_LDB(B0, 1, 0); PG8_SCHED; PG8_LDA(At, 1, 0); PG8_STAGE(PG8_SA(0, 1), a2 + hstepA, voffA);
            PG8_WAIT_L(8); PG8_BAR; PG8_WAIT_L(0); PG8_MMA(0, 0, At, B0); PG8_BAR; PG8_SCHED;
            PG8_LDB(B1, 1, 1); PG8_STAGE(PG8_SB(1, 0), b3, voffB);
            PG8_BAR; PG8_WAIT_L(0); PG8_MMA(0, 1, At, B1); PG8_BAR;
            PG8_LDA(At, 1, 1); PG8_STAGE(PG8_SA(1, 0), a3, voffA);
            PG8_BAR; PG8_WAIT_L(0); PG8_MMA(1, 0, At, B0); PG8_BAR; PG8_SCHED;
            PG8_STAGE(PG8_SB(1, 1), b3 + hstepB, voffB);
            PG8_WAIT_V(6); PG8_BAR; PG8_MMA(1, 1, At, B1); PG8_BAR;
        }
        { const int t2 = opaque_tid(); E(acc, cur, wr, wc, t2 & 15, (t2 & 63) >> 4); }
        if (!has_next) break;
#pragma unroll
        for (int a = 0; a < 2; ++a)
#pragma unroll
            for (int b = 0; b < 2; ++b)
#pragma unroll
                for (int m = 0; m < 4; ++m)
#pragma unroll
                    for (int n = 0; n < 2; ++n) acc[a][b][m][n] = (f32x4){0.f, 0.f, 0.f, 0.f};
        cur = nxt; cA = nA; cB = nB; ++ui;
    }
    PG8_WAIT_V(0);
    if (wr == 0) PG8_BAR;
    PG8_BAR;
#undef PG8_SA
#undef PG8_SB
#undef PG8_STAGE
#undef PG8_LDA
#undef PG8_LDB
#undef PG8_MMA
#undef PG8_WAIT_V
#undef PG8_WAIT_L
#undef PG8_BAR
#undef PG8_SCHED
}
}
using pg8::Unit;

struct EpiSwiGLU {
    static constexpr bool PERM = true;
    bf16_t* O;
    __device__ __forceinline__ void operator()(const f32x4 (&acc)[2][2][4][2], const Unit& u, int wr, int wc, int fr, int fq) const {
        const int row0 = u.pm * 256 + wr * 64 + fr, col0 = u.pn * 128 + wc * 32 + 8 * fq;
#pragma unroll
        for (int ai = 0; ai < 2; ++ai)
#pragma unroll
            for (int m = 0; m < 4; ++m) {
                bf16_t* rowp = O + (size_t)(row0 + ai * 128 + m * 16) * DFF + col0;
                const f32x4 g0 = acc[ai][0][m][0], g1 = acc[ai][0][m][1], u0 = acc[ai][1][m][0], u1 = acc[ai][1][m][1];
                u32x4 w;
                w.x = cvt_pk_bf16(siluf_(g0[0]) * u0[0], siluf_(g0[1]) * u0[1]);
                w.y = cvt_pk_bf16(siluf_(g0[2]) * u0[2], siluf_(g0[3]) * u0[3]);
                w.z = cvt_pk_bf16(siluf_(g1[0]) * u1[0], siluf_(g1[1]) * u1[1]);
                w.w = cvt_pk_bf16(siluf_(g1[2]) * u1[2], siluf_(g1[3]) * u1[3]);
                *(u32x4*)rowp = w;
                asm volatile("" ::: "memory");
            }
    }
};
struct EpiResid {
    static constexpr bool PERM = false;
    float* xlat; float* xctx; const float* gate_l; float coef;
    __device__ __forceinline__ void operator()(const f32x4 (&acc)[2][2][4][2], const Unit& u, int wr, int wc, int fr, int fq) const {
        float* base; int mod;
        if (u.pm < 128) { base = xlat + (size_t)u.pm * 256 * 1024; mod = u.pm >> 5; } else { base = xctx + (size_t)(u.pm - 128) * 256 * 1024; mod = 4; }
        const int col0 = u.pn * 256 + wc * 32 + 4 * fq;
        const float* gp = gate_l + mod * 9216 + col0;
        float* rbase = base + (size_t)(wr * 64 + fr) * 1024 + col0;
#pragma unroll
        for (int bj = 0; bj < 2; ++bj) {
            f32x4 xv[2][2][4];
#pragma unroll
            for (int n = 0; n < 2; ++n)
#pragma unroll
                for (int ai = 0; ai < 2; ++ai)
#pragma unroll
                    for (int m = 0; m < 4; ++m) xv[n][ai][m] = *(const f32x4*)(rbase + (size_t)(ai * 128 + m * 16) * 1024 + bj * 128 + n * 16);
            const f32x4 gv0 = *(const f32x4*)(gp + bj * 128) * coef, gv1 = *(const f32x4*)(gp + bj * 128 + 16) * coef;
#pragma unroll
            for (int n = 0; n < 2; ++n)
#pragma unroll
                for (int ai = 0; ai < 2; ++ai)
#pragma unroll
                    for (int m = 0; m < 4; ++m)
                        *(f32x4*)(rbase + (size_t)(ai * 128 + m * 16) * 1024 + bj * 128 + n * 16) = xv[n][ai][m] + (n == 0 ? gv0 : gv1) * acc[ai][bj][m][n];
            asm volatile("" ::: "memory");
        }
    }
};
struct EpiSlab {
    static constexpr bool PERM = false;
    float* slab;
    __device__ __forceinline__ void operator()(const f32x4 (&acc)[2][2][4][2], const Unit& u, int wr, int wc, int fr, int fq) const {
        float* base = slab + ((size_t)u.ks * NCTX + (size_t)u.pm * 256) * 1024;
        const int col0 = u.pn * 256 + wc * 32 + 4 * fq;
#pragma unroll
        for (int ai = 0; ai < 2; ++ai)
#pragma unroll
            for (int m = 0; m < 4; ++m) {
                float* rowp = base + (size_t)(wr * 64 + fr + ai * 128 + m * 16) * 1024 + col0;
#pragma unroll
                for (int bj = 0; bj < 2; ++bj)
#pragma unroll
                    for (int n = 0; n < 2; ++n) *(f32x4*)(rowp + bj * 128 + n * 16) = acc[ai][bj][m][n];
                asm volatile("" ::: "memory");
            }
    }
};
struct EpiInProj {
    static constexpr bool PERM = true;
    bf16_t* Pb; float* Pg;
    __device__ __forceinline__ void operator()(const f32x4 (&acc)[2][2][4][2], const Unit& u, int wr, int wc, int fr, int fq) const {
        const int row0 = u.pm * 256 + wr * 64 + fr;
#pragma unroll
        for (int bj = 0; bj < 2; ++bj) {
            const int c0 = u.pn * 256 + bj * 128 + wc * 32 + 8 * fq;
            int gi = -1;
            if (c0 >= 1024 && c0 < 1056) gi = c0 - 1024; else if (c0 >= 1824 && c0 < 1832) gi = 32 + c0 - 1824; else if (c0 >= 2856 && c0 < 2872) gi = 64 + c0 - 2856;
#pragma unroll
            for (int ai = 0; ai < 2; ++ai)
#pragma unroll
                for (int m = 0; m < 4; ++m) {
                    const size_t row = (size_t)(row0 + ai * 128 + m * 16);
                    const f32x4 v0 = acc[ai][bj][m][0], v1 = acc[ai][bj][m][1];
                    u32x4 w; w.x = cvt_pk_bf16(v0[0], v0[1]); w.y = cvt_pk_bf16(v0[2], v0[3]); w.z = cvt_pk_bf16(v1[0], v1[1]); w.w = cvt_pk_bf16(v1[2], v1[3]);
                    *(u32x4*)(Pb + row * NINP + c0) = w;
                    if (gi >= 0) { *(f32x4*)(Pg + row * PGW + gi) = v0; *(f32x4*)(Pg + row * PGW + gi + 4) = v1; }
                    asm volatile("" ::: "memory");
                }
        }
    }
};
struct EpiGLU {
    static constexpr bool PERM = true;
    const bf16_t* G; const float* bglu; bf16_t* O;
    __device__ __forceinline__ void operator()(const f32x4 (&acc)[2][2][4][2], const Unit& u, int wr, int wc, int fr, int fq) const {
        const int row0 = u.pm * 256 + wr * 64 + fr;
#pragma unroll
        for (int bj = 0; bj < 2; ++bj) {
            const int c0 = bj * 128 + wc * 32 + 8 * fq;
            const f32x4 bb0 = *(const f32x4*)(bglu + c0), bb1 = *(const f32x4*)(bglu + c0 + 4);
            u32x4 gw[2][4];
#pragma unroll
            for (int ai = 0; ai < 2; ++ai)
#pragma unroll
                for (int m = 0; m < 4; ++m) gw[ai][m] = *(const u32x4*)(G + (size_t)(row0 + ai * 128 + m * 16) * 256 + c0);
#pragma unroll
            for (int ai = 0; ai < 2; ++ai)
#pragma unroll
                for (int m = 0; m < 4; ++m) {
                    const size_t row = (size_t)(row0 + ai * 128 + m * 16);
                    const f32x4 v0 = acc[ai][bj][m][0] + bb0, v1 = acc[ai][bj][m][1] + bb1; const u32x4 g4 = gw[ai][m];
                    u32x4 w;
                    w.x = cvt_pk_bf16(bflo(g4.x) * sigmoidf_(v0[0]), bfhi(g4.x) * sigmoidf_(v0[1]));
                    w.y = cvt_pk_bf16(bflo(g4.y) * sigmoidf_(v0[2]), bfhi(g4.y) * sigmoidf_(v0[3]));
                    w.z = cvt_pk_bf16(bflo(g4.z) * sigmoidf_(v1[0]), bfhi(g4.z) * sigmoidf_(v1[1]));
                    w.w = cvt_pk_bf16(bflo(g4.w) * sigmoidf_(v1[2]), bfhi(g4.w) * sigmoidf_(v1[3]));
                    *(u32x4*)(O + row * 1024 + 768 + c0) = w;
                }
            asm volatile("" ::: "memory");
        }
    }
};

__device__ __forceinline__ void phase_mods(CPR P, lds_t lds) {
    const int tid = opaque_tid();
    LAS float* sc = (LAS float*)lds;
    LAS float* red = sc + 5120;
    const float* c = P.in[I_C]; const float* cc = P.in[I_CCTX]; const float* wmod = P.in[I_WMOD]; const float* bmod = P.in[I_BMOD];
    float* mods = (float*)(P.ws + WS_MODS);
    for (int i = tid; i < 5120; i += 512) { const int v = i >> 10, k = i & 1023; const float x = v < 4 ? c[v * 1024 + k] : cc[k]; sc[i] = siluf_(x); }
    __syncthreads();
    for (int item = blockIdx.x; item < 288; item += gridDim.x) {
        const int l = item / 72, col0 = (item % 72) * 128, c4 = (tid & 31) * 4, kg = tid >> 5;
        f32x4 acc[5];
#pragma unroll
        for (int v = 0; v < 5; ++v) acc[v] = (f32x4){0.f, 0.f, 0.f, 0.f};
        const float* wp = wmod + ((size_t)l * 1024 + kg * 64) * 9216 + col0 + c4;
#pragma unroll 8
        for (int kk = 0; kk < 64; ++kk) {
            const f32x4 w = *(const f32x4*)(wp + (size_t)kk * 9216);
#pragma unroll
            for (int v = 0; v < 5; ++v) { const float s = sc[v * 1024 + kg * 64 + kk]; acc[v] += w * s; }
        }
#pragma unroll
        for (int v = 0; v < 5; ++v) *(LAS f32x4*)(red + (kg * 5 + v) * 128 + c4) = acc[v];
        __syncthreads();
        for (int o = tid; o < 640; o += 512) {
            const int v = o >> 7, cx = o & 127; float s = 0.f;
#pragma unroll
            for (int k2 = 0; k2 < 16; ++k2) s += red[(k2 * 5 + v) * 128 + cx];
            mods[(size_t)(l * 5 + v) * 9216 + col0 + cx] = s + bmod[l * 9216 + col0 + cx];
        }
        __syncthreads();
    }
}

__device__ __forceinline__ void conv_tile(const float* src, int src_ld, int col0, int ncv, int k0, bf16_t* dst, int dst_ld, int drow0, LAS float* tile) {
    const int tid = opaque_tid();
    { const int r = tid >> 4, c4 = (tid & 15) * 4;
#pragma unroll
      for (int i = 0; i < 2; ++i) { const int k = r + 32 * i; f32x4 v = (f32x4){0.f, 0.f, 0.f, 0.f};
          if (c4 < ncv) v = *(const f32x4*)(src + (size_t)(k0 + k) * src_ld + col0 + c4);
          tile[k * 65 + c4 + 0] = v[0]; tile[k * 65 + c4 + 1] = v[1]; tile[k * 65 + c4 + 2] = v[2]; tile[k * 65 + c4 + 3] = v[3]; } }
    __syncthreads();
    { const int n = tid >> 3, k8 = (tid & 7) * 8; u32x4 w;
      w.x = cvt_pk_bf16(tile[(k8 + 0) * 65 + n], tile[(k8 + 1) * 65 + n]); w.y = cvt_pk_bf16(tile[(k8 + 2) * 65 + n], tile[(k8 + 3) * 65 + n]);
      w.z = cvt_pk_bf16(tile[(k8 + 4) * 65 + n], tile[(k8 + 5) * 65 + n]); w.w = cvt_pk_bf16(tile[(k8 + 6) * 65 + n], tile[(k8 + 7) * 65 + n]);
      *(u32x4*)(dst + (size_t)(drow0 + n) * dst_ld + k0 + k8) = w; }
    __syncthreads();
}
__device__ __forceinline__ void phase_convert(CPR P, lds_t lds, int l, int b0, int nb) {
    LAS float* tile = (LAS float*)lds;
    constexpr int PER_LAYER = 2 * 1408 + 2 * 704 + 832 + 256 + 16;
    for (int idx = (int)blockIdx.x - b0; idx < PER_LAYER; idx += nb) {
        int t = idx;
        if (t < 2816) {
            const int s = t / 1408; t %= 1408; const int rt = t >> 4, kt = t & 15, drow0 = rt * 64, t256 = drow0 >> 8, cc = drow0 & 255, j0 = t256 * 128 + (cc & 127);
            const int scol = (cc < 128) ? j0 : DFF + j0;
            conv_tile(P.in[I_FFNWIN] + (size_t)(l * 2 + s) * 1024 * 5632, 5632, scol, 64, kt * 64, (bf16_t*)(P.ws + WS_WFI) + (size_t)(l * 2 + s) * 5632 * 1024, 1024, drow0, tile);
        } else if (t < 4224) {
            t -= 2816; const int s = t / 704; t %= 704; const int rt = t / 44, kt = t % 44;
            conv_tile(P.in[I_FFNWOUT] + (size_t)(l * 2 + s) * DFF * 1024, 1024, rt * 64, 64, kt * 64, (bf16_t*)(P.ws + WS_WFO) + (size_t)(l * 2 + s) * 1024 * DFF, DFF, rt * 64, tile);
        } else if (t < 5056) {
            t -= 4224; const int rt = t >> 4, kt = t & 15;
            conv_tile(P.in[I_WIN] + (size_t)l * 1024 * NIN, NIN, rt * 64, NIN - rt * 64, kt * 64, (bf16_t*)(P.ws + WS_WIN) + (size_t)l * NINP * 1024, 1024, rt * 64, tile);
        } else if (t < 5312) {
            t -= 5056; const int rt = t >> 4, kt = t & 15;
            conv_tile(P.in[I_WOUT] + (size_t)l * 1024 * 1024, 1024, rt * 64, 64, kt * 64, (bf16_t*)(P.ws + WS_WOUT) + (size_t)l * 1024 * 1024, 1024, rt * 64, tile);
        } else {
            t -= 5312; const int rt = t >> 2, kt = t & 3;
            conv_tile(P.in[I_S5WGLU] + (size_t)l * 256 * 256, 256, rt * 64, 64, kt * 64, (bf16_t*)(P.ws + WS_WGLU) + (size_t)l * 256 * 256, 256, rt * 64, tile);
        }
    }
}

template <int CTRL> __device__ __forceinline__ float dpp_mov(float x) { return __int_as_float(__builtin_amdgcn_update_dpp(0, __float_as_int(x), CTRL, 0xf, 0xf, false)); }
__device__ __forceinline__ float wave_scan_add(float x, int lane) {
    const int rl = lane & 15; float t;
    t = dpp_mov<0x111>(x) + x; if (rl >= 1) x = t;
    t = dpp_mov<0x112>(x) + x; if (rl >= 2) x = t;
    t = dpp_mov<0x114>(x) + x; if (rl >= 4) x = t;
    t = dpp_mov<0x118>(x) + x; if (rl >= 8) x = t;
    t = dpp_mov<0x142>(x) + x; if ((lane & 31) >= 16) x = t;
    t = dpp_mov<0x143>(x) + x; if (lane >= 32) x = t;
    return x;
}
__device__ __forceinline__ float wave_scan_max(float x, int lane) {
    const int rl = lane & 15; float t;
    t = fmaxf(dpp_mov<0x111>(x), x); if (rl >= 1) x = t;
    t = fmaxf(dpp_mov<0x112>(x), x); if (rl >= 2) x = t;
    t = fmaxf(dpp_mov<0x114>(x), x); if (rl >= 4) x = t;
    t = fmaxf(dpp_mov<0x118>(x), x); if (rl >= 8) x = t;
    t = fmaxf(dpp_mov<0x142>(x), x); if ((lane & 31) >= 16) x = t;
    t = fmaxf(dpp_mov<0x143>(x), x); if (lane >= 32) x = t;
    return x;
}

__device__ __forceinline__ float row16_sum(float s) { s += dpp_mov<0xB1>(s); s += dpp_mov<0x4E>(s); s += dpp_mov<0x124>(s); s += dpp_mov<0x128>(s); return s; }
__device__ __forceinline__ float wave_sum(float s) { s = row16_sum(s);
    const int si = __float_as_int(s);
    return __int_as_float(__builtin_amdgcn_readlane(si, 0)) + __int_as_float(__builtin_amdgcn_readlane(si, 16)) + __int_as_float(__builtin_amdgcn_readlane(si, 32)) + __int_as_float(__builtin_amdgcn_readlane(si, 48)); }

__device__ __forceinline__ void phase_modnorm(CPR P, int l, int j, bool first) {
    const int jp = (j + 2) % 3, lp = (j == 0) ? l - 1 : l, nks = first ? 0 : (jp == 1 ? 4 : 11); const float coefp = (jp == 1) ? 1.0f : 0.5f;
    const float* slab = (const float*)(P.ws + WS_SLAB);
    const float* gatep = (const float*)(P.ws + WS_MODS) + (size_t)(lp < 0 ? 0 : lp) * 5 * 9216 + 4 * 9216 + (3 * jp + 2) * 1024;
    const int tid_ = opaque_tid(); const int lane = tid_ & 63, wid = tid_ >> 6;
    const float* mods_l = (const float*)(P.ws + WS_MODS) + (size_t)l * 5 * 9216;
    const float* gn = P.in[I_GNORM] + (size_t)(l * 3 + j) * 1024;
    float* xctx = (float*)(P.ws + WS_CTXX);
    bf16_t* H = (bf16_t*)(P.ws + WS_H);
    const float* xlat_src = first ? P.in[I_X] : P.out; const float* xctx_src = first ? P.in[I_CTX] : xctx;
    f32x4 gv[4], sh[4], scl[4], xn[4];
#pragma unroll
    for (int i = 0; i < 4; ++i) { gv[i] = *(const f32x4*)(gn + lane * 4 + 256 * i); sh[i] = gv[i]; scl[i] = gv[i]; xn[i] = gv[i]; }
    const int stride = gridDim.x * 8; int row = blockIdx.x * 8 + wid; int curmod = -1;
#define MN_LOAD(r_) do { const float* s_ = ((r_) < NLAT) ? xlat_src + (size_t)(r_) * 1024 : xctx_src + (size_t)((r_) - NLAT) * 1024; \
        _Pragma("unroll") for (int i_ = 0; i_ < 4; ++i_) xn[i_] = *(const f32x4*)(s_ + lane * 4 + 256 * i_); } while (0)
    if (row < NT) MN_LOAD(row);
    for (; row < NT; row += stride) {
        float* dst; int mod;
        if (row < NLAT) { dst = P.out + (size_t)row * 1024; mod = row >> 13; } else { dst = xctx + (size_t)(row - NLAT) * 1024; mod = 4; }
        f32x4 xv[4];
#pragma unroll
        for (int i = 0; i < 4; ++i) xv[i] = xn[i];
        if (row + stride < NT) MN_LOAD(row + stride);
        if (row >= NLAT && nks > 0) {
#pragma unroll
            for (int i = 0; i < 4; ++i) {
                f32x4 s = (f32x4){0.f, 0.f, 0.f, 0.f};
                for (int ks = 0; ks < nks; ++ks) s += *(const f32x4*)(slab + ((size_t)ks * NCTX + (row - NLAT)) * 1024 + lane * 4 + 256 * i);
                xv[i] += *(const f32x4*)(gatep + lane * 4 + 256 * i) * coefp * s;
                *(f32x4*)(dst + lane * 4 + 256 * i) = xv[i];
            }
        }
        float ss = 0.f;
#pragma unroll
        for (int i = 0; i < 4; ++i) ss += xv[i][0] * xv[i][0] + xv[i][1] * xv[i][1] + xv[i][2] * xv[i][2] + xv[i][3] * xv[i][3];
        if (first) {
#pragma unroll
            for (int i = 0; i < 4; ++i) *(f32x4*)(dst + lane * 4 + 256 * i) = xv[i];
        }
        if (mod != curmod) {
            const float* mp = mods_l + (size_t)mod * 9216 + (3 * j) * 1024;
#pragma unroll
            for (int i = 0; i < 4; ++i) { sh[i] = *(const f32x4*)(mp + lane * 4 + 256 * i); scl[i] = *(const f32x4*)(mp + 1024 + lane * 4 + 256 * i) + 1.0f; }
            curmod = mod;
        }
        const float rstd = rsqrtf(wave_sum(ss) * (1.0f / 1024.0f) + EPS);
#pragma unroll
        for (int i = 0; i < 4; ++i) {
            const f32x4 hv = xv[i] * rstd * gv[i] * scl[i] + sh[i];
            u32x2 w; w.x = cvt_pk_bf16(hv[0], hv[1]); w.y = cvt_pk_bf16(hv[2], hv[3]);
            *(u32x2*)(H + (size_t)row * 1024 + lane * 4 + 256 * i) = w;
        }
    }
#undef MN_LOAD
}
__device__ __forceinline__ void phase_final(CPR P) {
    const int tid_ = opaque_tid(); const int lane = tid_ & 63, wid = tid_ >> 6;
    const float* gn = P.in[I_GFINAL];
    f32x4 gv[4];
#pragma unroll
    for (int i = 0; i < 4; ++i) gv[i] = *(const f32x4*)(gn + lane * 4 + 256 * i);
    for (int row = blockIdx.x * 8 + wid; row < NLAT; row += gridDim.x * 8) {
        float* p = P.out + (size_t)row * 1024;
        f32x4 xv[4]; float ss = 0.f;
#pragma unroll
        for (int i = 0; i < 4; ++i) { xv[i] = *(const f32x4*)(p + lane * 4 + 256 * i); ss += xv[i][0] * xv[i][0] + xv[i][1] * xv[i][1] + xv[i][2] * xv[i][2] + xv[i][3] * xv[i][3]; }
        const float rstd = rsqrtf(wave_sum(ss) * (1.0f / 1024.0f) + EPS);
#pragma unroll
        for (int i = 0; i < 4; ++i) *(f32x4*)(p + lane * 4 + 256 * i) = xv[i] * rstd * gv[i];
    }
}

__device__ __forceinline__ void scan_gla(CPR P, int l, int b, int h, int dir, lds_t lds) {
    const int tid = opaque_tid(), lane = tid & 63, wid = tid >> 6, fr = lane & 15, fq = lane >> 4;
    const bf16_t* PB = (const bf16_t*)(P.ws + WS_PB); const float* PG = (const float*)(P.ws + WS_PG);
    bf16_t* OUT = (bf16_t*)(P.ws + (dir ? WS_H2 : WS_H));
    lds_t QR = lds, KR = lds + 9216, VT = lds + 18432, QT = lds + 27648, KT = lds + 36864, KWT = lds + 46080, ATT = lds + 55296, ST = lds + 64512;
    LAS float* LR = (LAS float*)(lds + 73728); LAS float* TOT = (LAS float*)(lds + 77824); LAS float* DEC = (LAS float*)(lds + 79872);
    const int d = tid & 63, o = tid >> 6;
    float wreg[16];
#pragma unroll
    for (int r = 0; r < 16; ++r) wreg[r] = P.in[I_GLAW][(size_t)((l * 2 + dir) * 16 + r) * 256 + h * 64 + d];
    const float bias = P.in[I_GLAB][(l * 2 + dir) * 256 + h * 64 + d];
    for (int i = tid; i < 9216 / 4; i += 512) ((LAS unsigned*)ST)[i] = 0u;
    f32x4 sacc[2] = {(f32x4){0.f, 0.f, 0.f, 0.f}, (f32x4){0.f, 0.f, 0.f, 0.f}};
    const int tm = wid >> 1, tn0 = (wid & 1) * 2;
    __syncthreads();
    u32x4 q8, k8, v8; f32x4 lr4 = (f32x4){0.f, 0.f, 0.f, 0.f};
#define GLA_ISSUE(cc_) do { const int sg_ = (cc_) >= 4, c_ = sg_ ? (cc_) - 4 : (cc_), L_ = sg_ ? SEQ : CTXL; const int t_ = tid >> 3, c8_ = tid & 7; const int lp_ = c_ * 64 + t_, p_ = dir ? (L_ - 1 - lp_) : lp_; \
        const bf16_t* pr_ = PB + (size_t)tok_row(sg_, b, p_, false) * NINP + h * 64 + c8_ * 8; \
        q8 = *(const u32x4*)(pr_ + GLA_Q); k8 = *(const u32x4*)(pr_ + GLA_K); v8 = *(const u32x4*)(pr_ + GLA_V); \
        { const int t2_ = (tid & 255) >> 2, r4_ = tid & 3; const int lp2_ = c_ * 64 + t2_, p2_ = dir ? (L_ - 1 - lp2_) : lp2_; \
            lr4 = *(const f32x4*)(PG + (size_t)tok_row(sg_, b, p2_, false) * PGW + dir * 16 + r4_ * 4); } } while (0)
    constexpr int D_GA = 80384, D_LR = 108032 - 73728;
#define GLA_STAGE(pp_) do { lds_t QRp_ = QR + (pp_) * D_GA; lds_t KRp_ = KR + (pp_) * D_GA; lds_t VTp_ = VT + (pp_) * D_GA; LAS float* LRp_ = LR + (pp_) * (D_LR / 4); \
        asm volatile("s_waitcnt vmcnt(0)" ::: "memory"); \
        { const int t_ = tid >> 3, c8_ = tid & 7; \
          *(LAS u32x4*)(QRp_ + t_ * LDT + c8_ * 16) = q8; *(LAS u32x4*)(KRp_ + t_ * LDT + c8_ * 16) = k8; \
          _Pragma("unroll") for (int i_ = 0; i_ < 4; ++i_) { *(LAS bf16_t*)(VTp_ + (c8_ * 8 + 2 * i_) * LDT + t_ * 2) = (bf16_t)(v8[i_] & 0xffffu); *(LAS bf16_t*)(VTp_ + (c8_ * 8 + 2 * i_ + 1) * LDT + t_ * 2) = (bf16_t)(v8[i_] >> 16); } \
          if (tid < 256) { const int t2_ = tid >> 2, r4_ = tid & 3; *(LAS f32x4*)(LRp_ + t2_ * 16 + r4_ * 4) = lr4; } } } while (0)
    constexpr int D_KW = 112128 - 46080, D_DEC = 121344 - 79872;
    float bl[8];
#define GLA_B1(pp_) do { LAS float* LRp_ = LR + (pp_) * (D_LR / 4); float run_ = 0.f; \
        _Pragma("unroll") for (int i_ = 0; i_ < 8; ++i_) { const int t_ = o * 8 + i_; float dot_ = bias; \
            _Pragma("unroll") for (int r4_ = 0; r4_ < 4; ++r4_) { const f32x4 x_ = *(const LAS f32x4*)(LRp_ + t_ * 16 + r4_ * 4); dot_ += x_[0] * wreg[4 * r4_] + x_[1] * wreg[4 * r4_ + 1] + x_[2] * wreg[4 * r4_ + 2] + x_[3] * wreg[4 * r4_ + 3]; } \
            run_ += logsigf_(dot_) * (1.0f / 16.0f); bl[i_] = run_; } \
        TOT[o * 64 + d] = run_; } while (0)
#define GLA_B2(pp_) do { lds_t QRp_ = QR + (pp_) * D_GA; lds_t KRp_ = KR + (pp_) * D_GA; float pre_ = 0.f, tot_ = 0.f; \
        _Pragma("unroll") for (int o2_ = 0; o2_ < 8; ++o2_) { const float v_ = TOT[o2_ * 64 + d]; if (o2_ < o) pre_ += v_; tot_ += v_; } \
        float kw_[8]; const float et_ = __expf(tot_); \
        _Pragma("unroll") for (int i_ = 0; i_ < 8; ++i_) { const int t_ = o * 8 + i_; const float bb_ = pre_ + bl[i_]; const float enb_ = __expf(-bb_); \
            const float qv_ = bf2f(*(const LAS bf16_t*)(QRp_ + t_ * LDT + d * 2)), kv_ = bf2f(*(const LAS bf16_t*)(KRp_ + t_ * LDT + d * 2)); \
            *(LAS bf16_t*)(QT + t_ * LDT + d * 2) = f2bf(qv_ * 0.125f * __expf(bb_)); *(LAS bf16_t*)(KT + t_ * LDT + d * 2) = f2bf(kv_ * enb_); kw_[i_] = kv_ * (et_ * enb_); } \
        u32x4 w_; w_.x = cvt_pk_bf16(kw_[0], kw_[1]); w_.y = cvt_pk_bf16(kw_[2], kw_[3]); w_.z = cvt_pk_bf16(kw_[4], kw_[5]); w_.w = cvt_pk_bf16(kw_[6], kw_[7]); \
        *(LAS u32x4*)(KWT + (pp_) * D_KW + d * LDT + o * 16) = w_; if (o == 0) (DEC + (pp_) * (D_DEC / 4))[d] = et_; } while (0)
    GLA_ISSUE(0);
    GLA_STAGE(0);
    GLA_ISSUE(1);
    __syncthreads();
    GLA_B1(0);
    __syncthreads();
    GLA_B2(0);
    __syncthreads();
#pragma unroll 1
    for (int cc = 0; cc < 132; ++cc) {
        {
            const int seg = cc >= 4, c = seg ? cc - 4 : cc, L = seg ? SEQ : CTXL; const int pb = cc & 1;
            lds_t VTc = VT + pb * D_GA; lds_t KWTc = KWT + pb * D_KW; LAS float* DECc = DEC + pb * (D_DEC / 4);
            f32x4 oacc[2];
#pragma unroll
            for (int i = 0; i < 2; ++i) {
                const int tn = tn0 + i; f32x4 a = (f32x4){0.f, 0.f, 0.f, 0.f};
                mma_tile<true, 2, LDT, LDT>(a, QT, tm * 16, KT, tn * 16, fr, fq);
                const int t = tm * 16 + fr, s0 = tn * 16 + fq * 4;
#pragma unroll
                for (int jx = 0; jx < 4; ++jx) a[jx] = (s0 + jx <= t) ? a[jx] : 0.f;
                u32x2 w; w.x = cvt_pk_bf16(a[0], a[1]); w.y = cvt_pk_bf16(a[2], a[3]);
                *(LAS u32x2*)(ATT + t * LDT + s0 * 2) = w;
                oacc[i] = (f32x4){0.f, 0.f, 0.f, 0.f};
                mma_tile<true, 2, LDT, LDT>(oacc[i], QT, tm * 16, ST, tn * 16, fr, fq);
            }
            if (cc + 1 < 132) { GLA_STAGE(pb ^ 1); if (cc + 2 < 132) GLA_ISSUE(cc + 2); }
            __syncthreads();
            {
                const int t = tm * 16 + fr; const int lp = c * 64 + t, p = dir ? (L - 1 - lp) : lp;
                bf16_t* orow = OUT + (size_t)tok_row(seg, b, p, false) * 1024 + 0 + h * 64;
#pragma unroll
                for (int i = 0; i < 2; ++i) {
                    const int tn = tn0 + i;
                    mma_tile<true, 2, LDT, LDT>(oacc[i], ATT, tm * 16, VTc, tn * 16, fr, fq);
                    u32x2 w; w.x = cvt_pk_bf16(oacc[i][0], oacc[i][1]); w.y = cvt_pk_bf16(oacc[i][2], oacc[i][3]);
                    *(u32x2*)(orow + tn * 16 + fq * 4) = w;
                }
            }
            GLA_B1(pb ^ 1);
            __syncthreads();
            {
                const f32x4 dv = *(const LAS f32x4*)(DECc + tm * 16 + fq * 4);
#pragma unroll
                for (int i = 0; i < 2; ++i) {
                    const int tn = tn0 + i;
                    sacc[i] *= dv;
                    mma_tile<false, 2, LDT, LDT>(sacc[i], KWTc, tm * 16, VTc, tn * 16, fr, fq);
                    u32x2 w; w.x = cvt_pk_bf16(sacc[i][0], sacc[i][1]); w.y = cvt_pk_bf16(sacc[i][2], sacc[i][3]);
                    *(LAS u32x2*)(ST + (tn * 16 + fr) * LDT + (tm * 16 + fq * 4) * 2) = w;
                }
            }
            GLA_B2(pb ^ 1);
            __syncthreads();
        }
    }
}

__device__ __forceinline__ void scan_ssd(CPR P, int l, int b, int h, int dir, lds_t lds) {
    const int tid = opaque_tid(), lane = tid & 63, wid = tid >> 6, fr = lane & 15, fq = lane >> 4;
    const bf16_t* PB = (const bf16_t*)(P.ws + WS_PB); const float* PG = (const float*)(P.ws + WS_PG);
    bf16_t* OUT = (bf16_t*)(P.ws + (dir ? WS_H2 : WS_H));
    lds_t CM = lds, BM = lds + 9216, XT = lds + 18432, BWT = lds + 27648, SC = lds + 36864, ST = lds + 46080, XS = lds + 55296, RAW = lds + 64512;
    LAS float* CUM = (LAS float*)(lds + 90912); LAS float* DTV = (LAS float*)(lds + 91168); LAS float* EWV = (LAS float*)(lds + 91424);
    constexpr int RS = 400;
    const int d = tid & 63, o = tid >> 6, g2 = h >> 1;
    const float* cw = P.in[I_SSDCW] + (size_t)l * 3 * 512; const float* cb = P.in[I_SSDCB] + (size_t)l * 512;
    const int chv[3] = {h * 64 + d, 256 + g2 * 64 + d, 384 + g2 * 64 + d};
    float w0[3], w1[3], w2[3], wb[3];
#pragma unroll
    for (int g = 0; g < 3; ++g) { w0[g] = cw[(dir ? 2 : 0) * 512 + chv[g]]; w1[g] = cw[512 + chv[g]]; w2[g] = cw[(dir ? 0 : 2) * 512 + chv[g]]; wb[g] = cb[chv[g]]; }
    const float dtb = P.in[I_SSDDTB][(l * 2 + dir) * 4 + h], nega = -__expf(P.in[I_SSDALOG][(l * 2 + dir) * 4 + h]), dsk = P.in[I_SSDD][l * 4 + h]; const float dskv = dir == 0 ? dsk : 0.f;
    for (int i = tid; i < 9216 / 4; i += 512) ((LAS unsigned*)ST)[i] = 0u;
    f32x4 sacc[2] = {(f32x4){0.f, 0.f, 0.f, 0.f}, (f32x4){0.f, 0.f, 0.f, 0.f}};
    const int tm = wid >> 1, tn0 = (wid & 1) * 2;
    __syncthreads();
    u32x4 rw[4]; float dtraw = 0.f;
#define SSD_LD(dst_, lp_) do { int lpp_ = (lp_); lpp_ = lpp_ < 0 ? 0 : (lpp_ >= L_ ? L_ - 1 : lpp_); const int p_ = dir ? (L_ - 1 - lpp_) : lpp_; \
        const int col_ = cgp_ == 0 ? SSD_X + h * 64 : (cgp_ == 1 ? SSD_B + g2 * 64 : SSD_C + g2 * 64); dst_ = *(const u32x4*)(PB + (size_t)tok_row(sg_, b, p_, true) * NINP + col_ + c8_ * 8); } while (0)
#define SSD_ISSUE(cc_) do { const int sg_ = (cc_) >= 4, c_ = sg_ ? (cc_) - 4 : (cc_), L_ = sg_ ? SEQ : CTXL; \
        _Pragma("unroll") for (int k_ = 0; k_ < 3; ++k_) { const int idx_ = tid + 512 * k_; const int rr_ = idx_ / 24, rem_ = idx_ % 24, cgp_ = rem_ >> 3, c8_ = rem_ & 7; SSD_LD(rw[k_], c_ * 64 + rr_); } \
        { const int th_ = tid % 48; const int rr_ = th_ / 24, rem_ = th_ % 24, cgp_ = rem_ >> 3, c8_ = rem_ & 7; SSD_LD(rw[3], c_ * 64 + (rr_ ? 64 : -1)); } \
        { const int lp_ = c_ * 64 + lane, p_ = dir ? (L_ - 1 - lp_) : lp_; dtraw = PG[(size_t)tok_row(sg_, b, p_, true) * PGW + 32 + dir * 4 + h]; } } while (0)
    constexpr int D_SB = 91904 - 64512;
#define SSD_STAGE(cn_, pp_) do { const int sgS_ = (cn_) >= 4, cS_ = sgS_ ? (cn_) - 4 : (cn_), LS_ = sgS_ ? SEQ : CTXL; \
        lds_t RAWp_ = RAW + (pp_) * D_SB; LAS float* CUMp_ = CUM + (pp_) * (D_SB / 4); LAS float* DTVp_ = DTV + (pp_) * (D_SB / 4); LAS float* EWVp_ = EWV + (pp_) * (D_SB / 4); \
        asm volatile("s_waitcnt vmcnt(0)" ::: "memory"); \
        _Pragma("unroll") for (int k_ = 0; k_ < 3; ++k_) { const int idx_ = tid + 512 * k_; const int rr_ = idx_ / 24, rem_ = idx_ % 24, cgp_ = rem_ >> 3, c8_ = rem_ & 7; *(LAS u32x4*)(RAWp_ + (rr_ + 1) * RS + cgp_ * 128 + c8_ * 16) = rw[k_]; } \
        if (tid < 48) { const int rr_ = tid / 24, rem_ = tid % 24, cgp_ = rem_ >> 3, c8_ = rem_ & 7; const int lph_ = cS_ * 64 + (rr_ ? 64 : -1); \
            *(LAS u32x4*)(RAWp_ + (rr_ ? 65 : 0) * RS + cgp_ * 128 + c8_ * 16) = (lph_ >= 0 && lph_ < LS_) ? rw[3] : (u32x4){0u, 0u, 0u, 0u}; } \
        if (wid == 0) { const float dt_ = softplusf_(dtraw + dtb); const float cum_ = wave_scan_add(dt_ * nega, lane); DTVp_[lane] = dt_; CUMp_[lane] = cum_; \
            const float clv_ = __int_as_float(__builtin_amdgcn_readlane(__float_as_int(cum_), 63)); EWVp_[lane] = __expf(clv_ - cum_); } } while (0)
    constexpr int D_XB = 119072 - 18432;
#define SSD_BCB(pp_) do { lds_t RAWp_ = RAW + (pp_) * D_SB; LAS float* EWVp_ = EWV + (pp_) * (D_SB / 4); float bw_[8]; \
        _Pragma("unroll") for (int g_ = 1; g_ < 3; ++g_) { \
            float prev_ = bf2f(*(const LAS bf16_t*)(RAWp_ + (o * 8 + 0) * RS + g_ * 128 + d * 2)), cur_ = bf2f(*(const LAS bf16_t*)(RAWp_ + (o * 8 + 1) * RS + g_ * 128 + d * 2)); \
            _Pragma("unroll") for (int i_ = 0; i_ < 8; ++i_) { const int t_ = o * 8 + i_; const float nxt_ = bf2f(*(const LAS bf16_t*)(RAWp_ + (t_ + 2) * RS + g_ * 128 + d * 2)); \
                const float v_ = siluf_(w0[g_] * prev_ + w1[g_] * cur_ + w2[g_] * nxt_ + wb[g_]); prev_ = cur_; cur_ = nxt_; \
                if (g_ == 1) { *(LAS bf16_t*)(BM + t_ * LDT + d * 2) = f2bf(v_); bw_[i_] = v_ * EWVp_[t_]; } else { *(LAS bf16_t*)(CM + t_ * LDT + d * 2) = f2bf(v_); } } } \
        u32x4 w_; w_.x = cvt_pk_bf16(bw_[0], bw_[1]); w_.y = cvt_pk_bf16(bw_[2], bw_[3]); w_.z = cvt_pk_bf16(bw_[4], bw_[5]); w_.w = cvt_pk_bf16(bw_[6], bw_[7]); \
        *(LAS u32x4*)(BWT + (pp_) * D_XB + d * LDT + o * 16) = w_; } while (0)
#define SSD_BX(pp_) do { lds_t RAWp_ = RAW + (pp_) * D_SB; LAS float* DTVp_ = DTV + (pp_) * (D_SB / 4); float xt_[8]; \
        float prev_ = bf2f(*(const LAS bf16_t*)(RAWp_ + (o * 8 + 0) * RS + d * 2)), cur_ = bf2f(*(const LAS bf16_t*)(RAWp_ + (o * 8 + 1) * RS + d * 2)); \
        _Pragma("unroll") for (int i_ = 0; i_ < 8; ++i_) { const int t_ = o * 8 + i_; const float nxt_ = bf2f(*(const LAS bf16_t*)(RAWp_ + (t_ + 2) * RS + d * 2)); \
            const float v_ = siluf_(w0[0] * prev_ + w1[0] * cur_ + w2[0] * nxt_ + wb[0]); prev_ = cur_; cur_ = nxt_; \
            *(LAS bf16_t*)(XS + t_ * LDT + d * 2) = f2bf(v_); xt_[i_] = v_ * DTVp_[t_]; } \
        u32x4 w_; w_.x = cvt_pk_bf16(xt_[0], xt_[1]); w_.y = cvt_pk_bf16(xt_[2], xt_[3]); w_.z = cvt_pk_bf16(xt_[4], xt_[5]); w_.w = cvt_pk_bf16(xt_[6], xt_[7]); \
        *(LAS u32x4*)(XT + (pp_) * D_XB + d * LDT + o * 16) = w_; } while (0)
    SSD_ISSUE(0);
    SSD_STAGE(0, 0);
    SSD_ISSUE(1);
    __syncthreads();
    SSD_BCB(0); SSD_BX(0);
    __syncthreads();
#pragma unroll 1
    for (int cc = 0; cc < 132; ++cc) {
        {
            const int seg = cc >= 4, c = seg ? cc - 4 : cc, L = seg ? SEQ : CTXL; const int pb = cc & 1;
            LAS float* CUMc = CUM + pb * (D_SB / 4); lds_t XTc = XT + pb * D_XB; lds_t BWTc = BWT + pb * D_XB;
            f32x4 yacc[2];
            {
                const int t = tm * 16 + fr; const float ct = CUMc[t]; const float ect = __expf(ct);
#pragma unroll
                for (int i = 0; i < 2; ++i) {
                    const int tn = tn0 + i; f32x4 a = (f32x4){0.f, 0.f, 0.f, 0.f};
                    mma_tile<true, 2, LDT, LDT>(a, CM, tm * 16, BM, tn * 16, fr, fq);
                    const int s0 = tn * 16 + fq * 4; const f32x4 cs = *(const LAS f32x4*)(CUMc + s0);
#pragma unroll
                    for (int jx = 0; jx < 4; ++jx) a[jx] = (s0 + jx <= t) ? a[jx] * __expf(ct - cs[jx]) : 0.f;
                    u32x2 w; w.x = cvt_pk_bf16(a[0], a[1]); w.y = cvt_pk_bf16(a[2], a[3]);
                    *(LAS u32x2*)(SC + t * LDT + s0 * 2) = w;
                    yacc[i] = (f32x4){0.f, 0.f, 0.f, 0.f};
                    mma_tile<true, 2, LDT, LDT>(yacc[i], CM, tm * 16, ST, tn * 16, fr, fq);
                    yacc[i] *= ect;
                }
            }
            if (cc + 1 < 132) { SSD_STAGE(cc + 1, pb ^ 1); if (cc + 2 < 132) SSD_ISSUE(cc + 2); }
            __syncthreads();
            {
                const int t = tm * 16 + fr; const int lp = c * 64 + t, p = dir ? (L - 1 - lp) : lp;
                bf16_t* orow = OUT + (size_t)tok_row(seg, b, p, true) * 1024 + 256 + h * 64;
#pragma unroll
                for (int i = 0; i < 2; ++i) {
                    const int tn = tn0 + i, p0 = tn * 16 + fq * 4;
                    mma_tile<true, 2, LDT, LDT>(yacc[i], SC, tm * 16, XTc, tn * 16, fr, fq);
                    {
                        const u32x2 xs = *(const LAS u32x2*)(XS + t * LDT + p0 * 2);
                        yacc[i][0] += dskv * bflo(xs.x); yacc[i][1] += dskv * bfhi(xs.x); yacc[i][2] += dskv * bflo(xs.y); yacc[i][3] += dskv * bfhi(xs.y); }
                    u32x2 w; w.x = cvt_pk_bf16(yacc[i][0], yacc[i][1]); w.y = cvt_pk_bf16(yacc[i][2], yacc[i][3]);
                    *(u32x2*)(orow + p0) = w;
                }
            }
            SSD_BCB(pb ^ 1);
            __syncthreads();
            {
                const float ecl_in = CUMc[63]; const float ecl = __expf(ecl_in);
#pragma unroll
                for (int i = 0; i < 2; ++i) {
                    const int tn = tn0 + i;
                    sacc[i] *= ecl;
                    mma_tile<false, 2, LDT, LDT>(sacc[i], BWTc, tm * 16, XTc, tn * 16, fr, fq);
                    u32x2 w; w.x = cvt_pk_bf16(sacc[i][0], sacc[i][1]); w.y = cvt_pk_bf16(sacc[i][2], sacc[i][3]);
                    *(LAS u32x2*)(ST + (tn * 16 + fr) * LDT + (tm * 16 + fq * 4) * 2) = w;
                }
            }
            SSD_BX(pb ^ 1);
            __syncthreads();
        }
    }
}

__device__ __forceinline__ void scan_mlstm(CPR P, int l, int b, int h, int dir, lds_t lds) {
    const int tid = opaque_tid(), lane = tid & 63, wid = tid >> 6, fr = lane & 15, fq = lane >> 4;
    const bf16_t* PB = (const bf16_t*)(P.ws + WS_PB); const float* PG = (const float*)(P.ws + WS_PG);
    bf16_t* OUT = (bf16_t*)(P.ws + (dir ? WS_H2 : WS_H));
    lds_t QM = lds, KM = lds + 9216, KWT = lds + 18432, WM = lds + 27648, VT = lds + 36864, CT = lds + 48384, RAW = lds + 59904;
    LAS float* FV = (LAS float*)(lds + 77856); LAS float* AV = (LAS float*)(lds + 78112); LAS float* MV = (LAS float*)(lds + 78368); LAS float* DEN = (LAS float*)(lds + 78624); LAS float* KWE = (LAS float*)(lds + 79648);
    constexpr int RS = 272;
    const int d = tid & 63, o = tid >> 6;
    const float* cw = P.in[I_MLCW] + (size_t)l * 3 * 512; const float* cb = P.in[I_MLCB] + (size_t)l * 512;
    const int chv[2] = {h * 64 + d, 256 + h * 64 + d};
    float w0[2], w1[2], w2[2], wb[2];
#pragma unroll
    for (int g = 0; g < 2; ++g) { w0[g] = cw[(dir ? 2 : 0) * 512 + chv[g]]; w1[g] = cw[512 + chv[g]]; w2[g] = cw[(dir ? 0 : 2) * 512 + chv[g]]; wb[g] = cb[chv[g]]; }
    const float gbi = P.in[I_MLGB][l * 16 + dir * 8 + h], gbf = P.in[I_MLGB][l * 16 + dir * 8 + 4 + h];
    for (int i = tid; i < 11520 / 4; i += 512) ((LAS unsigned*)CT)[i] = 0u;
    constexpr int D_VT = 80000 - 36864, D_RAW = 91520 - 59904, D_G = 31744;
    for (int i = tid; i < 16 * LDT / 4; i += 512) { const unsigned v = (i < LDT / 4) ? 0x3F803F80u : 0u; ((LAS unsigned*)(VT + 64 * LDT))[i] = v; ((LAS unsigned*)(VT + D_VT + 64 * LDT))[i] = v; }
    f32x4 cacc[3] = {(f32x4){0.f, 0.f, 0.f, 0.f}, (f32x4){0.f, 0.f, 0.f, 0.f}, (f32x4){0.f, 0.f, 0.f, 0.f}};
    float m_s = 0.f;
    const int tm = wid >> 1, tn0 = (wid & 1) * 2; const bool extra = (wid & 1) == 0;
    __syncthreads();
    u32x4 rw[3], v8; float graw_i = 0.f, graw_f = 0.f;
#define ML_LD(dst_, lp_) do { int lpp_ = (lp_); lpp_ = lpp_ < 0 ? 0 : (lpp_ >= L_ ? L_ - 1 : lpp_); const int p_ = dir ? (L_ - 1 - lpp_) : lpp_; \
        dst_ = *(const u32x4*)(PB + (size_t)tok_row(sg_, b, p_, false) * NINP + ML_Q + cgp_ * 256 + h * 64 + c8_ * 8); } while (0)
#define ML_ISSUE(cc_) do { const int sg_ = (cc_) >= 4, c_ = sg_ ? (cc_) - 4 : (cc_), L_ = sg_ ? SEQ : CTXL; \
        _Pragma("unroll") for (int k_ = 0; k_ < 2; ++k_) { const int idx_ = tid + 512 * k_; const int rr_ = idx_ >> 4, rem_ = idx_ & 15, cgp_ = rem_ >> 3, c8_ = rem_ & 7; ML_LD(rw[k_], c_ * 64 + rr_); } \
        { const int th_ = tid & 31; const int rr_ = th_ >> 4, rem_ = th_ & 15, cgp_ = rem_ >> 3, c8_ = rem_ & 7; ML_LD(rw[2], c_ * 64 + (rr_ ? 64 : -1)); } \
        { const int t_ = tid >> 3, c8_ = tid & 7; const int lp_ = c_ * 64 + t_, p_ = dir ? (L_ - 1 - lp_) : lp_; v8 = *(const u32x4*)(PB + (size_t)tok_row(sg_, b, p_, false) * NINP + ML_V + h * 64 + c8_ * 8); } \
        { const int lp_ = c_ * 64 + lane, p_ = dir ? (L_ - 1 - lp_) : lp_; const float* pg_ = PG + (size_t)tok_row(sg_, b, p_, false) * PGW + 64 + dir * 8 + h; graw_i = pg_[0]; graw_f = pg_[4]; } } while (0)
#define ML_STAGE(cn_, pp_, ms_) do { const int sgS_ = (cn_) >= 4, cS_ = sgS_ ? (cn_) - 4 : (cn_), LS_ = sgS_ ? SEQ : CTXL; \
        lds_t RAWp_ = RAW + (pp_) * D_RAW; lds_t VTp_ = VT + (pp_) * D_VT; LAS float* FVp_ = FV + (pp_) * (D_G / 4); LAS float* AVp_ = AV + (pp_) * (D_G / 4); LAS float* MVp_ = MV + (pp_) * (D_G / 4); LAS float* KWEp_ = KWE + (pp_) * (D_G / 4); \
        asm volatile("s_waitcnt vmcnt(0)" ::: "memory"); \
        _Pragma("unroll") for (int k_ = 0; k_ < 2; ++k_) { const int idx_ = tid + 512 * k_; const int rr_ = idx_ >> 4, rem_ = idx_ & 15, cgp_ = rem_ >> 3, c8_ = rem_ & 7; *(LAS u32x4*)(RAWp_ + (rr_ + 1) * RS + cgp_ * 128 + c8_ * 16) = rw[k_]; } \
        if (tid < 32) { const int rr_ = tid >> 4, rem_ = tid & 15, cgp_ = rem_ >> 3, c8_ = rem_ & 7; const int lph_ = cS_ * 64 + (rr_ ? 64 : -1); \
            *(LAS u32x4*)(RAWp_ + (rr_ ? 65 : 0) * RS + cgp_ * 128 + c8_ * 16) = (lph_ >= 0 && lph_ < LS_) ? rw[2] : (u32x4){0u, 0u, 0u, 0u}; } \
        { const int t_ = tid >> 3, c8_ = tid & 7; \
          _Pragma("unroll") for (int i_ = 0; i_ < 4; ++i_) { *(LAS bf16_t*)(VTp_ + (c8_ * 8 + 2 * i_) * LDT + t_ * 2) = (bf16_t)(v8[i_] & 0xffffu); *(LAS bf16_t*)(VTp_ + (c8_ * 8 + 2 * i_ + 1) * LDT + t_ * 2) = (bf16_t)(v8[i_] >> 16); } } \
        if (wid == 0) { const float ig_ = graw_i + gbi, lf_ = logsigf_(graw_f + gbf); \
            const float F_ = wave_scan_add(lf_, lane); const float a_ = ig_ - F_; const float M_ = fmaxf(wave_scan_max(a_, lane), (ms_)); \
            FVp_[lane] = F_; AVp_[lane] = a_; MVp_[lane] = M_; \
            const float m63_ = __int_as_float(__builtin_amdgcn_readlane(__float_as_int(M_), 63)); KWEp_[lane] = __expf(a_ - m63_); } } while (0)
    constexpr int D_KW = 111648 - 18432;
#define ML_BQ(pp_) do { lds_t RAWp_ = RAW + (pp_) * D_RAW; \
        float prev_ = bf2f(*(const LAS bf16_t*)(RAWp_ + (o * 8 + 0) * RS + d * 2)), cur_ = bf2f(*(const LAS bf16_t*)(RAWp_ + (o * 8 + 1) * RS + d * 2)); \
        _Pragma("unroll") for (int i_ = 0; i_ < 8; ++i_) { const int t_ = o * 8 + i_; const float nxt_ = bf2f(*(const LAS bf16_t*)(RAWp_ + (t_ + 2) * RS + d * 2)); \
            const float v_ = siluf_(w0[0] * prev_ + w1[0] * cur_ + w2[0] * nxt_ + wb[0]); prev_ = cur_; cur_ = nxt_; *(LAS bf16_t*)(QM + t_ * LDT + d * 2) = f2bf(v_); } } while (0)
#define ML_BK(pp_) do { lds_t RAWp_ = RAW + (pp_) * D_RAW; LAS float* KWEp_ = KWE + (pp_) * (D_G / 4); float kw_[8]; \
        float prev_ = bf2f(*(const LAS bf16_t*)(RAWp_ + (o * 8 + 0) * RS + 128 + d * 2)), cur_ = bf2f(*(const LAS bf16_t*)(RAWp_ + (o * 8 + 1) * RS + 128 + d * 2)); \
        _Pragma("unroll") for (int i_ = 0; i_ < 8; ++i_) { const int t_ = o * 8 + i_; const float nxt_ = bf2f(*(const LAS bf16_t*)(RAWp_ + (t_ + 2) * RS + 128 + d * 2)); \
            const float v_ = siluf_(w0[1] * prev_ + w1[1] * cur_ + w2[1] * nxt_ + wb[1]); prev_ = cur_; cur_ = nxt_; \
            const float kk_ = v_ * 0.125f; *(LAS bf16_t*)(KM + t_ * LDT + d * 2) = f2bf(kk_); kw_[i_] = kk_ * KWEp_[t_]; } \
        u32x4 w_; w_.x = cvt_pk_bf16(kw_[0], kw_[1]); w_.y = cvt_pk_bf16(kw_[2], kw_[3]); w_.z = cvt_pk_bf16(kw_[4], kw_[5]); w_.w = cvt_pk_bf16(kw_[6], kw_[7]); \
        *(LAS u32x4*)(KWT + (pp_) * D_KW + d * LDT + o * 16) = w_; } while (0)
    ML_ISSUE(0);
    ML_STAGE(0, 0, 0.f);
    ML_ISSUE(1);
    __syncthreads();
    ML_BQ(0); ML_BK(0);
    __syncthreads();
#pragma unroll 1
    for (int cc = 0; cc < 132; ++cc) {
        {
            const int seg = cc >= 4, c = seg ? cc - 4 : cc, L = seg ? SEQ : CTXL; const int pb = cc & 1;
            lds_t VTc = VT + pb * D_VT; LAS float* FVc = FV + pb * (D_G / 4); LAS float* AVc = AV + pb * (D_G / 4); LAS float* MVc = MV + pb * (D_G / 4); lds_t KWTc = KWT + pb * D_KW;
            f32x4 hacc[3];
            const int trow = tm * 16 + fr; const float Mt = MVc[trow];
            {
                const float winter = __expf(m_s - Mt);
#pragma unroll
                for (int i = 0; i < 2; ++i) {
                    const int tn = tn0 + i; f32x4 a = (f32x4){0.f, 0.f, 0.f, 0.f};
                    mma_tile<true, 2, LDT, LDT>(a, QM, tm * 16, KM, tn * 16, fr, fq);
                    const int s0 = tn * 16 + fq * 4; const f32x4 as = *(const LAS f32x4*)(AVc + s0);
#pragma unroll
                    for (int jx = 0; jx < 4; ++jx) a[jx] = (s0 + jx <= trow) ? a[jx] * __expf(as[jx] - Mt) : 0.f;
                    u32x2 w; w.x = cvt_pk_bf16(a[0], a[1]); w.y = cvt_pk_bf16(a[2], a[3]);
                    *(LAS u32x2*)(WM + trow * LDT + s0 * 2) = w;
                    hacc[i] = (f32x4){0.f, 0.f, 0.f, 0.f};
                    mma_tile<true, 2, LDT, LDT>(hacc[i], QM, tm * 16, CT, tn * 16, fr, fq);
                    hacc[i] *= winter;
                }
                hacc[2] = (f32x4){0.f, 0.f, 0.f, 0.f};
                if (extra) { mma_tile<true, 2, LDT, LDT>(hacc[2], QM, tm * 16, CT, 64, fr, fq); hacc[2] *= winter; }
            }
            if (cc + 1 < 132) { const float msn = FVc[63] + MVc[63]; ML_STAGE(cc + 1, pb ^ 1, msn); if (cc + 2 < 132) ML_ISSUE(cc + 2); }
            __syncthreads();
#pragma unroll
            for (int i = 0; i < 2; ++i) mma_tile<true, 2, LDT, LDT>(hacc[i], WM, tm * 16, VTc, (tn0 + i) * 16, fr, fq);
            if (extra) { mma_tile<true, 2, LDT, LDT>(hacc[2], WM, tm * 16, VTc, 64, fr, fq); DEN[fq * 64 + trow] = hacc[2][0]; }
            ML_BQ(pb ^ 1);
            __syncthreads();
            {
                const int lp = c * 64 + trow, p = dir ? (L - 1 - lp) : lp;
                bf16_t* orow = OUT + (size_t)tok_row(seg, b, p, false) * 1024 + 512 + h * 64;
                const float den = DEN[trow], mt = FVc[trow] + Mt; const float inv = __builtin_amdgcn_rcpf(fmaxf(fabsf(den), __expf(-mt)));
#pragma unroll
                for (int i = 0; i < 2; ++i) {
                    u32x2 w; w.x = cvt_pk_bf16(hacc[i][0] * inv, hacc[i][1] * inv); w.y = cvt_pk_bf16(hacc[i][2] * inv, hacc[i][3] * inv);
                    *(u32x2*)(orow + (tn0 + i) * 16 + fq * 4) = w;
                }
                const float M63 = MVc[63]; const float decay = __expf(m_s - M63);
#pragma unroll
                for (int i = 0; i < 2; ++i) {
                    const int tn = tn0 + i;
                    cacc[i] *= decay;
                    mma_tile<false, 2, LDT, LDT>(cacc[i], KWTc, tm * 16, VTc, tn * 16, fr, fq);
                    u32x2 w; w.x = cvt_pk_bf16(cacc[i][0], cacc[i][1]); w.y = cvt_pk_bf16(cacc[i][2], cacc[i][3]);
                    *(LAS u32x2*)(CT + (tn * 16 + fr) * LDT + (tm * 16 + fq * 4) * 2) = w;
                }
                if (extra) {
                    cacc[2] *= decay;
                    mma_tile<false, 2, LDT, LDT>(cacc[2], KWTc, tm * 16, VTc, 64, fr, fq);
                    u32x2 w; w.x = cvt_pk_bf16(cacc[2][0], cacc[2][1]); w.y = cvt_pk_bf16(cacc[2][2], cacc[2][3]);
                    *(LAS u32x2*)(CT + (64 + fr) * LDT + (tm * 16 + fq * 4) * 2) = w;
                }
                m_s = FVc[63] + M63;
            }
            ML_BK(pb ^ 1);
            __syncthreads();
        }
    }
}

__device__ __forceinline__ void scan_s5(CPR P, int l, int b, int g, int dir, lds_t lds) {
    const int tid = opaque_tid(), lane = tid & 63, wid = tid >> 6, fr = lane & 15, fq = lane >> 4;
    const bf16_t* PB = (const bf16_t*)(P.ws + WS_PB);
    bf16_t* OUT = (bf16_t*)(P.ws + (dir ? WS_H2 : WS_H));
    constexpr int US = 80, HS = 272;
    lds_t UA = lds, BB = lds + 5120, HB = lds + 49152, CB = lds + 66560;
    LAS float* BU = (LAS float*)(lds + 15360); LAS float* EO = (LAS float*)(lds + 70912);
    const int n = tid & 63, o = tid >> 6;
    const int pidx = ((l * 2 + dir) * 16 + g) * 64 + n;
    const float are = fminf(P.in[I_S5ARE][pidx], -1e-4f), aim = P.in[I_S5AIM][pidx], step = expf(P.in[I_S5LS][(l * 2 + dir) * 16 + g]);
    const float mag = expf(are * step), abr = mag * cosf(aim * step), abi = mag * sinf(aim * step);
    {
        const float den = are * are + aim * aim, nr = abr - 1.0f, ni = abi;
        const float cre = (nr * are + ni * aim) / den, cim = (ni * are - nr * aim) / den;
#pragma unroll
        for (int jj = 0; jj < 2; ++jj) {
            const int j = o * 2 + jj;
            const float bre = P.in[I_S5BRE][(size_t)((l * 16 + g) * 64 + n) * 16 + j], bim = P.in[I_S5BIM][(size_t)((l * 16 + g) * 64 + n) * 16 + j];
            *(LAS bf16_t*)(BB + n * US + j * 2) = f2bf(cre * bre - cim * bim);
            *(LAS bf16_t*)(BB + (64 + n) * US + j * 2) = f2bf(cre * bim + cim * bre);
            *(LAS bf16_t*)(BB + n * US + (16 + j) * 2) = 0; *(LAS bf16_t*)(BB + (64 + n) * US + (16 + j) * 2) = 0;
            *(LAS bf16_t*)(UA + n * US + (16 + j) * 2) = 0;
            const float cr = P.in[I_S5CRE][(size_t)((l * 16 + g) * 16 + j) * 64 + n], ci = P.in[I_S5CIM][(size_t)((l * 16 + g) * 16 + j) * 64 + n];
            *(LAS bf16_t*)(CB + j * HS + n * 2) = f2bf(cr); *(LAS bf16_t*)(CB + j * HS + (64 + n) * 2) = f2bf(-ci);
        }
    }
    float a8r = abr, a8i = abi;
#pragma unroll
    for (int s = 0; s < 3; ++s) { const float r2 = a8r * a8r - a8i * a8i, i2 = 2.0f * a8r * a8i; a8r = r2; a8i = i2; }
    float h0r = 0.f, h0i = 0.f;
    __syncthreads();
    u32x4 u8 = (u32x4){0u, 0u, 0u, 0u};
#define S5_ISSUE(cc_) do { { const int sg_ = (cc_) >= 4, c_ = sg_ ? (cc_) - 4 : (cc_), L_ = sg_ ? SEQ : CTXL; const int t_ = (tid & 127) >> 1, hf_ = tid & 1; const int lp_ = c_ * 64 + t_, p_ = dir ? (L_ - 1 - lp_) : lp_; \
        u8 = *(const u32x4*)(PB + (size_t)tok_row(sg_, b, p_, true) * NINP + S50 + g * 16 + hf_ * 8); } } while (0)
    S5_ISSUE(0);
#pragma unroll 1
    for (int cc = 0; cc < 132; ++cc) {
        {
            const int seg = cc >= 4, c = seg ? cc - 4 : cc, L = seg ? SEQ : CTXL;
            asm volatile("s_waitcnt vmcnt(0)" ::: "memory");
            if (tid < 128) { const int t = tid >> 1, hf = tid & 1; *(LAS u32x4*)(UA + t * US + hf * 16) = u8; }
            __syncthreads();
            if (cc + 1 < 132) S5_ISSUE(cc + 1);
            {   const int tm = wid >> 1;
#pragma unroll
                for (int i = 0; i < 4; ++i) { const int tn = (wid & 1) * 4 + i; f32x4 a = (f32x4){0.f, 0.f, 0.f, 0.f};
                    mma_tile<false, 1, US, US>(a, UA, tm * 16, BB, tn * 16, fr, fq);
#pragma unroll
                    for (int jx = 0; jx < 4; ++jx) BU[(tm * 16 + fq * 4 + jx) * 132 + tn * 16 + fr] = a[jx]; }
            }
            __syncthreads();
            float hr[8], hi[8];
            {   float r = 0.f, im = 0.f;
#pragma unroll
                for (int i = 0; i < 8; ++i) { const int t = o * 8 + i; const float br = BU[t * 132 + n], bi = BU[t * 132 + 64 + n];
                    const float nr = abr * r - abi * im + br, ni = abr * im + abi * r + bi; r = nr; im = ni; hr[i] = r; hi[i] = im; }
                EO[o * 128 + n] = r; EO[o * 128 + 64 + n] = im;
            }
            __syncthreads();
            {   float cr = h0r, ci = h0i, mr = 0.f, mi = 0.f;
#pragma unroll
                for (int o2 = 0; o2 < 8; ++o2) { if (o2 == o) { mr = cr; mi = ci; }
                    const float er = EO[o2 * 128 + n], ei = EO[o2 * 128 + 64 + n];
                    const float nr = a8r * cr - a8i * ci + er, ni = a8r * ci + a8i * cr + ei; cr = nr; ci = ni; }
                h0r = cr; h0i = ci;
                float pr = abr, pi = abi;
#pragma unroll
                for (int i = 0; i < 8; ++i) { const int t = o * 8 + i;
                    const float vr = hr[i] + pr * mr - pi * mi, vi = hi[i] + pr * mi + pi * mr;
                    *(LAS bf16_t*)(HB + t * HS + n * 2) = f2bf(vr); *(LAS bf16_t*)(HB + t * HS + (64 + n) * 2) = f2bf(vi);
                    const float qr = pr * abr - pi * abi, qi = pr * abi + pi * abr; pr = qr; pi = qi; }
            }
            __syncthreads();
            if (wid < 4) { const int tm = wid; f32x4 a = (f32x4){0.f, 0.f, 0.f, 0.f};
                mma_tile<true, 4, HS, HS>(a, HB, tm * 16, CB, 0, fr, fq);
                const int t = tm * 16 + fr; const int lp = c * 64 + t, p = dir ? (L - 1 - lp) : lp;
                u32x2 w; w.x = cvt_pk_bf16(a[0], a[1]); w.y = cvt_pk_bf16(a[2], a[3]);
                __hip_atomic_store((unsigned long long*)(OUT + (size_t)tok_row(seg, b, p, true) * 1024 + 768 + g * 16 + fq * 4), ((unsigned long long)w.y << 32) | w.x, __ATOMIC_RELAXED, __HIP_MEMORY_SCOPE_AGENT); }
        }
    }
    __syncthreads();
}

__device__ __forceinline__ void phase_mixers(CPR P, int l, lds_t lds) {
#pragma unroll 1
    for (int item = blockIdx.x; item < 224; item += gridDim.x) {
        if (item < 32) scan_gla(P, l, item >> 3, (item >> 1) & 3, item & 1, lds);
        else if (item < 64) { const int i = item - 32; scan_ssd(P, l, i >> 3, (i >> 1) & 3, i & 1, lds); }
        else if (item < 96) { const int i = item - 64; scan_mlstm(P, l, i >> 3, (i >> 1) & 3, i & 1, lds); }
        else { const int i = item - 96; scan_s5(P, l, i >> 5, (i >> 1) & 15, i & 1, lds); }
        __syncthreads();
    }
    if ((int)blockIdx.x >= 224 && l + 1 < DEPTH) phase_convert(P, lds, l + 1, 224, (int)gridDim.x - 224);
}

__device__ __forceinline__ void phase_post(CPR P, int l) {
    const int tid_ = opaque_tid(); const int lane = tid_ & 63, wid = tid_ >> 6, c4 = lane * 4;
    bf16_t* H = (bf16_t*)(P.ws + WS_H); const bf16_t* H2 = (const bf16_t*)(P.ws + WS_H2); const bf16_t* PB = (const bf16_t*)(P.ws + WS_PB);
    bf16_t* GB = (bf16_t*)(P.ws + WS_GB);
    const f32x4 gg = *(const f32x4*)(P.in[I_GLAG] + l * 256 + c4), gs = *(const f32x4*)(P.in[I_SSDG] + l * 256 + c4), gm = *(const f32x4*)(P.in[I_MLG] + l * 256 + c4), sd = *(const f32x4*)(P.in[I_S5D] + l * 256 + c4);
    for (int row = blockIdx.x * 8 + wid; row < NT; row += gridDim.x * 8) {
        bf16_t* hrow = H + (size_t)row * 1024; const bf16_t* orow = H2 + (size_t)row * 1024; const bf16_t* pr = PB + (size_t)row * NINP;
        u32x2 f[4], bk[4];
#pragma unroll
        for (int q = 0; q < 4; ++q) { f[q] = *(const u32x2*)(hrow + q * 256 + c4); bk[q] = *(const u32x2*)(orow + q * 256 + c4); }
        const u32x2 rr = *(const u32x2*)(pr + GLA_R + c4), zz = *(const u32x2*)(pr + SSD_Z + c4), oo = *(const u32x2*)(pr + ML_O + c4), pp = *(const u32x2*)(pr + S50 + c4);
        float v[4][4];
#pragma unroll
        for (int q = 0; q < 4; ++q) { v[q][0] = bflo(f[q].x) + bflo(bk[q].x); v[q][1] = bfhi(f[q].x) + bfhi(bk[q].x); v[q][2] = bflo(f[q].y) + bflo(bk[q].y); v[q][3] = bfhi(f[q].y) + bfhi(bk[q].y); }
        const float rv[4] = {bflo(rr.x), bfhi(rr.x), bflo(rr.y), bfhi(rr.y)}, zv[4] = {bflo(zz.x), bfhi(zz.x), bflo(zz.y), bfhi(zz.y)};
        const float ov[4] = {bflo(oo.x), bfhi(oo.x), bflo(oo.y), bfhi(oo.y)}, pv[4] = {bflo(pp.x), bfhi(pp.x), bflo(pp.y), bfhi(pp.y)};
        float ss = v[0][0] * v[0][0] + v[0][1] * v[0][1] + v[0][2] * v[0][2] + v[0][3] * v[0][3];
        ss = row16_sum(ss);
        float rs = rsqrtf(ss * (1.0f / 64.0f) + EPS);
        { u32x2 w; w.x = cvt_pk_bf16(v[0][0] * rs * gg[0] * siluf_(rv[0]), v[0][1] * rs * gg[1] * siluf_(rv[1])); w.y = cvt_pk_bf16(v[0][2] * rs * gg[2] * siluf_(rv[2]), v[0][3] * rs * gg[3] * siluf_(rv[3]));
          *(u32x2*)(hrow + c4) = w; }
        float y[4];
#pragma unroll
        for (int i = 0; i < 4; ++i) y[i] = v[1][i] * siluf_(zv[i]);
        ss = y[0] * y[0] + y[1] * y[1] + y[2] * y[2] + y[3] * y[3];
        ss = wave_sum(ss);
        rs = rsqrtf(ss * (1.0f / 256.0f) + EPS);
        { u32x2 w; w.x = cvt_pk_bf16(y[0] * rs * gs[0], y[1] * rs * gs[1]); w.y = cvt_pk_bf16(y[2] * rs * gs[2], y[3] * rs * gs[3]); *(u32x2*)(hrow + 256 + c4) = w; }
        ss = v[2][0] * v[2][0] + v[2][1] * v[2][1] + v[2][2] * v[2][2] + v[2][3] * v[2][3];
        ss = row16_sum(ss);
        rs = rsqrtf(ss * (1.0f / 64.0f) + EPS);
        { u32x2 w; w.x = cvt_pk_bf16(v[2][0] * rs * gm[0] * sigmoidf_(ov[0]), v[2][1] * rs * gm[1] * sigmoidf_(ov[1])); w.y = cvt_pk_bf16(v[2][2] * rs * gm[2] * sigmoidf_(ov[2]), v[2][3] * rs * gm[3] * sigmoidf_(ov[3]));
          *(u32x2*)(hrow + 512 + c4) = w; }
        { u32x2 w; w.x = cvt_pk_bf16(geluf_(v[3][0] + sd[0] * pv[0]), geluf_(v[3][1] + sd[1] * pv[1])); w.y = cvt_pk_bf16(geluf_(v[3][2] + sd[2] * pv[2]), geluf_(v[3][3] + sd[3] * pv[3]));
          *(u32x2*)(GB + (size_t)row * 256 + c4) = w; }
    }
}

#define XB_TMO      128
#define XB_XCNT(j)  (256  + 64 * (j))
#define XB_XSUB(j)  (1280 + 64 * (j))
#define XB_XGEN(j)  (2304 + 64 * (j))
#define XB_TOP      3328
#define XB_TOPGEN   3392
#define XCD_BAR_WORDS 3456
#define XB_SPIN_CAP (1u << 22)
__device__ __forceinline__ unsigned xb_ld(unsigned* p)              { return __hip_atomic_load(p, __ATOMIC_RELAXED, __HIP_MEMORY_SCOPE_AGENT); }
__device__ __forceinline__ unsigned xb_add(unsigned* p, unsigned v) { return __hip_atomic_fetch_add(p, v, __ATOMIC_RELAXED, __HIP_MEMORY_SCOPE_AGENT); }
__device__ __forceinline__ unsigned xb_xcc_id() { return (unsigned)__builtin_amdgcn_s_getreg((3 << 11) | 20) & 0xFu; }
#define XB_SPIN(cond, bar) do { unsigned _sp = 0; while (cond) { __builtin_amdgcn_s_sleep(1); \
    if ((++_sp & 255u) == 0u) { if (xb_ld(&(bar)[XB_TMO])) break; if (_sp > XB_SPIN_CAP) { atomicAdd(&(bar)[XB_TMO], 1u); break; } } } } while (0)
struct XcdBarrier { unsigned* bar; unsigned x; volatile LAS unsigned* st; };
__device__ __forceinline__ XcdBarrier xcd_barrier_post(unsigned* bar, volatile LAS unsigned* st) {
    XcdBarrier b; b.bar = bar; b.x = xb_xcc_id(); b.st = st;
    if (threadIdx.x == 0) (void)xb_add(&bar[XB_XCNT(b.x)], 1u);
    return b;
}
__device__ __forceinline__ void xcd_barrier_complete(unsigned* bar, unsigned x, unsigned& nloc, unsigned& nx) {
    const unsigned G = gridDim.x * gridDim.y * gridDim.z;
    unsigned sum, cnt, mine, sp = 0u;
    for (;;) {
        sum = 0u; cnt = 0u; mine = 0u;
#pragma unroll
        for (unsigned j = 0; j < 16; ++j) { const unsigned c = xb_ld(&bar[XB_XCNT(j)]); sum += c; cnt += (c > 0u) ? 1u : 0u; mine = (j == x) ? c : mine; }
        if (sum == G) break;
        __builtin_amdgcn_s_sleep(1);
        if ((++sp & 255u) == 0u) { if (xb_ld(&bar[XB_TMO])) break; if (sp > XB_SPIN_CAP) { atomicAdd(&bar[XB_TMO], 1u); break; } }
    }
    nloc = mine > 0u ? mine : 1u; nx = cnt > 0u ? cnt : 1u;
}
__device__ __forceinline__ void xcd_barrier(const XcdBarrier& b) {
    asm volatile("s_waitcnt vmcnt(0)" ::: "memory");
    __syncthreads();
    if (threadIdx.x == 0) {
        unsigned* bar = b.bar;
        __builtin_amdgcn_s_waitcnt(0);
        unsigned nloc = b.st[0], nx = b.st[1];
        if (nloc == 0u) { xcd_barrier_complete(bar, b.x, nloc, nx); b.st[0] = nloc; b.st[1] = nx; }
        const unsigned old = xb_add(&bar[XB_XSUB(b.x)], 1u);
        const unsigned gen = old / nloc;
        if (old + 1u == (gen + 1u) * nloc) {
            __builtin_amdgcn_fence(__ATOMIC_RELEASE, "agent");
            asm volatile("s_waitcnt vmcnt(0)" ::: "memory");
            const unsigned og = xb_add(&bar[XB_TOP], 1u);
            const unsigned tg = og / nx;
            if (og + 1u == (tg + 1u) * nx) xb_add(&bar[XB_TOPGEN], 1u);
            else XB_SPIN(xb_ld(&bar[XB_TOPGEN]) == tg, bar);
            __builtin_amdgcn_fence(__ATOMIC_ACQUIRE, "agent");
            xb_add(&bar[XB_XGEN(b.x)], 1u);
            asm volatile("s_waitcnt vmcnt(0)" ::: "memory");
        } else {
            XB_SPIN(xb_ld(&bar[XB_XGEN(b.x)]) == gen, bar);
            __builtin_amdgcn_fence(__ATOMIC_ACQUIRE, "agent");
            asm volatile("s_waitcnt vmcnt(0)" ::: "memory");
        }
    }
    __syncthreads();
}
__device__ __forceinline__ void gsync(cg::grid_group& grid) {
    asm volatile("s_waitcnt vmcnt(0) lgkmcnt(0)" ::: "memory");
    __builtin_amdgcn_fence(__ATOMIC_RELEASE, "agent");
    asm volatile("s_waitcnt vmcnt(0)" ::: "memory");
    grid.sync();
    __builtin_amdgcn_fence(__ATOMIC_ACQUIRE, "agent");
    asm volatile("s_waitcnt vmcnt(0)" ::: "memory");
    __syncthreads();
}
__global__ void __launch_bounds__(512, 2) fwd_megakernel(Params Pk) {
    extern __shared__ __attribute__((aligned(16))) unsigned char smem[];
    lds_t lds = (lds_t)smem;
    cg::grid_group grid = cg::this_grid();
    volatile LAS unsigned* xst = (volatile LAS unsigned*)(lds + 139264);
    if (threadIdx.x == 0) { xst[0] = 0u; xst[1] = 0u; xst[2] = 0u; xst[3] = 0u; }
    __syncthreads();
    const XcdBarrier xb = xcd_barrier_post((unsigned*)(getP()->ws + WS_BAR), xst);
    phase_mods(*getP(), lds);
    phase_convert(*getP(), lds, 0, 0, (int)gridDim.x);
    xcd_barrier(xb);
    if (getP()->ws == nullptr) gsync(grid);
#pragma unroll 1
    for (int l = 0; l < DEPTH; ++l) {
#pragma unroll 1
        for (int j = 0; j < 3; ++j) {
            phase_modnorm(*getP(), l, j, l == 0 && j == 0);
            xcd_barrier(xb);
            CPR P = *getP();
            bf16_t* H = (bf16_t*)(P.ws + WS_H); bf16_t* PBp = (bf16_t*)(P.ws + WS_PB);
            const float* mods_l = (const float*)(P.ws + WS_MODS) + (size_t)l * 5 * 9216;
            pg8::Gemm g2;
            if (j != 1) {
                const int s = j >> 1;
                pg8::Gemm g; g.A = H; g.Bt = (const bf16_t*)(P.ws + WS_WFI) + (size_t)(l * 2 + s) * 5632 * 1024; g.M = NT; g.N = 5632; g.K = 1024; g.lda = 1024; g.ldb = 1024;
                pg8::StaticOrder S; S.init(g.M, g.N, (int)gridDim.x, (int)blockIdx.x);
                EpiSwiGLU E; E.O = PBp;
                pg8::gemm_phase(lds, g, S, E);
                xcd_barrier(xb);
                g2.A = PBp; g2.Bt = (const bf16_t*)(P.ws + WS_WFO) + (size_t)(l * 2 + s) * 1024 * DFF; g2.M = NLAT; g2.N = 1024; g2.K = DFF; g2.lda = DFF; g2.ldb = DFF;
            } else {
                {
                    pg8::Gemm g; g.A = H; g.Bt = (const bf16_t*)(P.ws + WS_WIN) + (size_t)l * NINP * 1024; g.M = NT; g.N = NINP; g.K = 1024; g.lda = 1024; g.ldb = 1024;
                    pg8::StaticOrder S; S.init(g.M, g.N, (int)gridDim.x, (int)blockIdx.x);
                    EpiInProj E; E.Pb = PBp; E.Pg = (float*)(P.ws + WS_PG);
                    pg8::gemm_phase(lds, g, S, E);
                }
                xcd_barrier(xb);
                phase_mixers(*getP(), l, lds);
                xcd_barrier(xb);
                phase_post(*getP(), l);
                xcd_barrier(xb);
                {
                    pg8::Gemm g; g.A = (const bf16_t*)(P.ws + WS_GB); g.Bt = (const bf16_t*)(P.ws + WS_WGLU) + (size_t)l * 256 * 256; g.M = NT; g.N = 256; g.K = 256; g.lda = 256; g.ldb = 256;
                    pg8::StaticOrder S; S.init(g.M, g.N, (int)gridDim.x, (int)blockIdx.x);
                    EpiGLU E; E.G = (const bf16_t*)(P.ws + WS_GB); E.bglu = P.in[I_S5BGLU] + l * 256; E.O = H;
                    pg8::gemm_phase(lds, g, S, E);
                }
                xcd_barrier(xb);
                g2.A = H; g2.Bt = (const bf16_t*)(P.ws + WS_WOUT) + (size_t)l * 1024 * 1024; g2.M = NLAT; g2.N = 1024; g2.K = 1024; g2.lda = 1024; g2.ldb = 1024;
            }
            {
                pg8::StaticOrder S; S.init(g2.M, g2.N, (int)gridDim.x, (int)blockIdx.x);
                EpiResid E; E.xlat = P.out; E.xctx = (float*)(P.ws + WS_CTXX); E.gate_l = mods_l + (3 * j + 2) * 1024; E.coef = (j == 1) ? 1.0f : 0.5f;
                pg8::gemm_phase(lds, g2, S, E);
                pg8::Gemm g3 = g2; g3.A = g2.A + (size_t)NLAT * g2.lda; g3.M = NCTX; g3.K = 256;
                pg8::SplitKOrder S3; S3.init(g3.M, g3.N, g2.K / 256, (int)gridDim.x, (int)blockIdx.x);
                EpiSlab E3; E3.slab = (float*)(P.ws + WS_SLAB);
                pg8::gemm_phase(lds, g3, S3, E3);
            }
            xcd_barrier(xb);
        }
    }
    phase_final(*getP());
}

extern "C" void kernel_launch(void* const* d_in, const int* in_sizes, int n_in, void* d_out, int out_size, void* d_ws, size_t ws_size, hipStream_t stream) {
    constexpr int LDS_BYTES = 139264 + 64;
    static int grid = 0;
    if (grid == 0) {
        if (n_in != 35 || ws_size < WS_END) { fprintf(stderr, "kernel_launch: expected 35 inputs and >= %zu bytes of workspace; got %d, %zu\n", (size_t)WS_END, n_in, ws_size); grid = -1; return; }
        int dev = 0, cus = 0, per_cu = 0;
        hipGetDevice(&dev);
        hipDeviceGetAttribute(&cus, hipDeviceAttributeMultiprocessorCount, dev);
        if (hipFuncSetAttribute((const void*)fwd_megakernel, hipFuncAttributeMaxDynamicSharedMemorySize, LDS_BYTES) != hipSuccess) { fprintf(stderr, "kernel_launch: hipFuncSetAttribute failed\n"); grid = -1; return; }
        if (hipOccupancyMaxActiveBlocksPerMultiprocessor(&per_cu, (const void*)fwd_megakernel, 512, LDS_BYTES) != hipSuccess || per_cu < 1) { fprintf(stderr, "kernel_launch: occupancy query says %d blocks per CU\n", per_cu); per_cu = 1; }
        (void)hipGetLastError();
        grid = cus;
    }
    if (grid < 0) return;
    Params p{};
    for (int i = 0; i < 35; ++i) p.in[i] = (const float*)d_in[i];
    p.out = (float*)d_out; p.ws = (unsigned char*)d_ws;
    if (hipMemsetAsync((char*)d_ws + WS_BAR, 0, SZ_BAR, stream) != hipSuccess) { fprintf(stderr, "kernel_launch: memset of the barrier words failed\n"); return; }
    void* args[] = {&p};
    hipError_t e = hipLaunchCooperativeKernel((const void*)fwd_megakernel, dim3(grid), dim3(512), args, LDS_BYTES, stream);
    if (e != hipSuccess) fprintf(stderr, "cooperative launch failed: %s (grid %d)\n", hipGetErrorString(e), grid);
}
```
